# Optimizing an MI355X kernel written in HIP

```python
import math
import jax, jax.numpy as jnp
from jax import lax
import numpy as np

D_MODEL = 1024
BATCH = 16
SEQ = 2048
DEPTH = 4

GRID_W = 64
CTX_LEN = 256
HEAD_DIM = 64
QBLK = 128
WINDOW = 128
ROPE_THETA = 10000.0
ROPE_PAIRS = HEAD_DIM // 4
EPS = 1e-6
SUBLN_EPS = 1e-5
ATTN_SCALE = HEAD_DIM ** -0.5

A_HEADS = D_MODEL // 128
A_KV = A_HEADS // 4
A_G = A_HEADS // A_KV
A_W = A_HEADS * HEAD_DIM
A_KVW = A_KV * HEAD_DIM
B_HEADS = D_MODEL // 256
B_W = B_HEADS * 2 * HEAD_DIM
C_HEADS = D_MODEL // 128
C_KV = C_HEADS // 4
C_G = C_HEADS // C_KV
C_W = C_HEADS * HEAD_DIM
C_KVW = C_KV * HEAD_DIM

IN_SIZES = (A_W, A_KVW, A_KVW, A_W,
            B_W, B_W, B_W, B_W,
            C_W, C_KVW, C_KVW, C_W)
IN_WIDTH = sum(IN_SIZES)

kernel_name = "hybrid_parallel_gqa_diff_window_dit"


def rmsnorm(x, g, eps=EPS):
    xf = x.astype(jnp.float32)
    y = xf * lax.rsqrt(jnp.mean(xf * xf, axis=-1, keepdims=True) + eps)
    return (y * g.astype(jnp.float32)).astype(x.dtype)


def axial_rope_tables(rows, dtype):
    row = jnp.repeat(jnp.arange(rows), GRID_W).astype(jnp.float32)
    col = jnp.tile(jnp.arange(GRID_W), rows).astype(jnp.float32)
    freqs = ROPE_THETA ** (-jnp.arange(ROPE_PAIRS, dtype=jnp.float32) / ROPE_PAIRS)
    ang_r = row[:, None] * freqs
    ang_c = col[:, None] * freqs
    ang = jnp.concatenate([ang_r, ang_r, ang_c, ang_c], axis=-1)
    return jnp.cos(ang).astype(dtype), jnp.sin(ang).astype(dtype)


def rope(x, cos, sin):
    xs = x.reshape(x.shape[:-1] + (2, 2, ROPE_PAIRS))
    rot = jnp.concatenate([-xs[..., 1:, :], xs[..., :1, :]], axis=-2).reshape(x.shape)
    return x * cos[:, None, :] + rot * sin[:, None, :]


def project(h, w_in, qn_g, kn_g, cos, sin):
    B, T, _ = h.shape
    idx = [int(v) for v in np.cumsum(IN_SIZES)[:-1]]
    qa, ka, va, ga, qb, kb, vb, gb, qc, kc, vc, gc = jnp.split(h @ w_in, idx, axis=-1)
    qa = rmsnorm(qa.reshape(B, T, A_HEADS, HEAD_DIM), qn_g)
    ka = rmsnorm(ka.reshape(B, T, A_KV, HEAD_DIM), kn_g)
    qb = qb.reshape(B, T, 2 * B_HEADS, HEAD_DIM)
    kb = kb.reshape(B, T, 2 * B_HEADS, HEAD_DIM)
    qc = qc.reshape(B, T, C_HEADS, HEAD_DIM)
    kc = kc.reshape(B, T, C_KV, HEAD_DIM)
    if cos is not None:
        qa, ka, qb, kb, qc, kc = [rope(t, cos, sin) for t in (qa, ka, qb, kb, qc, kc)]
    return (qa.reshape(B, T, A_KV, A_G, HEAD_DIM), ka, va.reshape(B, T, A_KV, HEAD_DIM), ga,
            qb.reshape(B, T, B_HEADS, 2, HEAD_DIM), kb.reshape(B, T, B_HEADS, 2, HEAD_DIM),
            vb.reshape(B, T, B_HEADS, 2 * HEAD_DIM), gb,
            qc.reshape(B, T, C_KV, C_G, HEAD_DIM), kc, vc.reshape(B, T, C_KV, HEAD_DIM), gc)


def gqa_attend(q, k, v, sink=None):
    s = jnp.einsum('bqkgd,btkd->bkgqt', q, k).astype(jnp.float32) * ATTN_SCALE
    if sink is not None:
        kvh, g = q.shape[2], q.shape[3]
        col = jnp.broadcast_to(sink.reshape(kvh, g)[None, :, :, None, None].astype(jnp.float32),
                               s.shape[:-1] + (1,))
        p = jax.nn.softmax(jnp.concatenate([s, col], axis=-1), axis=-1)[..., :-1]
    else:
        p = jax.nn.softmax(s, axis=-1)
    return jnp.einsum('bkgqt,btkd->bqkgd', p.astype(v.dtype), v)


def diff_attend(q, k, v, lam):
    s = jnp.einsum('bqhcd,bthcd->bhcqt', q, k).astype(jnp.float32) * ATTN_SCALE
    p = jax.nn.softmax(s, axis=-1)
    a = p[:, :, 0] - lam * p[:, :, 1]
    return jnp.einsum('bhqt,bthe->bqhe', a.astype(v.dtype), v)


def diff_post(o, g, lam_init):
    B, T = o.shape[:2]
    return (rmsnorm(o, g, SUBLN_EPS) * (1.0 - lam_init)).reshape(B, T, B_W)


def query_blocked(fn, q):
    B, S = q.shape[:2]
    nblk = S // QBLK
    qb = jnp.moveaxis(q.reshape((B, nblk, QBLK) + q.shape[2:]), 1, 0)
    ob = lax.map(fn, qb)
    return jnp.moveaxis(ob, 0, 1).reshape((B, S) + ob.shape[3:])


def window_attend(q, k, v, kc, vc, sink):
    B, S = q.shape[:2]
    nblk = S // QBLK
    ncx = kc.shape[1]

    def band(t):
        tp = jnp.pad(t, ((0, 0), (QBLK, QBLK), (0, 0), (0, 0))).reshape((B, nblk + 2, QBLK) + t.shape[2:])
        return jnp.moveaxis(jnp.concatenate([tp[:, :-2], tp[:, 1:-1], tp[:, 2:]], axis=2), 1, 0)

    qpos = jnp.arange(S).reshape(nblk, QBLK)
    kpos = (jnp.arange(nblk)[:, None] - 1) * QBLK + jnp.arange(3 * QBLK)[None, :]
    mask = ((jnp.abs(qpos[:, :, None] - kpos[:, None, :]) <= WINDOW)
            & (kpos >= 0)[:, None, :] & (kpos < S)[:, None, :])
    qb = jnp.moveaxis(q.reshape((B, nblk, QBLK) + q.shape[2:]), 1, 0)
    sink_l = sink.reshape(C_KV, C_G).astype(jnp.float32)

    def f(args):
        qblk, kblk, vblk, mblk = args
        s_loc = jnp.einsum('bqkgd,btkd->bkgqt', qblk, kblk).astype(jnp.float32) * ATTN_SCALE
        s_loc = jnp.where(mblk[None, None, None], s_loc, -jnp.inf)
        s_ctx = jnp.einsum('bqkgd,btkd->bkgqt', qblk, kc).astype(jnp.float32) * ATTN_SCALE
        col = jnp.broadcast_to(sink_l[None, :, :, None, None], s_ctx.shape[:-1] + (1,))
        p = jax.nn.softmax(jnp.concatenate([s_ctx, s_loc, col], axis=-1), axis=-1)
        p_ctx = p[..., :ncx].astype(v.dtype)
        p_loc = p[..., ncx:-1].astype(v.dtype)
        return (jnp.einsum('bkgqt,btkd->bqkgd', p_ctx, vc)
                + jnp.einsum('bkgqt,btkd->bqkgd', p_loc, vblk))

    ob = lax.map(f, (qb, band(k), band(v), mask))
    return jnp.moveaxis(ob, 0, 1).reshape((B, S) + ob.shape[3:])


def merge_out(h, oa, ob, oc, ga, gb, gc, w_br_a, w_br_b, w_br_c, w_mg, b_mg, w_out):
    B, T, _ = h.shape
    pa = (oa.reshape(B, T, A_W) * jax.nn.silu(ga)) @ w_br_a
    pb = (ob * jax.nn.silu(gb)) @ w_br_b
    pc = (oc.reshape(B, T, C_W) * jax.nn.silu(gc)) @ w_br_c
    g_a, g_b, g_c = jnp.split(jax.nn.sigmoid(h @ w_mg + b_mg), 3, axis=-1)
    return (g_a * pa + g_b * pb + g_c * pc) @ w_out


def setup_inputs(seed: int = 0) -> dict:
    key = jax.random.key(seed)
    ks = jax.random.split(key, 24)
    f32 = jnp.float32
    n = lambda k, shape, s: jax.random.normal(k, shape, f32) * s
    D = D_MODEL
    return {
        "x": n(ks[0], (BATCH, SEQ, D), 1.0),
        "c": n(ks[1], (BATCH, D), 1.0),
        "ctx": n(ks[2], (BATCH, CTX_LEN, D), 1.0),
        "c_ctx": n(ks[3], (D,), 1.0),
        "w_ada": n(ks[4], (DEPTH, D, 3 * D), 0.5 * D ** -0.5),
        "b_ada": n(ks[5], (DEPTH, 3 * D), 0.02),
        "g_pre": 1.0 + n(ks[6], (DEPTH, D), 0.02),
        "g_post": 1.0 + n(ks[7], (DEPTH, D), 0.02),
        "w_in": n(ks[8], (DEPTH, D, IN_WIDTH), D ** -0.5),
        "q_norm": 1.0 + n(ks[9], (DEPTH, HEAD_DIM), 0.02),
        "k_norm": 1.0 + n(ks[10], (DEPTH, HEAD_DIM), 0.02),
        "lam_q1": n(ks[11], (DEPTH, HEAD_DIM), 0.1),
        "lam_k1": n(ks[12], (DEPTH, HEAD_DIM), 0.1),
        "lam_q2": n(ks[13], (DEPTH, HEAD_DIM), 0.1),
        "lam_k2": n(ks[14], (DEPTH, HEAD_DIM), 0.1),
        "subln": 1.0 + n(ks[15], (DEPTH, 2 * HEAD_DIM), 0.02),
        "sink": n(ks[16], (DEPTH, C_HEADS), 0.5),
        "w_br_a": n(ks[17], (DEPTH, A_W, D), A_W ** -0.5),
        "w_br_b": n(ks[18], (DEPTH, B_W, D), B_W ** -0.5),
        "w_br_c": n(ks[19], (DEPTH, C_W, D), C_W ** -0.5),
        "w_mg": n(ks[20], (DEPTH, D, 3 * D), D ** -0.5),
        "b_mg": n(ks[21], (DEPTH, 3 * D), 0.1),
        "w_out": n(ks[22], (DEPTH, D, D), D ** -0.5),
    }


def reference(x, c, ctx, c_ctx, w_ada, b_ada, g_pre, g_post, w_in, q_norm, k_norm,
              lam_q1, lam_k1, lam_q2, lam_k2, subln, sink, w_br_a, w_br_b, w_br_c,
              w_mg, b_mg, w_out):
    S = x.shape[1]
    ROWS = S // GRID_W
    cos, sin = axial_rope_tables(ROWS, x.dtype)
    sc = jax.nn.silu(c)
    scc = jax.nn.silu(c_ctx)
    cx = ctx
    for l in range(DEPTH):
        last = l == DEPTH - 1
        shift, scale, gate = jnp.split(sc @ w_ada[l] + b_ada[l], 3, axis=-1)
        shift_c, scale_c, gate_c = jnp.split(scc @ w_ada[l] + b_ada[l], 3, axis=-1)
        h = rmsnorm(x, g_pre[l]) * (1.0 + scale[:, None]) + shift[:, None]
        hc = rmsnorm(cx, g_pre[l]) * (1.0 + scale_c) + shift_c
        (qa, ka, va, ga, qb, kb, vb, gb, qc, kc, vc, gc) = project(h, w_in[l], q_norm[l], k_norm[l], cos, sin)
        (cqa, cka, cva, cga, cqb, ckb, cvb, cgb, cqc, ckc, cvc, cgc) = project(hc, w_in[l], q_norm[l], k_norm[l], None, None)
        lam_init = 0.8 - 0.6 * math.exp(-0.3 * l)
        lam = (jnp.exp(jnp.sum(lam_q1[l].astype(jnp.float32) * lam_k1[l].astype(jnp.float32)))
               - jnp.exp(jnp.sum(lam_q2[l].astype(jnp.float32) * lam_k2[l].astype(jnp.float32)))
               + lam_init)
        ka_all = jnp.concatenate([cka, ka], axis=1)
        va_all = jnp.concatenate([cva, va], axis=1)
        kb_all = jnp.concatenate([ckb, kb], axis=1)
        vb_all = jnp.concatenate([cvb, vb], axis=1)
        oa = query_blocked(lambda qblk: gqa_attend(qblk, ka_all, va_all), qa)
        ob = diff_post(query_blocked(lambda qblk: diff_attend(qblk, kb_all, vb_all, lam), qb), subln[l], lam_init)
        oc = window_attend(qc, kc, vc, ckc, cvc, sink[l])
        y = merge_out(h, oa, ob, oc, ga, gb, gc, w_br_a[l], w_br_b[l], w_br_c[l], w_mg[l], b_mg[l], w_out[l])
        if not last:
            coa = gqa_attend(cqa, cka, cva)
            cob = diff_post(diff_attend(cqb, ckb, cvb, lam), subln[l], lam_init)
            coc = gqa_attend(cqc, ckc, cvc, sink[l])
            yc = merge_out(hc, coa, cob, coc, cga, cgb, cgc, w_br_a[l], w_br_b[l], w_br_c[l], w_mg[l], b_mg[l], w_out[l])
            cx = cx + gate_c * rmsnorm(yc, g_post[l])
        x = x + gate[:, None] * rmsnorm(y, g_post[l])
    return x
```

```cpp
#include <hip/hip_runtime.h>
#include <hip/hip_cooperative_groups.h>
#include <cstdio>
#include <cstdint>
namespace cg = cooperative_groups;

typedef unsigned short bf16_t;
typedef short bf16x8 __attribute__((ext_vector_type(8)));
typedef float f32x16 __attribute__((ext_vector_type(16)));
typedef unsigned u32x4 __attribute__((ext_vector_type(4)));
typedef float f32x4 __attribute__((ext_vector_type(4)));
typedef unsigned u32x2 __attribute__((ext_vector_type(2)));

constexpr int NB = 16, SEQ = 2048, CTXL = 256, TT = 2304, DM = 1024, NLAY = 4, INW = 4608, N1 = 7680;
constexpr int CB = 8, NTC = CB * TT;
constexpr int LDS_BYTES = 147456;
constexpr int NTHR = 512;
constexpr int LROW = 144;
constexpr float LOG2E = 1.4426950408889634f;

#define MFMA(a, b, c) __builtin_amdgcn_mfma_f32_32x32x16_bf16((a), (b), (c), 0, 0, 0)

constexpr size_t al256(size_t x) { return (x + 255) & ~(size_t)255; }
constexpr size_t OFF_W1T = 0;
constexpr size_t OFF_WBRT = OFF_W1T + al256((size_t)NLAY * N1 * DM * 2);
constexpr size_t OFF_WOUTT = OFF_WBRT + al256((size_t)NLAY * 3 * DM * 512 * 2);
constexpr size_t OFF_MODP = OFF_WOUTT + al256((size_t)NLAY * DM * DM * 2);
constexpr size_t OFF_MOD = OFF_MODP + al256((size_t)8 * NLAY * 17 * 3072 * 4);
constexpr size_t OFF_ROPE = OFF_MOD + al256((size_t)NLAY * 17 * 3072 * 4);
constexpr size_t OFF_LAM = OFF_ROPE + al256(64 * 16 * 2 * 4);
constexpr size_t OFF_BAR = OFF_LAM + 256;
constexpr size_t OFF_CX = OFF_BAR + al256((size_t)16384 * 4);
constexpr size_t OFF_H = OFF_CX + al256((size_t)NB * CTXL * DM * 4);
constexpr size_t OFF_U = OFF_H + al256((size_t)NTC * DM * 2);
constexpr size_t OFF_PROJ = OFF_U + al256((size_t)NTC * 1536 * 2);
constexpr size_t OFF_VTA = OFF_PROJ + al256((size_t)NTC * INW * 2);
constexpr size_t OFF_VTB = OFF_VTA + al256((size_t)CB * 2 * 64 * TT * 2);
constexpr size_t OFF_VTC = OFF_VTB + al256((size_t)CB * 4 * 128 * TT * 2);
constexpr size_t OFF_G = OFF_VTC + al256((size_t)CB * 2 * 64 * TT * 2);
constexpr size_t WS_END = OFF_G + al256((size_t)NTC * 3072 * 2);
constexpr size_t OFF_MB = OFF_PROJ;
constexpr size_t OFF_Y = OFF_PROJ + (size_t)NTC * DM * 2;

struct Params {
    const float *x, *c, *ctx, *c_ctx, *w_ada, *b_ada, *g_pre, *g_post, *w_in, *q_norm, *k_norm;
    const float *lam_q1, *lam_k1, *lam_q2, *lam_k2, *subln, *sink, *w_br_a, *w_br_b, *w_br_c, *w_mg, *b_mg, *w_out;
    float* out;
    unsigned char* ws;
    __device__ __forceinline__ bf16_t* W1t() const { return (bf16_t*)(ws + OFF_W1T); }
    __device__ __forceinline__ bf16_t* Wbrt() const { return (bf16_t*)(ws + OFF_WBRT); }
    __device__ __forceinline__ bf16_t* Woutt() const { return (bf16_t*)(ws + OFF_WOUTT); }
    __device__ __forceinline__ float* MODP() const { return (float*)(ws + OFF_MODP); }
    __device__ __forceinline__ float* MOD() const { return (float*)(ws + OFF_MOD); }
    __device__ __forceinline__ float* ROPE() const { return (float*)(ws + OFF_ROPE); }
    __device__ __forceinline__ float* LAM() const { return (float*)(ws + OFF_LAM); }
    __device__ __forceinline__ unsigned* BAR() const { return (unsigned*)(ws + OFF_BAR); }
    __device__ __forceinline__ float* CX() const { return (float*)(ws + OFF_CX); }
    __device__ __forceinline__ bf16_t* H() const { return (bf16_t*)(ws + OFF_H); }
    __device__ __forceinline__ bf16_t* U() const { return (bf16_t*)(ws + OFF_U); }
    __device__ __forceinline__ bf16_t* PROJ() const { return (bf16_t*)(ws + OFF_PROJ); }
    __device__ __forceinline__ bf16_t* VtA() const { return (bf16_t*)(ws + OFF_VTA); }
    __device__ __forceinline__ bf16_t* VtB() const { return (bf16_t*)(ws + OFF_VTB); }
    __device__ __forceinline__ bf16_t* VtC() const { return (bf16_t*)(ws + OFF_VTC); }
    __device__ __forceinline__ bf16_t* G() const { return (bf16_t*)(ws + OFF_G); }
    __device__ __forceinline__ bf16_t* Mb() const { return (bf16_t*)(ws + OFF_MB); }
    __device__ __forceinline__ float* Y() const { return (float*)(ws + OFF_Y); }
};

typedef __bf16 bf16x2_t __attribute__((ext_vector_type(2)));
typedef float f32x2_t __attribute__((ext_vector_type(2)));
__device__ __forceinline__ unsigned pk2(float lo, float hi) { const f32x2_t f = {lo, hi}; const bf16x2_t b = __builtin_convertvector(f, bf16x2_t); return __builtin_bit_cast(unsigned, b); }
__device__ __forceinline__ float bflo(unsigned w) { return __uint_as_float(w << 16); }
__device__ __forceinline__ float bfhi(unsigned w) { return __uint_as_float(w & 0xffff0000u); }
__device__ __forceinline__ float sigmoid_f(float v) { return __builtin_amdgcn_rcpf(1.f + __builtin_amdgcn_exp2f(-LOG2E * v)); }
__device__ __forceinline__ float silu_f(float v) { return v * sigmoid_f(v); }
__device__ __forceinline__ float wave_sum(float v) {
    v += __shfl_xor(v, 32); v += __shfl_xor(v, 16); v += __shfl_xor(v, 8); v += __shfl_xor(v, 4); v += __shfl_xor(v, 2); v += __shfl_xor(v, 1); return v;
}
__device__ __forceinline__ int opaque_tid() { int t = threadIdx.x; asm volatile("" : "+v"(t)); return t; }
__device__ __forceinline__ float lam_init_of(int l) { return 0.8f - 0.6f * expf(-0.3f * (float)l); }


#define XB_TMO      128
#define XB_XCNT(j)  (256  + 64 * (j))
#define XB_XSUB(j)  (1280 + 64 * (j))
#define XB_XGEN(j)  (2304 + 64 * (j))
#define XB_TOP      3328
#define XB_TOPGEN   3392
#define XCD_BAR_WORDS 3456
#define G23_PC(mt)   (XCD_BAR_WORDS + 64 * (mt))
#define G23_TK       (XCD_BAR_WORDS + 64 * 72)
#define G23_PC2(mt)  (XCD_BAR_WORDS + 64 * 73 + 64 * (mt))
#define G23_TK2      (XCD_BAR_WORDS + 64 * 145)
#define G23_TK3      (XCD_BAR_WORDS + 64 * 146)
#define ALL_BAR_WORDS (XCD_BAR_WORDS + 64 * 147)
#define XB_SPIN_CAP (1u << 18)
#define LAS __attribute__((address_space(3)))
__device__ __forceinline__ unsigned xb_ld(unsigned* p)              { return __hip_atomic_load(p, __ATOMIC_RELAXED, __HIP_MEMORY_SCOPE_AGENT); }
__device__ __forceinline__ unsigned xb_add(unsigned* p, unsigned v) { return __hip_atomic_fetch_add(p, v, __ATOMIC_RELAXED, __HIP_MEMORY_SCOPE_AGENT); }
__device__ __forceinline__ unsigned xb_xcc_id() { return (unsigned)__builtin_amdgcn_s_getreg((3 << 11) | 20) & 0xFu; }
#define XB_SPIN(cond, bar) do { unsigned _sp = 0; while (cond) { __builtin_amdgcn_s_sleep(1); \
    if ((++_sp & 255u) == 0u) { if (xb_ld(&(bar)[XB_TMO])) break; if (_sp > XB_SPIN_CAP) { atomicAdd(&(bar)[XB_TMO], 1u); break; } } } } while (0)
#define XB_SPIN_SLOW(cond, bar) do { unsigned _sp = 0; while (cond) { __builtin_amdgcn_s_sleep(32); \
    if ((++_sp & 63u) == 0u) { if (xb_ld(&(bar)[XB_TMO])) break; if (_sp > (1u << 17)) { atomicAdd(&(bar)[XB_TMO], 1u); break; } } } } while (0)
struct XcdBarrier { unsigned* bar; unsigned x; volatile LAS unsigned* st; };
__device__ __forceinline__ XcdBarrier xcd_barrier_post(unsigned* bar, volatile LAS unsigned* st) {
    XcdBarrier b; b.bar = bar; b.x = xb_xcc_id(); b.st = st;
    if (threadIdx.x == 0) (void)xb_add(&bar[XB_XCNT(b.x)], 1u);
    return b;
}
__device__ __forceinline__ void xcd_barrier_complete(unsigned* bar, unsigned x, unsigned& nloc, unsigned& nx) {
    const unsigned G = gridDim.x * gridDim.y * gridDim.z;
    unsigned sum, cnt, mine, sp = 0u;
    for (;;) {
        sum = 0u; cnt = 0u; mine = 0u;
#pragma unroll
        for (unsigned j = 0; j < 16; ++j) { const unsigned c = xb_ld(&bar[XB_XCNT(j)]); sum += c; cnt += (c > 0u) ? 1u : 0u; mine = (j == x) ? c : mine; }
        if (sum == G) break;
        __builtin_amdgcn_s_sleep(1);
        if ((++sp & 255u) == 0u) { if (xb_ld(&bar[XB_TMO])) break; if (sp > XB_SPIN_CAP) { atomicAdd(&bar[XB_TMO], 1u); break; } }
    }
    nloc = mine > 0u ? mine : 1u; nx = cnt > 0u ? cnt : 1u;
}
__device__ __forceinline__ void xcd_barrier(unsigned* bar_, volatile LAS unsigned* st_) {
    XcdBarrier b; b.bar = bar_; b.x = xb_xcc_id(); b.st = st_;
    asm volatile("s_waitcnt vmcnt(0)" ::: "memory");
    __syncthreads();
    if (threadIdx.x == 0) {
        unsigned* bar = b.bar;
        __builtin_amdgcn_s_waitcnt(0);
        unsigned nloc = b.st[0], nx = b.st[1];
        if (nloc == 0u) { xcd_barrier_complete(bar, b.x, nloc, nx); b.st[0] = nloc; b.st[1] = nx; }
        const unsigned old = xb_add(&bar[XB_XSUB(b.x)], 1u);
        const unsigned gen = old / nloc;
        if (old + 1u == (gen + 1u) * nloc) {
            __builtin_amdgcn_fence(__ATOMIC_RELEASE, "agent");
            asm volatile("s_waitcnt vmcnt(0)" ::: "memory");
            const unsigned og = xb_add(&bar[XB_TOP], 1u);
            const unsigned tg = og / nx;
            if (og + 1u == (tg + 1u) * nx) xb_add(&bar[XB_TOPGEN], 1u);
            else XB_SPIN(xb_ld(&bar[XB_TOPGEN]) == tg, bar);
            __builtin_amdgcn_fence(__ATOMIC_ACQUIRE, "agent");
            xb_add(&bar[XB_XGEN(b.x)], 1u);
            asm volatile("s_waitcnt vmcnt(0)" ::: "memory");
        } else {
            XB_SPIN(xb_ld(&bar[XB_XGEN(b.x)]) == gen, bar);
            __builtin_amdgcn_fence(__ATOMIC_ACQUIRE, "agent");
            asm volatile("s_waitcnt vmcnt(0)" ::: "memory");
        }
    }
    __syncthreads();
}

template <int NY>
__device__ __forceinline__ void gemm_tile(const bf16_t* __restrict__ X, int ldx, const bf16_t* __restrict__ Y, int ldy, int K,
                                          f32x16 (&acc)[2][NY], unsigned char* lds, int tid) {
    const int lane = tid & 63, wave = tid >> 6, wm = wave >> 1, wn = wave & 1, l31 = lane & 31, hh = lane >> 5;
    const int lrow = tid >> 3, lc = tid & 7;
    const bf16_t* gx = X + (size_t)lrow * ldx + lc * 8;
    const bf16_t* gy = Y + (size_t)lrow * ldy + lc * 8;
    u32x4 rx[4], ry[2 * NY];
#pragma unroll
    for (int i = 0; i < 4; i++) rx[i] = *(const u32x4*)(gx + (size_t)(32 * i) * ldx);
#pragma unroll
    for (int i = 0; i < 2 * NY; i++) ry[i] = *(const u32x4*)(gy + (size_t)(32 * i) * ldy);
    __syncthreads();
    unsigned char* wx = lds + lrow * LROW + lc * 16;
#pragma unroll
    for (int i = 0; i < 4; i++) *(u32x4*)(wx + i * 32 * LROW) = rx[i];
#pragma unroll
    for (int i = 0; i < 2 * NY; i++) *(u32x4*)(wx + 18432 + i * 32 * LROW) = ry[i];
    __syncthreads();
    const int nk = K >> 6;
    const unsigned char* rxb = lds + (wm * 64 + l31) * LROW + hh * 16;
    const unsigned char* ryb = lds + 18432 + (wn * 32 * NY + l31) * LROW + hh * 16;
    for (int kt = 0; kt < nk; kt++) {
        const int cur = (kt & 1) * 36864;
        const bool more = (kt + 1 < nk);
        if (more) {
            const int ko = (kt + 1) * 64;
#pragma unroll
            for (int i = 0; i < 4; i++) rx[i] = *(const u32x4*)(gx + (size_t)(32 * i) * ldx + ko);
#pragma unroll
            for (int i = 0; i < 2 * NY; i++) ry[i] = *(const u32x4*)(gy + (size_t)(32 * i) * ldy + ko);
        }
#pragma unroll
        for (int kk = 0; kk < 4; kk++) {
            bf16x8 xf[2], yf[NY];
            xf[0] = *(const bf16x8*)(rxb + cur + kk * 32);
            xf[1] = *(const bf16x8*)(rxb + cur + 32 * LROW + kk * 32);
#pragma unroll
            for (int yi = 0; yi < NY; yi++) yf[yi] = *(const bf16x8*)(ryb + cur + yi * 32 * LROW + kk * 32);
#pragma unroll
            for (int xi = 0; xi < 2; xi++)
#pragma unroll
                for (int yi = 0; yi < NY; yi++) acc[xi][yi] = MFMA(xf[xi], yf[yi], acc[xi][yi]);
        }
        if (more) {
            unsigned char* w2 = wx + (36864 - cur);
#pragma unroll
            for (int i = 0; i < 4; i++) *(u32x4*)(w2 + i * 32 * LROW) = rx[i];
#pragma unroll
            for (int i = 0; i < 2 * NY; i++) *(u32x4*)(w2 + 18432 + i * 32 * LROW) = ry[i];
        }
        __syncthreads();
    }
}

template <int NY>
__device__ __forceinline__ void zero_acc(f32x16 (&acc)[2][NY]) {
#pragma unroll
    for (int a = 0; a < 2; a++)
#pragma unroll
        for (int b = 0; b < NY; b++)
#pragma unroll
            for (int r = 0; r < 16; r++) acc[a][b][r] = 0.f;
}

template <bool PERM = false>
__device__ __forceinline__ void transpose_tile(const float* __restrict__ src, int ldsrc, bf16_t* __restrict__ dst, int lddst, int k0, int n0, float* tile) {
    const int tid = opaque_tid();
    __syncthreads();
#pragma unroll
    for (int i = 0; i < 2; i++) {
        const int id = tid + i * 512, r = id >> 4, c4 = id & 15;
        const float4 v = *(const float4*)(src + (size_t)(k0 + r) * ldsrc + n0 + c4 * 4);
        float* tp = tile + r * 65 + c4 * 4;
        tp[0] = v.x; tp[1] = v.y; tp[2] = v.z; tp[3] = v.w;
    }
    __syncthreads();
    const int n = tid >> 3, kq = tid & 7;
    u32x4 w;
#pragma unroll
    for (int j = 0; j < 4; j++) w[j] = pk2(tile[(kq * 8 + 2 * j) * 65 + n], tile[(kq * 8 + 2 * j + 1) * 65 + n]);
    const int nrow = PERM ? (((n >> 2) & 3) * 16 + ((n >> 4) & 3) * 4 + (n & 3)) : n;
    *(u32x4*)(dst + (size_t)(n0 + nrow) * lddst + k0 + kq * 8) = w;
}

__device__ __forceinline__ int nb2ob(int nb) {
    if (nb < 4) return nb;
    if (nb == 4) return 4;
    if (nb == 5) return 30;
    if (nb == 6) return 5;
    if (nb == 7) return 31;
    if (nb < 32) return nb - 2;
    return nb;
}

__device__ __forceinline__ void phase_pro_a(const Params& p, unsigned char* lds) {
    const int tid = opaque_tid();
    float* tile = (float*)lds;
    const int NCONV = 2560 * NLAY;
    for (int j = blockIdx.x; j < NCONV + 192; j += gridDim.x) {
        if (j < NCONV) {
            const int l = j / 2560; int r = j - l * 2560;
            if (r < 1920) {
                const int kt = r / 120, nt = r - kt * 120;
                const int ob = nb2ob(nt >> 1), oc = ob * 128 + (nt & 1) * 64;
                bf16_t* dstw = p.W1t() + ((size_t)l * N1 + nt * 64) * DM;
                if (oc < INW) transpose_tile(p.w_in + (size_t)l * DM * INW + oc, INW, dstw, DM, kt * 64, 0, tile);
                else transpose_tile(p.w_mg + (size_t)l * DM * 3072 + (oc - INW), 3072, dstw, DM, kt * 64, 0, tile);
            }
            else if (r < 2304) { r -= 1920; const int which = r >> 7; r &= 127; const int kt = r >> 4, nt = r & 15;
                bf16_t* dstw = p.Wbrt() + (size_t)(l * 3 + which) * DM * 512;
                if (which == 0) transpose_tile<true>(p.w_br_a + (size_t)l * 512 * DM, DM, dstw, 512, kt * 64, nt * 64, tile);
                else if (which == 1) transpose_tile<true>(p.w_br_b + (size_t)l * 512 * DM, DM, dstw, 512, kt * 64, nt * 64, tile);
                else transpose_tile<true>(p.w_br_c + (size_t)l * 512 * DM, DM, dstw, 512, kt * 64, nt * 64, tile); }
            else { r -= 2304; const int kt = r >> 4, nt = r & 15;
                transpose_tile(p.w_out + (size_t)l * DM * DM, DM, p.Woutt() + (size_t)l * DM * DM, DM, kt * 64, nt * 64, tile); }
        } else {
            const int jj = j - NCONV; const int l = jj / 48; const int rr = jj - l * 48; const int kc = rr / 6, jb = rr - kc * 6;
            float* sc = (float*)lds;
            __syncthreads();
            for (int idx = tid; idx < 17 * 128; idx += NTHR) {
                const int r = idx >> 7, k = idx & 127;
                const float v = (r < 16) ? p.c[r * DM + kc * 128 + k] : p.c_ctx[kc * 128 + k];
                sc[idx] = v / (1.f + expf(-v));
            }
            __syncthreads();
            float a[17];
#pragma unroll
            for (int r = 0; r < 17; r++) a[r] = 0.f;
            const float* w = p.w_ada + ((size_t)l * DM + kc * 128) * 3072 + jb * NTHR + tid;
            for (int k = 0; k < 128; k++) {
                const float wv = w[(size_t)k * 3072];
#pragma unroll
                for (int r = 0; r < 17; r++) a[r] += sc[r * 128 + k] * wv;
            }
#pragma unroll
            for (int r = 0; r < 17; r++) p.MODP()[((size_t)(kc * 4 + l) * 17 + r) * 3072 + jb * NTHR + tid] = a[r];
        }
    }
}

__device__ const double ROPE_FREQ[16] = {1.0, 0.5623413251903491, 0.31622776601683794, 0.1778279410038923, 0.1, 0.05623413251903491,
    0.031622776601683794, 0.01778279410038923, 0.01, 0.005623413251903491, 0.0031622776601683794, 0.001778279410038923,
    0.001, 0.0005623413251903491, 0.00031622776601683794, 0.0001778279410038923};

__device__ __forceinline__ void sincos_d(double a, double& s, double& c) {
    const double n = rint(a * 0.6366197723675814);
    double r = fma(-n, 1.5707963267948966, a); r = fma(-n, 6.123233995736766e-17, r);
    const double r2 = r * r;
    const double sp = r * (1.0 + r2 * (-1.0 / 6.0 + r2 * (1.0 / 120.0 + r2 * (-1.0 / 5040.0 + r2 * (1.0 / 362880.0 + r2 * (-1.0 / 39916800.0 + r2 * (1.0 / 6227020800.0 + r2 * (-1.0 / 1307674368000.0))))))));
    const double cp = 1.0 + r2 * (-0.5 + r2 * (1.0 / 24.0 + r2 * (-1.0 / 720.0 + r2 * (1.0 / 40320.0 + r2 * (-1.0 / 3628800.0 + r2 * (1.0 / 479001600.0 + r2 * (-1.0 / 87178291200.0 + r2 * (1.0 / 20922789888000.0))))))));
    const int q = ((int)n) & 3;
    if (q == 0) { s = sp; c = cp; } else if (q == 1) { s = cp; c = -sp; } else if (q == 2) { s = -sp; c = -cp; } else { s = -cp; c = sp; }
}

__device__ __forceinline__ void phase_pro_b(const Params& p) {
    const int tid = opaque_tid(), lane = tid & 63, wave = tid >> 6;
    const int gsz = gridDim.x * NTHR;
    for (int idx = blockIdx.x * NTHR + tid; idx < NLAY * 17 * 3072; idx += gsz) {
        const int l = idx / (17 * 3072), j = idx % 3072;
        float s = p.b_ada[l * 3072 + j];
#pragma unroll
        for (int kc = 0; kc < 8; kc++) s += p.MODP()[(size_t)kc * (NLAY * 17 * 3072) + idx];
        p.MOD()[idx] = s;
    }
    if (blockIdx.x == 0 && wave < NLAY) {
        const int l = wave;
        float a = p.lam_q1[l * 64 + lane] * p.lam_k1[l * 64 + lane];
        float b = p.lam_q2[l * 64 + lane] * p.lam_k2[l * 64 + lane];
        a = wave_sum(a); b = wave_sum(b);
        if (lane == 0) p.LAM()[l] = expf(a) - expf(b) + lam_init_of(l);
    }
    if (blockIdx.x == (gridDim.x > 1 ? 1 : 0)) {
        for (int idx = tid; idx < 1024; idx += NTHR) {
            const int pp = idx >> 4, i = idx & 15;
            double s, c; sincos_d((double)pp * ROPE_FREQ[i], s, c);
            p.ROPE()[idx * 2] = (float)c; p.ROPE()[idx * 2 + 1] = (float)s;
        }
    }
}

__device__ __forceinline__ int panel_of(int pi) { return pi < 64 ? (pi >> 3) * 9 + 1 + (pi & 7) : (pi - 64) * 9; }
__device__ __forceinline__ unsigned panel_want(int mt, int inst) { return 4u * (unsigned)(inst + 1) - ((inst > 3 && (mt % 9) == 0) ? 4u : 0u); }
template <bool HOIST>
__device__ __forceinline__ void norm_rows(const Params& p, int chunk, int layer, int row_begin, int row_end, int row_step) {
    const int tid = opaque_tid(), lane = tid & 63, wave = tid >> 6;
    float4 gq[4], ga[4], sh[4];
    auto load_vecs = [&](int mr) {
        if (layer >= 0) {
            const float* gate = p.MOD() + ((size_t)layer * 17 + mr) * 3072 + 2048;
            const float* gp = p.g_post + layer * DM;
#pragma unroll
            for (int i = 0; i < 4; i++) { const int e = i * 256 + lane * 4; const float4 g = *(const float4*)(gate + e), q = *(const float4*)(gp + e);
                gq[i] = make_float4(g.x * q.x, g.y * q.y, g.z * q.z, g.w * q.w); }
        }
        if (layer < NLAY - 1) {
            const int nl = layer + 1;
            const float* md = p.MOD() + ((size_t)nl * 17 + mr) * 3072;
            const float* gpre = p.g_pre + nl * DM;
#pragma unroll
            for (int i = 0; i < 4; i++) { const int e = i * 256 + lane * 4; const float4 s4 = *(const float4*)(md + e), scl = *(const float4*)(md + 1024 + e), g = *(const float4*)(gpre + e);
                ga[i] = make_float4(g.x * (1.f + scl.x), g.y * (1.f + scl.y), g.z * (1.f + scl.z), g.w * (1.f + scl.w)); sh[i] = s4; }
        }
    };
    if (HOIST) { const int bl0 = row_begin / TT, t0 = row_begin - bl0 * TT; load_vecs(t0 < CTXL ? 16 : chunk * CB + bl0); }
    for (int row = row_begin + wave; row < row_end; row += row_step) {
        const int bl = row / TT, t = row - bl * TT, b = chunk * CB + bl;
        const bool isctx = t < CTXL;
        if (layer == NLAY - 1 && isctx) continue;
        const float* xin; float* xst; int mr;
        if (isctx) { const size_t o = ((size_t)b * CTXL + t) * DM; xin = (layer <= 0 ? p.ctx : (const float*)p.CX()) + o; xst = p.CX() + o; mr = 16; }
        else { const size_t o = ((size_t)b * SEQ + (t - CTXL)) * DM; xin = (layer <= 0 ? p.x : (const float*)p.out) + o; xst = p.out + o; mr = b; }
        if (!HOIST) load_vecs(mr);
        float4 xv[4];
#pragma unroll
        for (int i = 0; i < 4; i++) xv[i] = *(const float4*)(xin + i * 256 + lane * 4);
        if (layer >= 0) {
            const bf16_t* yr = (const bf16_t*)p.Y() + (size_t)row * DM;
            float4 yv[4]; float ss = 0.f;
#pragma unroll
            for (int i = 0; i < 4; i++) { const uint2 w = *(const uint2*)(yr + i * 256 + lane * 4); yv[i] = make_float4(bflo(w.x), bfhi(w.x), bflo(w.y), bfhi(w.y));
                ss += yv[i].x * yv[i].x + yv[i].y * yv[i].y + yv[i].z * yv[i].z + yv[i].w * yv[i].w; }
            ss = wave_sum(ss);
            const float rstd = rsqrtf(ss * (1.f / DM) + 1e-6f);
#pragma unroll
            for (int i = 0; i < 4; i++) {
                const int e = i * 256 + lane * 4;
                xv[i].x += gq[i].x * (yv[i].x * rstd); xv[i].y += gq[i].y * (yv[i].y * rstd);
                xv[i].z += gq[i].z * (yv[i].z * rstd); xv[i].w += gq[i].w * (yv[i].w * rstd);
                *(float4*)(xst + e) = xv[i];
            }
        }
        if (layer < NLAY - 1) {
            float ss = 0.f;
#pragma unroll
            for (int i = 0; i < 4; i++) ss += xv[i].x * xv[i].x + xv[i].y * xv[i].y + xv[i].z * xv[i].z + xv[i].w * xv[i].w;
            ss = wave_sum(ss);
            const float rstd = rsqrtf(ss * (1.f / DM) + 1e-6f);
#pragma unroll
            for (int i = 0; i < 4; i++) {
                const int e = i * 256 + lane * 4;
                const float h0 = xv[i].x * rstd * ga[i].x + sh[i].x, h1 = xv[i].y * rstd * ga[i].y + sh[i].y;
                const float h2 = xv[i].z * rstd * ga[i].z + sh[i].z, h3 = xv[i].w * rstd * ga[i].w + sh[i].w;
                *(uint2*)(p.H() + (size_t)row * DM + e) = make_uint2(pk2(h0, h1), pk2(h2, h3));
            }
        }
    }
}
__device__ __forceinline__ void phase_norm(const Params& p, int chunk, int layer) {
    norm_rows<false>(p, chunk, layer, blockIdx.x * 8, NTC, gridDim.x * 8);
}
__device__ __forceinline__ void phase_norm_ticketed(const Params& p, int chunk, int layer, int inst, volatile LAS unsigned* bst) {
    for (;;) {
        __syncthreads();
        if (threadIdx.x == 0) {
            const unsigned tk = xb_add(&p.BAR()[G23_TK2], 1u) - 544u * (unsigned)inst;
            if (tk < 288u && !(layer == NLAY - 1 && ((int)(tk >> 2) % 9) == 0)) {
                unsigned* pc = &p.BAR()[G23_PC2(tk >> 2)];
                const unsigned want = panel_want((int)(tk >> 2), inst);
                XB_SPIN_SLOW(xb_ld(pc) < want, p.BAR());
                __builtin_amdgcn_fence(__ATOMIC_ACQUIRE, "agent");
                asm volatile("s_waitcnt vmcnt(0)" ::: "memory");
            }
            bst[2] = tk;
        }
        __syncthreads();
        const unsigned it = (unsigned)__builtin_amdgcn_readfirstlane((int)bst[2]);
        if (it >= 288u) break;
        norm_rows<true>(p, chunk, layer, (int)it * 64, (int)it * 64 + 64, 8);
    }
}

__device__ __forceinline__ void phase_norm0_ticketed(const Params& p, int chunk, volatile LAS unsigned* bst) {
    for (;;) {
        __syncthreads();
        if (threadIdx.x == 0) bst[2] = xb_add(&p.BAR()[G23_TK3], 1u);
        __syncthreads();
        const unsigned it = (unsigned)__builtin_amdgcn_readfirstlane((int)bst[2]);
        if (it >= 288u) break;
        norm_rows<true>(p, chunk, -1, (int)it * 64, (int)it * 64 + 64, 8);
    }
}

__device__ __forceinline__ int lds_byte(int r, int c) {
    const int st = (r >> 4) * 2 + (c >> 5), rr = r & 15, cc = c & 31, ob = rr * 64 + cc * 2;
    return st * 1024 + (ob ^ (((ob >> 9) & 1) << 5));
}
__device__ __forceinline__ void stage_rc(int b, int& R, int& C) {
    const int st = b / 1024, sb = b % 1024, swz = sb ^ (((sb >> 9) & 1) << 5);
    R = (st >> 1) * 16 + swz / 64; C = (st & 1) * 32 + (swz % 64) / 2;
}
struct NoHook { __device__ __forceinline__ void operator()(int, f32x4 (&)[2][2][4][2]) const {} };
template <int LDA, int LDB, int KSEG = 0, class Hook = NoHook>
__device__ __forceinline__ void gemm256(const bf16_t* __restrict__ A, const bf16_t* __restrict__ Bt, const int K, const int brow, const int bcol,
                                        f32x4 (&acc)[2][2][4][2], LAS unsigned char* lds, const size_t segA = 0, const size_t segB = 0, const Hook hook = Hook()) {
    constexpr int BK = 64, HALF = 128, HTB = HALF * BK * 2;
    const int tid = opaque_tid(), wid = __builtin_amdgcn_readfirstlane(tid >> 6), lane = tid & 63, wr = wid >> 2, wc = wid & 3, fr = lane & 15, fq = lane >> 4;
    unsigned voffA[2], voffB[2];
#pragma unroll
    for (int i = 0; i < 2; ++i) { int R, C; stage_rc(tid * 16 + i * 8192, R, C); voffA[i] = (unsigned)(R * LDA + C) * 2u; voffB[i] = (unsigned)(R * LDB + C) * 2u; }
    const size_t kstep = (size_t)(BK * 2);
    const size_t hstepA = (size_t)HALF * LDA * 2, hstepB = (size_t)HALF * LDB * 2;
    const unsigned ldsw = (unsigned)wid * 1024u;
    const int aoff = lds_byte(wr * 64 + fr, fq * 8), boff = lds_byte(wc * 32 + fr, fq * 8);
    const char* cA = (const char*)(A + (size_t)brow * LDA);
    const char* cB = (const char*)(Bt + (size_t)bcol * LDB);
    auto pA = [&](int T) -> const char* { return KSEG ? cA + (size_t)(T / (KSEG ? KSEG : 1)) * segA + (size_t)(T % (KSEG ? KSEG : 1)) * kstep : cA + (size_t)T * kstep; };
    auto pB = [&](int T) -> const char* { return KSEG ? cB + (size_t)(T / (KSEG ? KSEG : 1)) * segB + (size_t)(T % (KSEG ? KSEG : 1)) * kstep : cB + (size_t)T * kstep; };
#define SA(b, h) (((b) * 2 + (h)) * HTB)
#define SB(b, h) ((4 + (b) * 2 + (h)) * HTB)
#define STAGE(bufoff, gbase, voff) do { _Pragma("unroll") for (int _i = 0; _i < 2; ++_i) \
        __builtin_amdgcn_global_load_lds((const unsigned*)((const char*)(gbase) + voff[_i]), (LAS unsigned*)(lds + (bufoff) + ldsw + _i * 8192), 16, 0, 0); } while (0)
#define LDA(dst, b, h) do { _Pragma("unroll") for (int m = 0; m < 4; ++m) _Pragma("unroll") for (int k = 0; k < 2; ++k) dst[m][k] = *(const LAS bf16x8*)(lds + SA(b, h) + aoff + m * 2048 + k * 1024); } while (0)
#define LDB(dst, b, h) do { _Pragma("unroll") for (int n = 0; n < 2; ++n) _Pragma("unroll") for (int k = 0; k < 2; ++k) dst[n][k] = *(const LAS bf16x8*)(lds + SB(b, h) + boff + n * 2048 + k * 1024); } while (0)
#define MMA(ai, bj, At, Bx) do { __builtin_amdgcn_s_setprio(1); _Pragma("unroll") for (int m = 0; m < 4; ++m) _Pragma("unroll") for (int n = 0; n < 2; ++n) _Pragma("unroll") for (int k = 0; k < 2; ++k) \
      acc[ai][bj][m][n] = __builtin_amdgcn_mfma_f32_16x16x32_bf16(At[m][k], Bx[n][k], acc[ai][bj][m][n], 0, 0, 0); \
    __builtin_amdgcn_s_setprio(0); } while (0)
#define WAIT_V(n) asm volatile("s_waitcnt vmcnt(" #n ")" ::: "memory")
#define WAIT_L(n) asm volatile("s_waitcnt lgkmcnt(" #n ")" ::: "memory")
#define BAR __builtin_amdgcn_s_barrier()
#define SCHED __builtin_amdgcn_sched_barrier(0)
#pragma unroll
    for (int a = 0; a < 2; a++)
#pragma unroll
        for (int b = 0; b < 2; b++)
#pragma unroll
            for (int m = 0; m < 4; m++)
#pragma unroll
                for (int n = 0; n < 2; n++) acc[a][b][m][n] = (f32x4){0.f, 0.f, 0.f, 0.f};
    bf16x8 At[4][2], B0[2][2], B1[2][2];
    const int nt = K / BK;
    WAIT_V(0); WAIT_L(0);
    __syncthreads();
    STAGE(SB(0, 0), cB, voffB); STAGE(SA(0, 0), cA, voffA); STAGE(SB(0, 1), cB + hstepB, voffB); STAGE(SA(0, 1), cA + hstepA, voffA);
    if (wr == 1) BAR;
    WAIT_V(4); BAR;
    STAGE(SB(1, 0), pB(1), voffB); STAGE(SA(1, 0), pA(1), voffA); STAGE(SB(1, 1), pB(1) + hstepB, voffB);
    WAIT_V(6); BAR;
    for (int t = 0; t < nt - 2; t += 2) {
        if (KSEG && t > 0 && (t % (KSEG ? KSEG : 1)) == 0) hook(t / (KSEG ? KSEG : 1), acc);
        const char* a1 = pA(t + 1); const char* a2 = pA(t + 2); const char* a3 = pA(t + 3);
        const char* b2 = pB(t + 2); const char* b3 = pB(t + 3);
        LDB(B0, 0, 0); SCHED; LDA(At, 0, 0); STAGE(SA(1, 1), a1 + hstepA, voffA);
        WAIT_L(8); BAR; WAIT_L(0); MMA(0, 0, At, B0); BAR; SCHED;
        LDB(B1, 0, 1); STAGE(SB(0, 0), b2, voffB);
        BAR; WAIT_L(0); MMA(0, 1, At, B1); BAR;
        LDA(At, 0, 1); STAGE(SA(0, 0), a2, voffA);
        BAR; WAIT_L(0); MMA(1, 0, At, B0); BAR; SCHED;
        STAGE(SB(0, 1), b2 + hstepB, voffB);
        WAIT_V(6); BAR; MMA(1, 1, At, B1); BAR;
        LDB(B0, 1, 0); SCHED; LDA(At, 1, 0); STAGE(SA(0, 1), a2 + hstepA, voffA);
        WAIT_L(8); BAR; WAIT_L(0); MMA(0, 0, At, B0); BAR; SCHED;
        LDB(B1, 1, 1); STAGE(SB(1, 0), b3, voffB);
        BAR; WAIT_L(0); MMA(0, 1, At, B1); BAR;
        LDA(At, 1, 1); STAGE(SA(1, 0), a3, voffA);
        BAR; WAIT_L(0); MMA(1, 0, At, B0); BAR; SCHED;
        STAGE(SB(1, 1), b3 + hstepB, voffB);
        WAIT_V(6); BAR; MMA(1, 1, At, B1); BAR;
    }
    { LDB(B0, 0, 0); LDA(At, 0, 0); STAGE(SA(1, 1), pA(nt - 1) + hstepA, voffA);
      BAR; WAIT_L(0); MMA(0, 0, At, B0); BAR;
      LDB(B1, 0, 1); BAR; WAIT_L(0); MMA(0, 1, At, B1); BAR;
      LDA(At, 0, 1); WAIT_V(4); BAR; WAIT_L(0); MMA(1, 0, At, B0); MMA(1, 1, At, B1); BAR; }
    { LDB(B0, 1, 0); LDA(At, 1, 0); WAIT_V(2); BAR; WAIT_L(0); MMA(0, 0, At, B0); BAR;
      LDB(B1, 1, 1); WAIT_V(0); BAR; WAIT_L(0); MMA(0, 1, At, B1); BAR;
      LDA(At, 1, 1); BAR; WAIT_L(0); MMA(1, 0, At, B0); MMA(1, 1, At, B1); BAR; }
    if (wr == 0) BAR;
#undef SA
#undef SB
#undef STAGE
#undef LDA
#undef LDB
#undef MMA
#undef WAIT_V
#undef WAIT_L
#undef BAR
#undef SCHED
}

template <bool PERMF = false, class F>
__device__ __forceinline__ void epi_store_rows(LAS unsigned char* lds, int wid, int lane2, int fr, int fq, int wc, int mt, bf16_t* dbase, size_t dld, F getpk) {
    LAS unsigned char* reg = lds + wid * 9216;
#pragma unroll
    for (int bj = 0; bj < 2; bj++)
#pragma unroll
        for (int n = 0; n < 2; n++)
#pragma unroll
            for (int m = 0; m < 4; m++) *(LAS u32x2*)(reg + ((bj * 2 + n) * 16 + fr) * LROW + (PERMF ? fq * 32 + m * 8 : fq * 8 + m * 32)) = getpk(bj, n, m);
#pragma unroll
    for (int i = 0; i < 8; i++) {
        const int c = lane2 + 64 * i, row = c >> 3, ch = c & 7;
        const u32x4 w = *(const LAS u32x4*)(reg + row * LROW + ch * 16);
        const int tk2 = mt * 256 + (row >> 5) * 128 + wc * 32 + (row & 31);
        *(u32x4*)(dbase + (size_t)tk2 * dld + ch * 8) = w;
    }
}

__device__ __forceinline__ void phase_gemm1(const Params& p, int layer, LAS unsigned char* lds) {
    const int tid = opaque_tid(), wid = __builtin_amdgcn_readfirstlane(tid >> 6), wr = wid >> 2, wc = wid & 3;
    const bf16_t* Wt = p.W1t() + (size_t)layer * N1 * DM;
    const bool lastl = (layer == NLAY - 1);
    const int nslots = lastl ? (1920 + 48) : 6 * 48 * 8;
    for (int L = blockIdx.x; L < nslots; L += gridDim.x) {
        int mt, nt;
        if (lastl && L >= 1920) {
            const int c = L - 1920, cp = c / 6, k = c - cp * 6;
            mt = cp * 9; nt = (k < 2) ? 2 + k : 6 + k;
        } else {
            const int xc = L & 7, q = L >> 3, pidx = q / 48, w = q - pidx * 48, gp = pidx * 8 + xc;
            if (gp >= 45) continue;
            const int pmp = gp / 5, pnp = gp - pmp * 5;
            const int pr = pmp * 8 + (w & 7);
            mt = lastl ? (pr >> 3) * 9 + 1 + (pr & 7) : pr;
            nt = pnp * 6 + (w >> 3);
        }
        const bool isV = (nt == 3) || (nt == 10) || (nt == 11);
        f32x4 acc[2][2][4][2];
        if (isV) {
            gemm256<DM, DM>(p.H(), Wt, DM, mt * 256, nt * 256, acc, lds);
            const int tid2 = opaque_tid(), lane2 = tid2 & 63, fr = lane2 & 15, fq = lane2 >> 4;
            const int tok0 = mt * 256; const int bl = tok0 / TT, t0 = tok0 - bl * TT;
            const int ppos = 8 * (fq & 1) + 4 * (fq >> 1);
            LAS unsigned char* vreg = lds + wid * 2304;
#pragma unroll
            for (int bj = 0; bj < 2; bj++)
#pragma unroll
                for (int n = 0; n < 2; n++)
#pragma unroll
                    for (int ai = 0; ai < 2; ai++) {
#pragma unroll
                        for (int m = 0; m < 4; m++) {
                            const f32x4 v = acc[ai][bj][m][n];
                            *(LAS u32x2*)(vreg + fr * LROW + m * 32 + ppos * 2) = (u32x2){pk2(v[0], v[1]), pk2(v[2], v[3])};
                        }
#pragma unroll
                        for (int i = 0; i < 2; i++) {
                            const int c = lane2 + 64 * i, r = c >> 3, ch = c & 7;
                            const int vcr = wc * 32 + n * 16 + r;
                            bf16_t* dr;
                            if (nt == 3) dr = (bj == 0 ? p.VtA() : p.VtC()) + ((size_t)(bl * 2 + (vcr >> 6)) * 64 + (vcr & 63)) * TT;
                            else { const int vc = (nt - 10) * 256 + bj * 128 + vcr; dr = p.VtB() + ((size_t)(bl * 4 + (vc >> 7)) * 128 + (vc & 127)) * TT; }
                            *(u32x4*)(dr + t0 + ai * 128 + wr * 64 + ch * 8) = *(const LAS u32x4*)(vreg + r * LROW + ch * 16);
                        }
                    }
        } else {
            gemm256<DM, DM>(Wt, p.H(), DM, nt * 256, mt * 256, acc, lds);
            const int tid2 = opaque_tid(), lane2 = tid2 & 63, fr = lane2 & 15, fq = lane2 >> 4;
#pragma unroll
            for (int ai = 0; ai < 2; ai++) {
                const int col0 = nb2ob(nt * 2 + ai) * 128 + wr * 64;
                int type;
                if (col0 < 512) type = 0; else if (col0 < 640) type = 1; else if (col0 < 1280) type = 3; else if (col0 < 2304) type = 2;
                else if (col0 < 3328) type = 3; else if (col0 < 3968) type = 2; else if (col0 < 4608) type = 3; else type = 4;
#pragma unroll
                for (int bj = 0; bj < 2; bj++)
#pragma unroll
                    for (int n = 0; n < 2; n++) {
                        const int tk = mt * 256 + bj * 128 + wc * 32 + n * 16 + fr;
                        const int bl = tk / TT, t = tk - bl * TT;
                        float v[4][4];
#pragma unroll
                        for (int m = 0; m < 4; m++)
#pragma unroll
                            for (int j = 0; j < 4; j++) v[m][j] = acc[ai][bj][m][n][j];
                        if (type <= 1) {
                            float ss = 0.f;
#pragma unroll
                            for (int m = 0; m < 4; m++)
#pragma unroll
                                for (int j = 0; j < 4; j++) ss += v[m][j] * v[m][j];
                            ss += __shfl_xor(ss, 16); ss += __shfl_xor(ss, 32);
                            const float rstd = rsqrtf(ss * (1.f / 64.f) + 1e-6f);
                            const float* gn = (type == 0 ? p.q_norm : p.k_norm) + layer * 64;
#pragma unroll
                            for (int m = 0; m < 4; m++) {
                                const float4 g4 = *(const float4*)(gn + m * 16 + fq * 4);
                                v[m][0] *= rstd * g4.x; v[m][1] *= rstd * g4.y; v[m][2] *= rstd * g4.z; v[m][3] *= rstd * g4.w;
                            }
                        }
                        if (type <= 2 && t >= CTXL) {
                            const int pos = t - CTXL;
#pragma unroll
                            for (int ax = 0; ax < 2; ax++) {
                                const int pp = (ax == 0) ? (pos >> 6) : (pos & 63);
                                const float4* rp = (const float4*)(p.ROPE() + (size_t)(pp * 16 + fq * 4) * 2);
                                const float4 c01 = rp[0], c23 = rp[1];
                                const float cs[4] = {c01.x, c01.z, c23.x, c23.z}, sn[4] = {c01.y, c01.w, c23.y, c23.w};
#pragma unroll
                                for (int j = 0; j < 4; j++) {
                                    const float x1 = v[2 * ax][j], x2 = v[2 * ax + 1][j];
                                    v[2 * ax][j] = x1 * cs[j] - x2 * sn[j];
                                    v[2 * ax + 1][j] = x2 * cs[j] + x1 * sn[j];
                                }
                            }
                        }
                        if (type == 3) {
#pragma unroll
                            for (int m = 0; m < 4; m++)
#pragma unroll
                                for (int j = 0; j < 4; j++) v[m][j] = silu_f(v[m][j]);
                        }
                        if (type == 4) {
                            const float* bm = p.b_mg + layer * 3072 + (col0 - INW);
#pragma unroll
                            for (int m = 0; m < 4; m++) {
                                const float4 b4 = *(const float4*)(bm + m * 16 + fq * 4);
                                v[m][0] = fmaxf(sigmoid_f(v[m][0] + b4.x), 5.96e-8f); v[m][1] = fmaxf(sigmoid_f(v[m][1] + b4.y), 5.96e-8f);
                                v[m][2] = fmaxf(sigmoid_f(v[m][2] + b4.z), 5.96e-8f); v[m][3] = fmaxf(sigmoid_f(v[m][3] + b4.w), 5.96e-8f);
                            }
                        }
                        if (type == 4) {
                            LAS unsigned char* srow = lds + wid * 9216 + ((bj * 2 + n) * 16 + fr) * 80 + fq * 4;
#pragma unroll
                            for (int m = 0; m < 4; m++) {
                                const unsigned q0 = (unsigned)fmaxf(__builtin_rintf(v[m][0] * 255.f), 1.f), q1 = (unsigned)fmaxf(__builtin_rintf(v[m][1] * 255.f), 1.f);
                                const unsigned q2 = (unsigned)fmaxf(__builtin_rintf(v[m][2] * 255.f), 1.f), q3 = (unsigned)fmaxf(__builtin_rintf(v[m][3] * 255.f), 1.f);
                                *(LAS unsigned*)(srow + m * 16) = q0 | (q1 << 8) | (q2 << 16) | (q3 << 24);
                            }
                        } else {
                        LAS unsigned char* srow = lds + wid * 9216 + ((bj * 2 + n) * 16 + fr) * LROW + fq * 8;
#pragma unroll
                        for (int m = 0; m < 4; m++)
                            *(LAS u32x2*)(srow + m * 32) = (u32x2){pk2(v[m][0], v[m][1]), pk2(v[m][2], v[m][3])};
                        }
                    }
                if (type == 4) {
                    unsigned char* dbase = (unsigned char*)p.G() + (col0 - INW);
#pragma unroll
                    for (int i = 0; i < 4; i++) {
                        const int c = lane2 + 64 * i, row = c >> 2, ch = c & 3;
                        const u32x4 w = *(const LAS u32x4*)(lds + wid * 9216 + row * 80 + ch * 16);
                        const int tk2 = mt * 256 + (row >> 5) * 128 + wc * 32 + (row & 31);
                        *(u32x4*)(dbase + (size_t)tk2 * 3072 + ch * 16) = w;
                    }
                } else {
                    bf16_t* dbase = p.PROJ() + col0;
                    const size_t dld = INW;
#pragma unroll
                    for (int i = 0; i < 8; i++) {
                        const int c = lane2 + 64 * i, row = c >> 3, ch = c & 7;
                        const u32x4 w = *(const LAS u32x4*)(lds + wid * 9216 + row * LROW + ch * 16);
                        const int tk2 = mt * 256 + (row >> 5) * 128 + wc * 32 + (row & 31);
                        *(u32x4*)(dbase + (size_t)tk2 * dld + ch * 8) = w;
                    }
                }
            }
        }
    }
}

template <int DV>
__device__ __forceinline__ void attn_tile(const unsigned char* Kl, const unsigned char* Vl, const bf16x8 (&qf)[4], f32x16 (&O)[DV / 32], float& m, float& l,
                                          int l31, int hh, bool domask, int qpos, int kpos0) {
    const float SL2 = 0.125f * LOG2E;
    const float THR = 8.f;
    f32x16 S[2];
#pragma unroll
    for (int sub = 0; sub < 2; sub++)
#pragma unroll
        for (int r = 0; r < 16; r++) S[sub][r] = 0.f;
#pragma unroll
    for (int kk = 0; kk < 4; kk++)
#pragma unroll
        for (int sub = 0; sub < 2; sub++) {
            const bf16x8 kf = *(const bf16x8*)(Kl + (sub * 32 + l31) * LROW + kk * 32 + hh * 16);
            S[sub] = MFMA(kf, qf[kk], S[sub]);
        }
    if (domask) {
#pragma unroll
        for (int sub = 0; sub < 2; sub++)
#pragma unroll
            for (int r = 0; r < 16; r++) {
                const int d = qpos - (kpos0 + sub * 32 + (r & 3) + 8 * (r >> 2) + 4 * hh);
                S[sub][r] = (d <= 128 && d >= -128) ? S[sub][r] : -1e30f;
            }
    }
    float mx = S[0][0];
#pragma unroll
    for (int sub = 0; sub < 2; sub++)
#pragma unroll
        for (int r = 0; r < 16; r++) mx = fmaxf(mx, S[sub][r]);
    mx = fmaxf(mx, __shfl_xor(mx, 32));
    const float mxs = mx * SL2;
    if (__any(mxs > m + THR)) {
        const float mnew = fmaxf(m, mxs);
        const float alpha = __builtin_amdgcn_exp2f(m - mnew);
        m = mnew; l *= alpha;
#pragma unroll
        for (int dt = 0; dt < DV / 32; dt++)
#pragma unroll
            for (int r = 0; r < 16; r++) O[dt][r] *= alpha;
    }
    float ps = 0.f;
#pragma unroll
    for (int sub = 0; sub < 2; sub++)
#pragma unroll
        for (int r = 0; r < 16; r++) { S[sub][r] = __builtin_amdgcn_exp2f(__builtin_fmaf(S[sub][r], SL2, -m)); ps += S[sub][r]; }
    l += ps;
    bf16x8 pb[2][2];
#pragma unroll
    for (int sub = 0; sub < 2; sub++)
#pragma unroll
        for (int s = 0; s < 2; s++) {
            u32x4 cv;
            cv[0] = pk2(S[sub][8 * s + 0], S[sub][8 * s + 1]); cv[1] = pk2(S[sub][8 * s + 2], S[sub][8 * s + 3]);
            cv[2] = pk2(S[sub][8 * s + 4], S[sub][8 * s + 5]); cv[3] = pk2(S[sub][8 * s + 6], S[sub][8 * s + 7]);
            pb[sub][s] = __builtin_bit_cast(bf16x8, cv);
        }
#pragma unroll
    for (int sub = 0; sub < 2; sub++)
#pragma unroll
        for (int s = 0; s < 2; s++)
#pragma unroll
            for (int dt = 0; dt < DV / 32; dt++) {
                const bf16x8 vf = *(const bf16x8*)(Vl + (dt * 32 + l31) * LROW + (sub * 4 + s * 2 + hh) * 16);
                O[dt] = MFMA(vf, pb[sub][s], O[dt]);
            }
}

template <bool DIFF>
__device__ __forceinline__ void attn_unit(const Params& p, int layer, int mode, int bl, int hidx, int qblk, bool isctx, unsigned char* lds) {
    constexpr int DV = DIFF ? 128 : 64;
    constexpr int NKM = DIFF ? 2 : 1;
    constexpr int KBYTES = NKM * 9216, VBYTES = DV * LROW, BUFB = KBYTES + VBYTES;
    const int tid = opaque_tid(), lane = tid & 63, wave = __builtin_amdgcn_readfirstlane(tid >> 6), l31 = lane & 31, hh = lane >> 5;
    int qcol, kcol, gcol, ucol, tq, head = 0, cm = 0, qs = 0;
    const bf16_t* vt;
    int qpos;
    if (DIFF) {
        cm = wave & 1; qs = wave >> 1;
        qcol = 1280 + hidx * 128 + cm * 64; kcol = 1792 + hidx * 128; gcol = 2816 + hidx * 128; ucol = NTC * 512 + hidx * 128;
        vt = p.VtB() + (size_t)(bl * 4 + hidx) * 128 * TT;
        qpos = qblk * 128 + qs * 32 + l31;
        tq = bl * TT + (isctx ? 0 : CTXL) + qpos;
    } else {
        head = hidx * 4 + (wave & 3);
        qpos = qblk * 64 + (wave >> 2) * 32 + l31;
        if (mode == 0) { qcol = head * 64; kcol = 512 + hidx * 64; gcol = 768 + head * 64; ucol = head * 64; vt = p.VtA() + (size_t)(bl * 2 + hidx) * 64 * TT; }
        else { qcol = 3328 + head * 64; kcol = 3840 + hidx * 64; gcol = 4096 + head * 64; ucol = 2 * NTC * 512 + head * 64; vt = p.VtC() + (size_t)(bl * 2 + hidx) * 64 * TT; }
        tq = bl * TT + (isctx ? 0 : CTXL) + qpos;
    }
    const bool win = (!DIFF) && (mode == 2) && !isctx;
    int n2, start2;
    if (isctx) { n2 = 0; start2 = 0; }
    else if (win) { const int q0 = qblk * 64; int lo = q0 - 128; if (lo < 0) lo = 0; int hi = q0 + 192; if (hi > SEQ) hi = SEQ; n2 = (hi - lo) >> 6; start2 = CTXL + lo; }
    else { n2 = 32; start2 = CTXL; }
    const int ntile = 4 + n2;

    const bf16_t* kp = p.PROJ() + (size_t)(bl * TT) * INW + kcol;
    const int lr = tid >> 3, lc = tid & 7;
    u32x4 kr[NKM], vr[DV / 64];
    bf16x8 qf[4];
    {
        unsigned char* qreg = lds + 73728 + wave * 4608;
        const int tqb = tq - l31;
#pragma unroll
        for (int i = 0; i < 4; i++) {
            const int c = lane + 64 * i, row = c >> 3, ch = c & 7;
            *(u32x4*)(qreg + row * LROW + ch * 16) = *(const u32x4*)(p.PROJ() + (size_t)(tqb + row) * INW + qcol + ch * 8);
        }
#pragma unroll
        for (int kk = 0; kk < 4; kk++) qf[kk] = *(const bf16x8*)(qreg + l31 * LROW + kk * 32 + hh * 16);
    }
    f32x16 O[DV / 32];
#pragma unroll
    for (int dt = 0; dt < DV / 32; dt++)
#pragma unroll
        for (int r = 0; r < 16; r++) O[dt][r] = 0.f;
    float m = -1e30f, l = 0.f;

    {
        const int t0 = 0;
#pragma unroll
        for (int i = 0; i < NKM; i++) kr[i] = *(const u32x4*)(kp + (size_t)(t0 + lr) * INW + i * 64 + lc * 8);
#pragma unroll
        for (int i = 0; i < DV / 64; i++) vr[i] = *(const u32x4*)(vt + (size_t)(lr + i * 64) * TT + t0 + lc * 8);
    }
    __syncthreads();
    {
        unsigned char* wb = lds + lr * LROW + lc * 16;
#pragma unroll
        for (int i = 0; i < NKM; i++) *(u32x4*)(wb + i * 9216) = kr[i];
#pragma unroll
        for (int i = 0; i < DV / 64; i++) *(u32x4*)(wb + KBYTES + i * 64 * LROW) = vr[i];
    }
    __syncthreads();
    for (int it = 0; it < ntile; it++) {
        const unsigned char* cur = lds + (it & 1) * BUFB;
        const bool more = (it + 1 < ntile);
        if (more) {
            const int t0 = (it + 1 < 4) ? (it + 1) * 64 : start2 + (it + 1 - 4) * 64;
#pragma unroll
            for (int i = 0; i < NKM; i++) kr[i] = *(const u32x4*)(kp + (size_t)(t0 + lr) * INW + i * 64 + lc * 8);
#pragma unroll
            for (int i = 0; i < DV / 64; i++) vr[i] = *(const u32x4*)(vt + (size_t)(lr + i * 64) * TT + t0 + lc * 8);
        }
        const int tcur = (it < 4) ? it * 64 : start2 + (it - 4) * 64;
        attn_tile<DV>(cur + cm * 9216, cur + KBYTES, qf, O, m, l, l31, hh, win && (it >= 4), qpos, tcur - CTXL);
        if (more) {
            unsigned char* wb = lds + ((it + 1) & 1) * BUFB + lr * LROW + lc * 16;
#pragma unroll
            for (int i = 0; i < NKM; i++) *(u32x4*)(wb + i * 9216) = kr[i];
#pragma unroll
            for (int i = 0; i < DV / 64; i++) *(u32x4*)(wb + KBYTES + i * 64 * LROW) = vr[i];
        }
        __syncthreads();
    }
    float lt = l + __shfl_xor(l, 32);
    if (DIFF) {
        const float inv = 1.f / lt;
        float* xb = (float*)lds + qs * 128 * 32;
        if (cm == 1) {
#pragma unroll
            for (int dt = 0; dt < DV / 32; dt++)
#pragma unroll
                for (int r = 0; r < 16; r++) xb[(dt * 32 + (r & 3) + 8 * (r >> 2) + 4 * hh) * 32 + l31] = O[dt][r] * inv;
        }
        __syncthreads();
        if (cm == 0) {
            const float lam = p.LAM()[layer];
            const float om = 1.f - lam_init_of(layer);
            float ss = 0.f;
#pragma unroll
            for (int dt = 0; dt < DV / 32; dt++)
#pragma unroll
                for (int r = 0; r < 16; r++) {
                    const float o = O[dt][r] * inv - lam * xb[(dt * 32 + (r & 3) + 8 * (r >> 2) + 4 * hh) * 32 + l31];
                    O[dt][r] = o; ss += o * o;
                }
            ss += __shfl_xor(ss, 32);
            const float rstd = rsqrtf(ss * (1.f / 128.f) + 1e-5f) * om;
            unsigned char* sreg = lds + 65536 + wave * 9216;
            constexpr int RS = DV * 2 + 16, CPR = DV / 8;
            const int lane_e = opaque_tid() & 63;
            const int tqb = tq - l31;
#pragma unroll
            for (int i = 0; i < DV / 16; i++) {
                const int c = lane_e + 64 * i, row = c / CPR, ch = c % CPR;
                *(u32x4*)(sreg + row * RS + ch * 16) = *(const u32x4*)(p.PROJ() + (size_t)(tqb + row) * INW + gcol + ch * 8);
            }
#pragma unroll
            for (int dt = 0; dt < DV / 32; dt++)
#pragma unroll
                for (int rg = 0; rg < 4; rg++) {
                    const int d0 = dt * 32 + rg * 8 + hh * 4;
                    const float4 sg = *(const float4*)(p.subln + layer * 128 + d0);
                    u32x2* sp = (u32x2*)(sreg + l31 * RS + d0 * 2);
                    const u32x2 gw = *sp;
                    const float o0 = O[dt][rg * 4 + 0] * rstd * sg.x * bflo(gw[0]), o1 = O[dt][rg * 4 + 1] * rstd * sg.y * bfhi(gw[0]);
                    const float o2 = O[dt][rg * 4 + 2] * rstd * sg.z * bflo(gw[1]), o3 = O[dt][rg * 4 + 3] * rstd * sg.w * bfhi(gw[1]);
                    *sp = (u32x2){pk2(o0, o1), pk2(o2, o3)};
                }
#pragma unroll
            for (int i = 0; i < DV / 16; i++) {
                const int c = lane_e + 64 * i, row = c / CPR, ch = c % CPR;
                *(u32x4*)(p.U() + (size_t)(tqb + row) * 512 + ucol + ch * 8) = *(const u32x4*)(sreg + row * RS + ch * 16);
            }
        }
    } else {
        float a = 1.f;
        if (mode == 2) {
            const float s2 = p.sink[layer * 8 + head] * LOG2E;
            const float mf = fmaxf(m, s2);
            a = __builtin_amdgcn_exp2f(m - mf);
            lt = lt * a + __builtin_amdgcn_exp2f(s2 - mf);
        }
        const float inv = a / lt;
        unsigned char* sreg = lds + 65536 + wave * 9216;
        constexpr int RS = DV * 2 + 16, CPR = DV / 8;
        const int lane_e = opaque_tid() & 63;
        const int tqb = tq - l31;
#pragma unroll
        for (int i = 0; i < DV / 16; i++) {
            const int c = lane_e + 64 * i, row = c / CPR, ch = c % CPR;
            *(u32x4*)(sreg + row * RS + ch * 16) = *(const u32x4*)(p.PROJ() + (size_t)(tqb + row) * INW + gcol + ch * 8);
        }
#pragma unroll
        for (int dt = 0; dt < DV / 32; dt++)
#pragma unroll
            for (int rg = 0; rg < 4; rg++) {
                const int d0 = dt * 32 + rg * 8 + hh * 4;
                u32x2* sp = (u32x2*)(sreg + l31 * RS + d0 * 2);
                const u32x2 gw = *sp;
                const float o0 = O[dt][rg * 4 + 0] * inv * bflo(gw[0]), o1 = O[dt][rg * 4 + 1] * inv * bfhi(gw[0]);
                const float o2 = O[dt][rg * 4 + 2] * inv * bflo(gw[1]), o3 = O[dt][rg * 4 + 3] * inv * bfhi(gw[1]);
                *sp = (u32x2){pk2(o0, o1), pk2(o2, o3)};
            }
#pragma unroll
        for (int i = 0; i < DV / 16; i++) {
            const int c = lane_e + 64 * i, row = c / CPR, ch = c % CPR;
            *(u32x4*)(p.U() + (size_t)(tqb + row) * 512 + ucol + ch * 8) = *(const u32x4*)(sreg + row * RS + ch * 16);
        }
    }
}

__device__ __forceinline__ void phase_attn(const Params& p, int layer, unsigned char* lds) {
    const int nunits = 1536 + ((layer < NLAY - 1) ? 192 : 0);
    for (int u = blockIdx.x; u < nunits; u += gridDim.x) {
        int mode, bl, hidx, qb; bool isctx;
        if (u < 512) { const int x = u & 7, rest = u >> 3; qb = rest & 15; const int combo = (rest >> 4) * 8 + x; mode = 1; bl = combo >> 2; hidx = combo & 3; isctx = false; }
        else if (u < 1536) { const int u2 = (u - 512) & 511; const int x = u2 & 7, rest = u2 >> 3; qb = rest & 31; const int combo = (rest >> 5) * 8 + x;
            mode = (u < 1024) ? 0 : 2; bl = combo >> 1; hidx = combo & 1; isctx = false; }
        else if (u < 1600) { const int u2 = u - 1536; qb = u2 & 1; const int combo = u2 >> 1; mode = 1; bl = combo >> 2; hidx = combo & 3; isctx = true; }
        else { const int u2 = (u - 1600) & 63; qb = u2 & 3; const int combo = u2 >> 2; mode = (u < 1664) ? 0 : 2; bl = combo >> 1; hidx = combo & 1; isctx = true; }
        __syncthreads();
        if (mode == 1) attn_unit<true>(p, layer, mode, bl, hidx, qb, isctx, lds);
        else attn_unit<false>(p, layer, mode, bl, hidx, qb, isctx, lds);
    }
}

__device__ __forceinline__ float ub(unsigned w, int j) { return (float)((w >> (8 * j)) & 0xffu); }
struct GateHook {
    const unsigned char* G; int tok0, feat0;
    __device__ __forceinline__ void operator()(int seg, f32x4 (&acc)[2][2][4][2]) const {
        const int tid2 = opaque_tid(), lane2 = tid2 & 63, wid2 = __builtin_amdgcn_readfirstlane(tid2 >> 6), wr = wid2 >> 2, wc = wid2 & 3, fr = lane2 & 15, fq = lane2 >> 4;
#pragma unroll
        for (int bj = 0; bj < 2; bj++)
#pragma unroll
            for (int n = 0; n < 2; n++) {
                const int tk = tok0 + bj * 128 + wc * 32 + n * 16 + fr;
                const unsigned char* gprev = G + (size_t)tk * 3072 + (seg - 1) * 1024 + feat0 + wr * 64 + fq * 16;
#pragma unroll
                for (int ai = 0; ai < 2; ai++) {
                    const u32x4 gp = *(const u32x4*)(gprev + ai * 128), gn = *(const u32x4*)(gprev + 1024 + ai * 128);
#pragma unroll
                    for (int m = 0; m < 4; m++) {
                        f32x4& v = acc[ai][bj][m][n];
                        v[0] *= ub(gp[m], 0) * __builtin_amdgcn_rcpf(ub(gn[m], 0)); v[1] *= ub(gp[m], 1) * __builtin_amdgcn_rcpf(ub(gn[m], 1));
                        v[2] *= ub(gp[m], 2) * __builtin_amdgcn_rcpf(ub(gn[m], 2)); v[3] *= ub(gp[m], 3) * __builtin_amdgcn_rcpf(ub(gn[m], 3));
                    }
                }
            }
    }
};

__device__ __forceinline__ void phase_gemm2(const Params& p, int layer, LAS unsigned char* lds) {
    const int tid = opaque_tid(), wid = __builtin_amdgcn_readfirstlane(tid >> 6), wr = wid >> 2, wc = wid & 3;
    const int ntiles = (layer == NLAY - 1) ? 256 : 288;
    for (int L = blockIdx.x; L < ntiles; L += gridDim.x) {
        const int mt = panel_of(L >> 2), nt = L & 3;
        f32x4 acc[2][2][4][2];
        GateHook hk; hk.G = (const unsigned char*)p.G(); hk.tok0 = mt * 256; hk.feat0 = nt * 256;
        gemm256<512, 512, 8, GateHook>(p.Wbrt() + (size_t)(layer * 3) * DM * 512, p.U(), 1536, nt * 256, mt * 256, acc, lds,
                                       (size_t)DM * 512 * 2, (size_t)NTC * 512 * 2, hk);
        const int tid2 = opaque_tid(), lane2 = tid2 & 63, fr = lane2 & 15, fq = lane2 >> 4;
#pragma unroll
        for (int ai = 0; ai < 2; ai++) {
            const int f0 = nt * 256 + ai * 128 + wr * 64;
            epi_store_rows<true>(lds, wid, lane2, fr, fq, wc, mt, p.Mb() + f0, DM, [&](int bj, int n, int m) -> u32x2 {
                const int tk = mt * 256 + bj * 128 + wc * 32 + n * 16 + fr;
                const unsigned gw = *(const unsigned*)((const unsigned char*)p.G() + (size_t)tk * 3072 + 2048 + f0 + fq * 16 + m * 4);
                const f32x4 v = acc[ai][bj][m][n] * (1.f / 255.f);
                return (u32x2){pk2(v[0] * ub(gw, 0), v[1] * ub(gw, 1)), pk2(v[2] * ub(gw, 2), v[3] * ub(gw, 3))};
            });
        }
        asm volatile("s_waitcnt vmcnt(0)" ::: "memory");
        __syncthreads();
        if (threadIdx.x == 0) {
            __builtin_amdgcn_fence(__ATOMIC_RELEASE, "agent");
            asm volatile("s_waitcnt vmcnt(0)" ::: "memory");
            xb_add(&p.BAR()[G23_PC(mt)], 1u);
        }
    }
}

__device__ __forceinline__ void phase_gemm3(const Params& p, int layer, int inst, LAS unsigned char* lds, volatile LAS unsigned* bst) {
    const int tid = opaque_tid(), wid = __builtin_amdgcn_readfirstlane(tid >> 6), wr = wid >> 2, wc = wid & 3;
    const unsigned nvalid = (layer == NLAY - 1) ? 256u : 288u;
    for (;;) {
        __syncthreads();
        if (threadIdx.x == 0) {
            const unsigned tk = xb_add(&p.BAR()[G23_TK], 1u) - (544u * (unsigned)inst - (inst > 3 ? 32u : 0u));
            if (tk < nvalid) {
                const int pmt = panel_of((int)(tk >> 2));
                unsigned* pc = &p.BAR()[G23_PC(pmt)];
                const unsigned want = panel_want(pmt, inst);
                XB_SPIN_SLOW(xb_ld(pc) < want, p.BAR());
                __builtin_amdgcn_fence(__ATOMIC_ACQUIRE, "agent");
                asm volatile("s_waitcnt vmcnt(0)" ::: "memory");
            }
            bst[2] = tk;
        }
        __syncthreads();
        const unsigned L = (unsigned)__builtin_amdgcn_readfirstlane((int)bst[2]);
        if (L >= nvalid) break;
        const int mt = panel_of((int)(L >> 2)), nt = (int)(L & 3u);
        f32x4 acc[2][2][4][2];
        gemm256<DM, DM>(p.Woutt() + (size_t)layer * DM * DM, p.Mb(), DM, nt * 256, mt * 256, acc, lds);
        const int tid2 = opaque_tid(), lane2 = tid2 & 63, fr = lane2 & 15, fq = lane2 >> 4;
#pragma unroll
        for (int ai = 0; ai < 2; ai++)
            epi_store_rows(lds, wid, lane2, fr, fq, wc, mt, (bf16_t*)p.Y() + nt * 256 + ai * 128 + wr * 64, DM, [&](int bj, int n, int m) -> u32x2 {
                const f32x4 v = acc[ai][bj][m][n];
                return (u32x2){pk2(v[0], v[1]), pk2(v[2], v[3])};
            });
        asm volatile("s_waitcnt vmcnt(0)" ::: "memory");
        __syncthreads();
        if (threadIdx.x == 0) {
            __builtin_amdgcn_fence(__ATOMIC_RELEASE, "agent");
            asm volatile("s_waitcnt vmcnt(0)" ::: "memory");
            xb_add(&p.BAR()[G23_PC2(mt)], 1u);
        }
    }
}

__global__ void __launch_bounds__(512, 2) fwd_kernel(Params p) {
    extern __shared__ __attribute__((aligned(16))) unsigned char lds[];
    cg::grid_group grid = cg::this_grid();
    volatile LAS unsigned* bst = (volatile LAS unsigned*)((LAS unsigned char*)lds + LDS_BYTES);
    if (threadIdx.x == 0) { bst[0] = 0u; bst[1] = 0u; }
    __syncthreads();
    (void)xcd_barrier_post(p.BAR(), bst);
    phase_pro_a(p, lds);
    grid.sync();
    phase_pro_b(p);
    xcd_barrier(p.BAR(), bst);
    for (int chunk = 0; chunk < NB / CB; chunk++) {
        if (chunk == 0) {
            phase_norm(p, chunk, -1);
            xcd_barrier(p.BAR(), bst);
        }
        for (int layer = 0; layer < NLAY; layer++) {
            phase_gemm1(p, layer, (LAS unsigned char*)lds);
            xcd_barrier(p.BAR(), bst);
            phase_attn(p, layer, lds);
            xcd_barrier(p.BAR(), bst);
            phase_gemm2(p, layer, (LAS unsigned char*)lds);
            phase_gemm3(p, layer, chunk * NLAY + layer, (LAS unsigned char*)lds, bst);
            phase_norm_ticketed(p, chunk, layer, chunk * NLAY + layer, bst);
            if (layer == NLAY - 1 && chunk + 1 < NB / CB) phase_norm0_ticketed(p, chunk + 1, bst);
            xcd_barrier(p.BAR(), bst);
        }
    }
}

extern "C" void kernel_launch(void* const* d_in, const int* in_sizes, int n_in, void* d_out, int out_size, void* d_ws, size_t ws_size, hipStream_t stream) {
    static int grid_blocks = 0;
    if (!grid_blocks) {
        int dev = 0, cus = 0, per_cu = 0;
        hipGetDevice(&dev);
        hipDeviceGetAttribute(&cus, hipDeviceAttributeMultiprocessorCount, dev);
        hipFuncSetAttribute((const void*)fwd_kernel, hipFuncAttributeMaxDynamicSharedMemorySize, LDS_BYTES + 16);
        hipOccupancyMaxActiveBlocksPerMultiprocessor(&per_cu, (const void*)fwd_kernel, NTHR, LDS_BYTES + 16);
        if (per_cu < 1) per_cu = 1;
        if (per_cu > 1) per_cu = 1;
        grid_blocks = cus * per_cu;
    }
    Params p{};
    const float* const* in = (const float* const*)d_in;
    p.x = in[0]; p.c = in[1]; p.ctx = in[2]; p.c_ctx = in[3]; p.w_ada = in[4]; p.b_ada = in[5]; p.g_pre = in[6]; p.g_post = in[7];
    p.w_in = in[8]; p.q_norm = in[9]; p.k_norm = in[10]; p.lam_q1 = in[11]; p.lam_k1 = in[12]; p.lam_q2 = in[13]; p.lam_k2 = in[14];
    p.subln = in[15]; p.sink = in[16]; p.w_br_a = in[17]; p.w_br_b = in[18]; p.w_br_c = in[19]; p.w_mg = in[20]; p.b_mg = in[21]; p.w_out = in[22];
    p.out = (float*)d_out;
    p.ws = (unsigned char*)d_ws;
    if (WS_END > ws_size) { fprintf(stderr, "kernel_launch: workspace too small: need %zu, have %zu\n", (size_t)WS_END, ws_size); return; }
    hipMemsetAsync((unsigned char*)d_ws + OFF_BAR, 0, ALL_BAR_WORDS * 4, stream);
    void* args[] = {&p};
    hipError_t e = hipLaunchCooperativeKernel((void*)fwd_kernel, dim3(grid_blocks), dim3(NTHR), args, LDS_BYTES + 16, stream);
    if (e != hipSuccess) fprintf(stderr, "cooperative launch failed: %s (grid %d)\n", hipGetErrorString(e), grid_blocks);
}
```

```cpp
#include <hip/hip_runtime.h>
#include <hip/hip_cooperative_groups.h>
#include <cstdio>
#include <cstdint>
namespace cg = cooperative_groups;

typedef unsigned short bf16_t;
typedef short bf16x8 __attribute__((ext_vector_type(8)));
typedef float f32x16 __attribute__((ext_vector_type(16)));
typedef unsigned u32x4 __attribute__((ext_vector_type(4)));
typedef float f32x4 __attribute__((ext_vector_type(4)));
typedef unsigned u32x2 __attribute__((ext_vector_type(2)));

constexpr int NB = 16, SEQ = 2048, CTXL = 256, TT = 2304, DM = 1024, NLAY = 4, INW = 4608, N1 = 7680;
constexpr int CB = 8, NTC = CB * TT;
constexpr int LDS_BYTES = 147456;
constexpr int NTHR = 512;
constexpr int LROW = 144;
constexpr float LOG2E = 1.4426950408889634f;

#define MFMA(a, b, c) __builtin_amdgcn_mfma_f32_32x32x16_bf16((a), (b), (c), 0, 0, 0)

constexpr size_t al256(size_t x) { return (x + 255) & ~(size_t)255; }
constexpr size_t OFF_W1T = 0;
constexpr size_t OFF_WBRT = OFF_W1T + al256((size_t)NLAY * N1 * DM * 2);
constexpr size_t OFF_WOUTT = OFF_WBRT + al256((size_t)NLAY * 3 * DM * 512 * 2);
constexpr size_t OFF_MODP = OFF_WOUTT + al256((size_t)NLAY * DM * DM * 2);
constexpr size_t OFF_MOD = OFF_MODP + al256((size_t)8 * NLAY * 17 * 3072 * 4);
constexpr size_t OFF_ROPE = OFF_MOD + al256((size_t)NLAY * 17 * 3072 * 4);
constexpr size_t OFF_LAM = OFF_ROPE + al256(64 * 16 * 2 * 4);
constexpr size_t OFF_BAR = OFF_LAM + 256;
constexpr size_t OFF_CX = OFF_BAR + al256((size_t)16384 * 4);
constexpr size_t OFF_H = OFF_CX + al256((size_t)NB * CTXL * DM * 4);
constexpr size_t OFF_U = OFF_H + al256((size_t)NTC * DM * 2);
constexpr size_t OFF_PROJ = OFF_U + al256((size_t)NTC * 1536 * 2);
constexpr size_t OFF_VTA = OFF_PROJ + al256((size_t)NTC * INW * 2);
constexpr size_t OFF_VTB = OFF_VTA + al256((size_t)CB * 2 * 64 * TT * 2);
constexpr size_t OFF_VTC = OFF_VTB + al256((size_t)CB * 4 * 128 * TT * 2);
constexpr size_t OFF_G = OFF_VTC + al256((size_t)CB * 2 * 64 * TT * 2);
constexpr size_t WS_END = OFF_G + al256((size_t)NTC * 3072 * 2);
constexpr size_t OFF_MB = OFF_PROJ;
constexpr size_t OFF_Y = OFF_PROJ + (size_t)NTC * DM * 2;

struct Params {
    const float *x, *c, *ctx, *c_ctx, *w_ada, *b_ada, *g_pre, *g_post, *w_in, *q_norm, *k_norm;
    const float *lam_q1, *lam_k1, *lam_q2, *lam_k2, *subln, *sink, *w_br_a, *w_br_b, *w_br_c, *w_mg, *b_mg, *w_out;
    float* out;
    unsigned char* ws;
    __device__ __forceinline__ bf16_t* W1t() const { return (bf16_t*)(ws + OFF_W1T); }
    __device__ __forceinline__ bf16_t* Wbrt() const { return (bf16_t*)(ws + OFF_WBRT); }
    __device__ __forceinline__ bf16_t* Woutt() const { return (bf16_t*)(ws + OFF_WOUTT); }
    __device__ __forceinline__ float* MODP() const { return (float*)(ws + OFF_MODP); }
    __device__ __forceinline__ float* MOD() const { return (float*)(ws + OFF_MOD); }
    __device__ __forceinline__ float* ROPE() const { return (float*)(ws + OFF_ROPE); }
    __device__ __forceinline__ float* LAM() const { return (float*)(ws + OFF_LAM); }
    __device__ __forceinline__ unsigned* BAR() const { return (unsigned*)(ws + OFF_BAR); }
    __device__ __forceinline__ float* CX() const { return (float*)(ws + OFF_CX); }
    __device__ __forceinline__ bf16_t* H() const { return (bf16_t*)(ws + OFF_H); }
    __device__ __forceinline__ bf16_t* U() const { return (bf16_t*)(ws + OFF_U); }
    __device__ __forceinline__ bf16_t* PROJ() const { return (bf16_t*)(ws + OFF_PROJ); }
    __device__ __forceinline__ bf16_t* VtA() const { return (bf16_t*)(ws + OFF_VTA); }
    __device__ __forceinline__ bf16_t* VtB() const { return (bf16_t*)(ws + OFF_VTB); }
    __device__ __forceinline__ bf16_t* VtC() const { return (bf16_t*)(ws + OFF_VTC); }
    __device__ __forceinline__ bf16_t* G() const { return (bf16_t*)(ws + OFF_G); }
    __device__ __forceinline__ bf16_t* Mb() const { return (bf16_t*)(ws + OFF_MB); }
    __device__ __forceinline__ float* Y() const { return (float*)(ws + OFF_Y); }
};

typedef __bf16 bf16x2_t __attribute__((ext_vector_type(2)));
typedef float f32x2_t __attribute__((ext_vector_type(2)));
__device__ __forceinline__ unsigned pk2(float lo, float hi) { const f32x2_t f = {lo, hi}; const bf16x2_t b = __builtin_convertvector(f, bf16x2_t); return __builtin_bit_cast(unsigned, b); }
__device__ __forceinline__ float bflo(unsigned w) { return __uint_as_float(w << 16); }
__device__ __forceinline__ float bfhi(unsigned w) { return __uint_as_float(w & 0xffff0000u); }
__device__ __forceinline__ float sigmoid_f(float v) { return __builtin_amdgcn_rcpf(1.f + __builtin_amdgcn_exp2f(-LOG2E * v)); }
__device__ __forceinline__ float silu_f(float v) { return v * sigmoid_f(v); }
__device__ __forceinline__ float wave_sum(float v) {
    v += __shfl_xor(v, 32); v += __shfl_xor(v, 16); v += __shfl_xor(v, 8); v += __shfl_xor(v, 4); v += __shfl_xor(v, 2); v += __shfl_xor(v, 1); return v;
}
__device__ __forceinline__ int opaque_tid() { int t = threadIdx.x; asm volatile("" : "+v"(t)); return t; }
__device__ __forceinline__ float lam_init_of(int l) { return 0.8f - 0.6f * expf(-0.3f * (float)l); }


#define XB_TMO      128
#define XB_XCNT(j)  (256  + 64 * (j))
#define XB_XSUB(j)  (1280 + 64 * (j))
#define XB_XGEN(j)  (2304 + 64 * (j))
#define XB_TOP      3328
#define XB_TOPGEN   3392
#define XCD_BAR_WORDS 3456
#define G23_PC(mt)   (XCD_BAR_WORDS + 64 * (mt))
#define G23_TK       (XCD_BAR_WORDS + 64 * 72)
#define G23_PC2(mt)  (XCD_BAR_WORDS + 64 * 73 + 64 * (mt))
#define G23_TK2      (XCD_BAR_WORDS + 64 * 145)
#define ALL_BAR_WORDS (XCD_BAR_WORDS + 64 * 146)
#define XB_SPIN_CAP (1u << 18)
#define LAS __attribute__((address_space(3)))
__device__ __forceinline__ unsigned xb_ld(unsigned* p)              { return __hip_atomic_load(p, __ATOMIC_RELAXED, __HIP_MEMORY_SCOPE_AGENT); }
__device__ __forceinline__ unsigned xb_add(unsigned* p, unsigned v) { return __hip_atomic_fetch_add(p, v, __ATOMIC_RELAXED, __HIP_MEMORY_SCOPE_AGENT); }
__device__ __forceinline__ unsigned xb_xcc_id() { return (unsigned)__builtin_amdgcn_s_getreg((3 << 11) | 20) & 0xFu; }
#define XB_SPIN(cond, bar) do { unsigned _sp = 0; while (cond) { __builtin_amdgcn_s_sleep(1); \
    if ((++_sp & 255u) == 0u) { if (xb_ld(&(bar)[XB_TMO])) break; if (_sp > XB_SPIN_CAP) { atomicAdd(&(bar)[XB_TMO], 1u); break; } } } } while (0)
#define XB_SPIN_SLOW(cond, bar) do { unsigned _sp = 0; while (cond) { __builtin_amdgcn_s_sleep(32); \
    if ((++_sp & 63u) == 0u) { if (xb_ld(&(bar)[XB_TMO])) break; if (_sp > (1u << 17)) { atomicAdd(&(bar)[XB_TMO], 1u); break; } } } } while (0)
struct XcdBarrier { unsigned* bar; unsigned x; volatile LAS unsigned* st; };
__device__ __forceinline__ XcdBarrier xcd_barrier_post(unsigned* bar, volatile LAS unsigned* st) {
    XcdBarrier b; b.bar = bar; b.x = xb_xcc_id(); b.st = st;
    if (threadIdx.x == 0) (void)xb_add(&bar[XB_XCNT(b.x)], 1u);
    return b;
}
__device__ __forceinline__ void xcd_barrier_complete(unsigned* bar, unsigned x, unsigned& nloc, unsigned& nx) {
    const unsigned G = gridDim.x * gridDim.y * gridDim.z;
    unsigned sum, cnt, mine, sp = 0u;
    for (;;) {
        sum = 0u; cnt = 0u; mine = 0u;
#pragma unroll
        for (unsigned j = 0; j < 16; ++j) { const unsigned c = xb_ld(&bar[XB_XCNT(j)]); sum += c; cnt += (c > 0u) ? 1u : 0u; mine = (j == x) ? c : mine; }
        if (sum == G) break;
        __builtin_amdgcn_s_sleep(1);
        if ((++sp & 255u) == 0u) { if (xb_ld(&bar[XB_TMO])) break; if (sp > XB_SPIN_CAP) { atomicAdd(&bar[XB_TMO], 1u); break; } }
    }
    nloc = mine > 0u ? mine : 1u; nx = cnt > 0u ? cnt : 1u;
}
__device__ __forceinline__ void xcd_barrier(unsigned* bar_, volatile LAS unsigned* st_) {
    XcdBarrier b; b.bar = bar_; b.x = xb_xcc_id(); b.st = st_;
    asm volatile("s_waitcnt vmcnt(0)" ::: "memory");
    __syncthreads();
    if (threadIdx.x == 0) {
        unsigned* bar = b.bar;
        __builtin_amdgcn_s_waitcnt(0);
        unsigned nloc = b.st[0], nx = b.st[1];
        if (nloc == 0u) { xcd_barrier_complete(bar, b.x, nloc, nx); b.st[0] = nloc; b.st[1] = nx; }
        const unsigned old = xb_add(&bar[XB_XSUB(b.x)], 1u);
        const unsigned gen = old / nloc;
        if (old + 1u == (gen + 1u) * nloc) {
            __builtin_amdgcn_fence(__ATOMIC_RELEASE, "agent");
            asm volatile("s_waitcnt vmcnt(0)" ::: "memory");
            const unsigned og = xb_add(&bar[XB_TOP], 1u);
            const unsigned tg = og / nx;
            if (og + 1u == (tg + 1u) * nx) xb_add(&bar[XB_TOPGEN], 1u);
            else XB_SPIN(xb_ld(&bar[XB_TOPGEN]) == tg, bar);
            __builtin_amdgcn_fence(__ATOMIC_ACQUIRE, "agent");
            xb_add(&bar[XB_XGEN(b.x)], 1u);
            asm volatile("s_waitcnt vmcnt(0)" ::: "memory");
        } else {
            XB_SPIN(xb_ld(&bar[XB_XGEN(b.x)]) == gen, bar);
            __builtin_amdgcn_fence(__ATOMIC_ACQUIRE, "agent");
            asm volatile("s_waitcnt vmcnt(0)" ::: "memory");
        }
    }
    __syncthreads();
}

template <int NY>
__device__ __forceinline__ void gemm_tile(const bf16_t* __restrict__ X, int ldx, const bf16_t* __restrict__ Y, int ldy, int K,
                                          f32x16 (&acc)[2][NY], unsigned char* lds, int tid) {
    const int lane = tid & 63, wave = tid >> 6, wm = wave >> 1, wn = wave & 1, l31 = lane & 31, hh = lane >> 5;
    const int lrow = tid >> 3, lc = tid & 7;
    const bf16_t* gx = X + (size_t)lrow * ldx + lc * 8;
    const bf16_t* gy = Y + (size_t)lrow * ldy + lc * 8;
    u32x4 rx[4], ry[2 * NY];
#pragma unroll
    for (int i = 0; i < 4; i++) rx[i] = *(const u32x4*)(gx + (size_t)(32 * i) * ldx);
#pragma unroll
    for (int i = 0; i < 2 * NY; i++) ry[i] = *(const u32x4*)(gy + (size_t)(32 * i) * ldy);
    __syncthreads();
    unsigned char* wx = lds + lrow * LROW + lc * 16;
#pragma unroll
    for (int i = 0; i < 4; i++) *(u32x4*)(wx + i * 32 * LROW) = rx[i];
#pragma unroll
    for (int i = 0; i < 2 * NY; i++) *(u32x4*)(wx + 18432 + i * 32 * LROW) = ry[i];
    __syncthreads();
    const int nk = K >> 6;
    const unsigned char* rxb = lds + (wm * 64 + l31) * LROW + hh * 16;
    const unsigned char* ryb = lds + 18432 + (wn * 32 * NY + l31) * LROW + hh * 16;
    for (int kt = 0; kt < nk; kt++) {
        const int cur = (kt & 1) * 36864;
        const bool more = (kt + 1 < nk);
        if (more) {
            const int ko = (kt + 1) * 64;
#pragma unroll
            for (int i = 0; i < 4; i++) rx[i] = *(const u32x4*)(gx + (size_t)(32 * i) * ldx + ko);
#pragma unroll
            for (int i = 0; i < 2 * NY; i++) ry[i] = *(const u32x4*)(gy + (size_t)(32 * i) * ldy + ko);
        }
#pragma unroll
        for (int kk = 0; kk < 4; kk++) {
            bf16x8 xf[2], yf[NY];
            xf[0] = *(const bf16x8*)(rxb + cur + kk * 32);
            xf[1] = *(const bf16x8*)(rxb + cur + 32 * LROW + kk * 32);
#pragma unroll
            for (int yi = 0; yi < NY; yi++) yf[yi] = *(const bf16x8*)(ryb + cur + yi * 32 * LROW + kk * 32);
#pragma unroll
            for (int xi = 0; xi < 2; xi++)
#pragma unroll
                for (int yi = 0; yi < NY; yi++) acc[xi][yi] = MFMA(xf[xi], yf[yi], acc[xi][yi]);
        }
        if (more) {
            unsigned char* w2 = wx + (36864 - cur);
#pragma unroll
            for (int i = 0; i < 4; i++) *(u32x4*)(w2 + i * 32 * LROW) = rx[i];
#pragma unroll
            for (int i = 0; i < 2 * NY; i++) *(u32x4*)(w2 + 18432 + i * 32 * LROW) = ry[i];
        }
        __syncthreads();
    }
}

template <int NY>
__device__ __forceinline__ void zero_acc(f32x16 (&acc)[2][NY]) {
#pragma unroll
    for (int a = 0; a < 2; a++)
#pragma unroll
        for (int b = 0; b < NY; b++)
#pragma unroll
            for (int r = 0; r < 16; r++) acc[a][b][r] = 0.f;
}

template <bool PERM = false>
__device__ __forceinline__ void transpose_tile(const float* __restrict__ src, int ldsrc, bf16_t* __restrict__ dst, int lddst, int k0, int n0, float* tile) {
    const int tid = opaque_tid();
    __syncthreads();
#pragma unroll
    for (int i = 0; i < 2; i++) {
        const int id = tid + i * 512, r = id >> 4, c4 = id & 15;
        const float4 v = *(const float4*)(src + (size_t)(k0 + r) * ldsrc + n0 + c4 * 4);
        float* tp = tile + r * 65 + c4 * 4;
        tp[0] = v.x; tp[1] = v.y; tp[2] = v.z; tp[3] = v.w;
    }
    __syncthreads();
    const int n = tid >> 3, kq = tid & 7;
    u32x4 w;
#pragma unroll
    for (int j = 0; j < 4; j++) w[j] = pk2(tile[(kq * 8 + 2 * j) * 65 + n], tile[(kq * 8 + 2 * j + 1) * 65 + n]);
    const int nrow = PERM ? (((n >> 2) & 3) * 16 + ((n >> 4) & 3) * 4 + (n & 3)) : n;
    *(u32x4*)(dst + (size_t)(n0 + nrow) * lddst + k0 + kq * 8) = w;
}

__device__ __forceinline__ int nb2ob(int nb) {
    if (nb < 4) return nb;
    if (nb == 4) return 4;
    if (nb == 5) return 30;
    if (nb == 6) return 5;
    if (nb == 7) return 31;
    if (nb < 32) return nb - 2;
    return nb;
}

__device__ __forceinline__ void phase_pro_a(const Params& p, unsigned char* lds) {
    const int tid = opaque_tid();
    float* tile = (float*)lds;
    const int NCONV = 2560 * NLAY;
    for (int j = blockIdx.x; j < NCONV + 192; j += gridDim.x) {
        if (j < NCONV) {
            const int l = j / 2560; int r = j - l * 2560;
            if (r < 1920) {
                const int kt = r / 120, nt = r - kt * 120;
                const int ob = nb2ob(nt >> 1), oc = ob * 128 + (nt & 1) * 64;
                bf16_t* dstw = p.W1t() + ((size_t)l * N1 + nt * 64) * DM;
                if (oc < INW) transpose_tile(p.w_in + (size_t)l * DM * INW + oc, INW, dstw, DM, kt * 64, 0, tile);
                else transpose_tile(p.w_mg + (size_t)l * DM * 3072 + (oc - INW), 3072, dstw, DM, kt * 64, 0, tile);
            }
            else if (r < 2304) { r -= 1920; const int which = r >> 7; r &= 127; const int kt = r >> 4, nt = r & 15;
                bf16_t* dstw = p.Wbrt() + (size_t)(l * 3 + which) * DM * 512;
                if (which == 0) transpose_tile<true>(p.w_br_a + (size_t)l * 512 * DM, DM, dstw, 512, kt * 64, nt * 64, tile);
                else if (which == 1) transpose_tile<true>(p.w_br_b + (size_t)l * 512 * DM, DM, dstw, 512, kt * 64, nt * 64, tile);
                else transpose_tile<true>(p.w_br_c + (size_t)l * 512 * DM, DM, dstw, 512, kt * 64, nt * 64, tile); }
            else { r -= 2304; const int kt = r >> 4, nt = r & 15;
                transpose_tile(p.w_out + (size_t)l * DM * DM, DM, p.Woutt() + (size_t)l * DM * DM, DM, kt * 64, nt * 64, tile); }
        } else {
            const int jj = j - NCONV; const int l = jj / 48; const int rr = jj - l * 48; const int kc = rr / 6, jb = rr - kc * 6;
            float* sc = (float*)lds;
            __syncthreads();
            for (int idx = tid; idx < 17 * 128; idx += NTHR) {
                const int r = idx >> 7, k = idx & 127;
                const float v = (r < 16) ? p.c[r * DM + kc * 128 + k] : p.c_ctx[kc * 128 + k];
                sc[idx] = v / (1.f + expf(-v));
            }
            __syncthreads();
            float a[17];
#pragma unroll
            for (int r = 0; r < 17; r++) a[r] = 0.f;
            const float* w = p.w_ada + ((size_t)l * DM + kc * 128) * 3072 + jb * NTHR + tid;
            for (int k = 0; k < 128; k++) {
                const float wv = w[(size_t)k * 3072];
#pragma unroll
                for (int r = 0; r < 17; r++) a[r] += sc[r * 128 + k] * wv;
            }
#pragma unroll
            for (int r = 0; r < 17; r++) p.MODP()[((size_t)(kc * 4 + l) * 17 + r) * 3072 + jb * NTHR + tid] = a[r];
        }
    }
}

__device__ const double ROPE_FREQ[16] = {1.0, 0.5623413251903491, 0.31622776601683794, 0.1778279410038923, 0.1, 0.05623413251903491,
    0.031622776601683794, 0.01778279410038923, 0.01, 0.005623413251903491, 0.0031622776601683794, 0.001778279410038923,
    0.001, 0.0005623413251903491, 0.00031622776601683794, 0.0001778279410038923};

__device__ __forceinline__ void sincos_d(double a, double& s, double& c) {
    const double n = rint(a * 0.6366197723675814);
    double r = fma(-n, 1.5707963267948966, a); r = fma(-n, 6.123233995736766e-17, r);
    const double r2 = r * r;
    const double sp = r * (1.0 + r2 * (-1.0 / 6.0 + r2 * (1.0 / 120.0 + r2 * (-1.0 / 5040.0 + r2 * (1.0 / 362880.0 + r2 * (-1.0 / 39916800.0 + r2 * (1.0 / 6227020800.0 + r2 * (-1.0 / 1307674368000.0))))))));
    const double cp = 1.0 + r2 * (-0.5 + r2 * (1.0 / 24.0 + r2 * (-1.0 / 720.0 + r2 * (1.0 / 40320.0 + r2 * (-1.0 / 3628800.0 + r2 * (1.0 / 479001600.0 + r2 * (-1.0 / 87178291200.0 + r2 * (1.0 / 20922789888000.0))))))));
    const int q = ((int)n) & 3;
    if (q == 0) { s = sp; c = cp; } else if (q == 1) { s = cp; c = -sp; } else if (q == 2) { s = -sp; c = -cp; } else { s = -cp; c = sp; }
}

__device__ __forceinline__ void phase_pro_b(const Params& p) {
    const int tid = opaque_tid(), lane = tid & 63, wave = tid >> 6;
    const int gsz = gridDim.x * NTHR;
    for (int idx = blockIdx.x * NTHR + tid; idx < NLAY * 17 * 3072; idx += gsz) {
        const int l = idx / (17 * 3072), j = idx % 3072;
        float s = p.b_ada[l * 3072 + j];
#pragma unroll
        for (int kc = 0; kc < 8; kc++) s += p.MODP()[(size_t)kc * (NLAY * 17 * 3072) + idx];
        p.MOD()[idx] = s;
    }
    if (blockIdx.x == 0 && wave < NLAY) {
        const int l = wave;
        float a = p.lam_q1[l * 64 + lane] * p.lam_k1[l * 64 + lane];
        float b = p.lam_q2[l * 64 + lane] * p.lam_k2[l * 64 + lane];
        a = wave_sum(a); b = wave_sum(b);
        if (lane == 0) p.LAM()[l] = expf(a) - expf(b) + lam_init_of(l);
    }
    if (blockIdx.x == (gridDim.x > 1 ? 1 : 0)) {
        for (int idx = tid; idx < 1024; idx += NTHR) {
            const int pp = idx >> 4, i = idx & 15;
            double s, c; sincos_d((double)pp * ROPE_FREQ[i], s, c);
            p.ROPE()[idx * 2] = (float)c; p.ROPE()[idx * 2 + 1] = (float)s;
        }
    }
}

__device__ __forceinline__ int panel_of(int pi) { return pi < 64 ? (pi >> 3) * 9 + 1 + (pi & 7) : (pi - 64) * 9; }
__device__ __forceinline__ unsigned panel_want(int mt, int inst) { return 4u * (unsigned)(inst + 1) - ((inst > 3 && (mt % 9) == 0) ? 4u : 0u); }
template <bool HOIST>
__device__ __forceinline__ void norm_rows(const Params& p, int chunk, int layer, int row_begin, int row_end, int row_step) {
    const int tid = opaque_tid(), lane = tid & 63, wave = tid >> 6;
    float4 gq[4], ga[4], sh[4];
    auto load_vecs = [&](int mr) {
        if (layer >= 0) {
            const float* gate = p.MOD() + ((size_t)layer * 17 + mr) * 3072 + 2048;
            const float* gp = p.g_post + layer * DM;
#pragma unroll
            for (int i = 0; i < 4; i++) { const int e = i * 256 + lane * 4; const float4 g = *(const float4*)(gate + e), q = *(const float4*)(gp + e);
                gq[i] = make_float4(g.x * q.x, g.y * q.y, g.z * q.z, g.w * q.w); }
        }
        if (layer < NLAY - 1) {
            const int nl = layer + 1;
            const float* md = p.MOD() + ((size_t)nl * 17 + mr) * 3072;
            const float* gpre = p.g_pre + nl * DM;
#pragma unroll
            for (int i = 0; i < 4; i++) { const int e = i * 256 + lane * 4; const float4 s4 = *(const float4*)(md + e), scl = *(const float4*)(md + 1024 + e), g = *(const float4*)(gpre + e);
                ga[i] = make_float4(g.x * (1.f + scl.x), g.y * (1.f + scl.y), g.z * (1.f + scl.z), g.w * (1.f + scl.w)); sh[i] = s4; }
        }
    };
    if (HOIST) { const int bl0 = row_begin / TT, t0 = row_begin - bl0 * TT; load_vecs(t0 < CTXL ? 16 : chunk * CB + bl0); }
    for (int row = row_begin + wave; row < row_end; row += row_step) {
        const int bl = row / TT, t = row - bl * TT, b = chunk * CB + bl;
        const bool isctx = t < CTXL;
        if (layer == NLAY - 1 && isctx) continue;
        const float* xin; float* xst; int mr;
        if (isctx) { const size_t o = ((size_t)b * CTXL + t) * DM; xin = (layer <= 0 ? p.ctx : (const float*)p.CX()) + o; xst = p.CX() + o; mr = 16; }
        else { const size_t o = ((size_t)b * SEQ + (t - CTXL)) * DM; xin = (layer <= 0 ? p.x : (const float*)p.out) + o; xst = p.out + o; mr = b; }
        if (!HOIST) load_vecs(mr);
        float4 xv[4];
#pragma unroll
        for (int i = 0; i < 4; i++) xv[i] = *(const float4*)(xin + i * 256 + lane * 4);
        if (layer >= 0) {
            const bf16_t* yr = (const bf16_t*)p.Y() + (size_t)row * DM;
            float4 yv[4]; float ss = 0.f;
#pragma unroll
            for (int i = 0; i < 4; i++) { const uint2 w = *(const uint2*)(yr + i * 256 + lane * 4); yv[i] = make_float4(bflo(w.x), bfhi(w.x), bflo(w.y), bfhi(w.y));
                ss += yv[i].x * yv[i].x + yv[i].y * yv[i].y + yv[i].z * yv[i].z + yv[i].w * yv[i].w; }
            ss = wave_sum(ss);
            const float rstd = rsqrtf(ss * (1.f / DM) + 1e-6f);
#pragma unroll
            for (int i = 0; i < 4; i++) {
                const int e = i * 256 + lane * 4;
                xv[i].x += gq[i].x * (yv[i].x * rstd); xv[i].y += gq[i].y * (yv[i].y * rstd);
                xv[i].z += gq[i].z * (yv[i].z * rstd); xv[i].w += gq[i].w * (yv[i].w * rstd);
                *(float4*)(xst + e) = xv[i];
            }
        }
        if (layer < NLAY - 1) {
            float ss = 0.f;
#pragma unroll
            for (int i = 0; i < 4; i++) ss += xv[i].x * xv[i].x + xv[i].y * xv[i].y + xv[i].z * xv[i].z + xv[i].w * xv[i].w;
            ss = wave_sum(ss);
            const float rstd = rsqrtf(ss * (1.f / DM) + 1e-6f);
#pragma unroll
            for (int i = 0; i < 4; i++) {
                const int e = i * 256 + lane * 4;
                const float h0 = xv[i].x * rstd * ga[i].x + sh[i].x, h1 = xv[i].y * rstd * ga[i].y + sh[i].y;
                const float h2 = xv[i].z * rstd * ga[i].z + sh[i].z, h3 = xv[i].w * rstd * ga[i].w + sh[i].w;
                *(uint2*)(p.H() + (size_t)row * DM + e) = make_uint2(pk2(h0, h1), pk2(h2, h3));
            }
        }
    }
}
__device__ __forceinline__ void phase_norm(const Params& p, int chunk, int layer) {
    norm_rows<false>(p, chunk, layer, blockIdx.x * 8, NTC, gridDim.x * 8);
}
__device__ __forceinline__ void phase_norm_ticketed(const Params& p, int chunk, int layer, int inst, volatile LAS unsigned* bst) {
    for (;;) {
        __syncthreads();
        if (threadIdx.x == 0) {
            const unsigned tk = xb_add(&p.BAR()[G23_TK2], 1u) - 544u * (unsigned)inst;
            if (tk < 288u && !(layer == NLAY - 1 && ((int)(tk >> 2) % 9) == 0)) {
                unsigned* pc = &p.BAR()[G23_PC2(tk >> 2)];
                const unsigned want = panel_want((int)(tk >> 2), inst);
                XB_SPIN_SLOW(xb_ld(pc) < want, p.BAR());
                __builtin_amdgcn_fence(__ATOMIC_ACQUIRE, "agent");
                asm volatile("s_waitcnt vmcnt(0)" ::: "memory");
            }
            bst[2] = tk;
        }
        __syncthreads();
        const unsigned it = (unsigned)__builtin_amdgcn_readfirstlane((int)bst[2]);
        if (it >= 288u) break;
        norm_rows<true>(p, chunk, layer, (int)it * 64, (int)it * 64 + 64, 8);
    }
}

__device__ __forceinline__ int lds_byte(int r, int c) {
    const int st = (r >> 4) * 2 + (c >> 5), rr = r & 15, cc = c & 31, ob = rr * 64 + cc * 2;
    return st * 1024 + (ob ^ (((ob >> 9) & 1) << 5));
}
__device__ __forceinline__ void stage_rc(int b, int& R, int& C) {
    const int st = b / 1024, sb = b % 1024, swz = sb ^ (((sb >> 9) & 1) << 5);
    R = (st >> 1) * 16 + swz / 64; C = (st & 1) * 32 + (swz % 64) / 2;
}
struct NoHook { __device__ __forceinline__ void operator()(int, f32x4 (&)[2][2][4][2]) const {} };
template <int LDA, int LDB, int KSEG = 0, class Hook = NoHook>
__device__ __forceinline__ void gemm256(const bf16_t* __restrict__ A, const bf16_t* __restrict__ Bt, const int K, const int brow, const int bcol,
                                        f32x4 (&acc)[2][2][4][2], LAS unsigned char* lds, const size_t segA = 0, const size_t segB = 0, const Hook hook = Hook()) {
    constexpr int BK = 64, HALF = 128, HTB = HALF * BK * 2;
    const int tid = opaque_tid(), wid = __builtin_amdgcn_readfirstlane(tid >> 6), lane = tid & 63, wr = wid >> 2, wc = wid & 3, fr = lane & 15, fq = lane >> 4;
    unsigned voffA[2], voffB[2];
#pragma unroll
    for (int i = 0; i < 2; ++i) { int R, C; stage_rc(tid * 16 + i * 8192, R, C); voffA[i] = (unsigned)(R * LDA + C) * 2u; voffB[i] = (unsigned)(R * LDB + C) * 2u; }
    const size_t kstep = (size_t)(BK * 2);
    const size_t hstepA = (size_t)HALF * LDA * 2, hstepB = (size_t)HALF * LDB * 2;
    const unsigned ldsw = (unsigned)wid * 1024u;
    const int aoff = lds_byte(wr * 64 + fr, fq * 8), boff = lds_byte(wc * 32 + fr, fq * 8);
    const char* cA = (const char*)(A + (size_t)brow * LDA);
    const char* cB = (const char*)(Bt + (size_t)bcol * LDB);
    auto pA = [&](int T) -> const char* { return KSEG ? cA + (size_t)(T / (KSEG ? KSEG : 1)) * segA + (size_t)(T % (KSEG ? KSEG : 1)) * kstep : cA + (size_t)T * kstep; };
    auto pB = [&](int T) -> const char* { return KSEG ? cB + (size_t)(T / (KSEG ? KSEG : 1)) * segB + (size_t)(T % (KSEG ? KSEG : 1)) * kstep : cB + (size_t)T * kstep; };
#define SA(b, h) (((b) * 2 + (h)) * HTB)
#define SB(b, h) ((4 + (b) * 2 + (h)) * HTB)
#define STAGE(bufoff, gbase, voff) do { _Pragma("unroll") for (int _i = 0; _i < 2; ++_i) \
        __builtin_amdgcn_global_load_lds((const unsigned*)((const char*)(gbase) + voff[_i]), (LAS unsigned*)(lds + (bufoff) + ldsw + _i * 8192), 16, 0, 0); } while (0)
#define LDA(dst, b, h) do { _Pragma("unroll") for (int m = 0; m < 4; ++m) _Pragma("unroll") for (int k = 0; k < 2; ++k) dst[m][k] = *(const LAS bf16x8*)(lds + SA(b, h) + aoff + m * 2048 + k * 1024); } while (0)
#define LDB(dst, b, h) do { _Pragma("unroll") for (int n = 0; n < 2; ++n) _Pragma("unroll") for (int k = 0; k < 2; ++k) dst[n][k] = *(const LAS bf16x8*)(lds + SB(b, h) + boff + n * 2048 + k * 1024); } while (0)
#define MMA(ai, bj, At, Bx) do { __builtin_amdgcn_s_setprio(1); _Pragma("unroll") for (int m = 0; m < 4; ++m) _Pragma("unroll") for (int n = 0; n < 2; ++n) _Pragma("unroll") for (int k = 0; k < 2; ++k) \
      acc[ai][bj][m][n] = __builtin_amdgcn_mfma_f32_16x16x32_bf16(At[m][k], Bx[n][k], acc[ai][bj][m][n], 0, 0, 0); \
    __builtin_amdgcn_s_setprio(0); } while (0)
#define WAIT_V(n) asm volatile("s_waitcnt vmcnt(" #n ")" ::: "memory")
#define WAIT_L(n) asm volatile("s_waitcnt lgkmcnt(" #n ")" ::: "memory")
#define BAR __builtin_amdgcn_s_barrier()
#define SCHED __builtin_amdgcn_sched_barrier(0)
#pragma unroll
    for (int a = 0; a < 2; a++)
#pragma unroll
        for (int b = 0; b < 2; b++)
#pragma unroll
            for (int m = 0; m < 4; m++)
#pragma unroll
                for (int n = 0; n < 2; n++) acc[a][b][m][n] = (f32x4){0.f, 0.f, 0.f, 0.f};
    bf16x8 At[4][2], B0[2][2], B1[2][2];
    const int nt = K / BK;
    WAIT_V(0); WAIT_L(0);
    __syncthreads();
    STAGE(SB(0, 0), cB, voffB); STAGE(SA(0, 0), cA, voffA); STAGE(SB(0, 1), cB + hstepB, voffB); STAGE(SA(0, 1), cA + hstepA, voffA);
    if (wr == 1) BAR;
    WAIT_V(4); BAR;
    STAGE(SB(1, 0), pB(1), voffB); STAGE(SA(1, 0), pA(1), voffA); STAGE(SB(1, 1), pB(1) + hstepB, voffB);
    WAIT_V(6); BAR;
    for (int t = 0; t < nt - 2; t += 2) {
        if (KSEG && t > 0 && (t % (KSEG ? KSEG : 1)) == 0) hook(t / (KSEG ? KSEG : 1), acc);
        const char* a1 = pA(t + 1); const char* a2 = pA(t + 2); const char* a3 = pA(t + 3);
        const char* b2 = pB(t + 2); const char* b3 = pB(t + 3);
        LDB(B0, 0, 0); SCHED; LDA(At, 0, 0); STAGE(SA(1, 1), a1 + hstepA, voffA);
        WAIT_L(8); BAR; WAIT_L(0); MMA(0, 0, At, B0); BAR; SCHED;
        LDB(B1, 0, 1); STAGE(SB(0, 0), b2, voffB);
        BAR; WAIT_L(0); MMA(0, 1, At, B1); BAR;
        LDA(At, 0, 1); STAGE(SA(0, 0), a2, voffA);
        BAR; WAIT_L(0); MMA(1, 0, At, B0); BAR; SCHED;
        STAGE(SB(0, 1), b2 + hstepB, voffB);
        WAIT_V(6); BAR; MMA(1, 1, At, B1); BAR;
        LDB(B0, 1, 0); SCHED; LDA(At, 1, 0); STAGE(SA(0, 1), a2 + hstepA, voffA);
        WAIT_L(8); BAR; WAIT_L(0); MMA(0, 0, At, B0); BAR; SCHED;
        LDB(B1, 1, 1); STAGE(SB(1, 0), b3, voffB);
        BAR; WAIT_L(0); MMA(0, 1, At, B1); BAR;
        LDA(At, 1, 1); STAGE(SA(1, 0), a3, voffA);
        BAR; WAIT_L(0); MMA(1, 0, At, B0); BAR; SCHED;
        STAGE(SB(1, 1), b3 + hstepB, voffB);
        WAIT_V(6); BAR; MMA(1, 1, At, B1); BAR;
    }
    { LDB(B0, 0, 0); LDA(At, 0, 0); STAGE(SA(1, 1), pA(nt - 1) + hstepA, voffA);
      BAR; WAIT_L(0); MMA(0, 0, At, B0); BAR;
      LDB(B1, 0, 1); BAR; WAIT_L(0); MMA(0, 1, At, B1); BAR;
      LDA(At, 0, 1); WAIT_V(4); BAR; WAIT_L(0); MMA(1, 0, At, B0); MMA(1, 1, At, B1); BAR; }
    { LDB(B0, 1, 0); LDA(At, 1, 0); WAIT_V(2); BAR; WAIT_L(0); MMA(0, 0, At, B0); BAR;
      LDB(B1, 1, 1); WAIT_V(0); BAR; WAIT_L(0); MMA(0, 1, At, B1); BAR;
      LDA(At, 1, 1); BAR; WAIT_L(0); MMA(1, 0, At, B0); MMA(1, 1, At, B1); BAR; }
    if (wr == 0) BAR;
#undef SA
#undef SB
#undef STAGE
#undef LDA
#undef LDB
#undef MMA
#undef WAIT_V
#undef WAIT_L
#undef BAR
#undef SCHED
}

template <bool PERMF = false, class F>
__device__ __forceinline__ void epi_store_rows(LAS unsigned char* lds, int wid, int lane2, int fr, int fq, int wc, int mt, bf16_t* dbase, size_t dld, F getpk) {
    LAS unsigned char* reg = lds + wid * 9216;
#pragma unroll
    for (int bj = 0; bj < 2; bj++)
#pragma unroll
        for (int n = 0; n < 2; n++)
#pragma unroll
            for (int m = 0; m < 4; m++) *(LAS u32x2*)(reg + ((bj * 2 + n) * 16 + fr) * LROW + (PERMF ? fq * 32 + m * 8 : fq * 8 + m * 32)) = getpk(bj, n, m);
#pragma unroll
    for (int i = 0; i < 8; i++) {
        const int c = lane2 + 64 * i, row = c >> 3, ch = c & 7;
        const u32x4 w = *(const LAS u32x4*)(reg + row * LROW + ch * 16);
        const int tk2 = mt * 256 + (row >> 5) * 128 + wc * 32 + (row & 31);
        *(u32x4*)(dbase + (size_t)tk2 * dld + ch * 8) = w;
    }
}

__device__ __forceinline__ void phase_gemm1(const Params& p, int layer, LAS unsigned char* lds) {
    const int tid = opaque_tid(), wid = __builtin_amdgcn_readfirstlane(tid >> 6), wr = wid >> 2, wc = wid & 3;
    const bf16_t* Wt = p.W1t() + (size_t)layer * N1 * DM;
    const bool lastl = (layer == NLAY - 1);
    const int nslots = lastl ? (1920 + 48) : 6 * 48 * 8;
    for (int L = blockIdx.x; L < nslots; L += gridDim.x) {
        int mt, nt;
        if (lastl && L >= 1920) {
            const int c = L - 1920, cp = c / 6, k = c - cp * 6;
            mt = cp * 9; nt = (k < 2) ? 2 + k : 6 + k;
        } else {
            const int xc = L & 7, q = L >> 3, pidx = q / 48, w = q - pidx * 48, gp = pidx * 8 + xc;
            if (gp >= 45) continue;
            const int pmp = gp / 5, pnp = gp - pmp * 5;
            const int pr = pmp * 8 + (w & 7);
            mt = lastl ? (pr >> 3) * 9 + 1 + (pr & 7) : pr;
            nt = pnp * 6 + (w >> 3);
        }
        const bool isV = (nt == 3) || (nt == 10) || (nt == 11);
        f32x4 acc[2][2][4][2];
        if (isV) {
            gemm256<DM, DM>(p.H(), Wt, DM, mt * 256, nt * 256, acc, lds);
            const int tid2 = opaque_tid(), lane2 = tid2 & 63, fr = lane2 & 15, fq = lane2 >> 4;
            const int tok0 = mt * 256; const int bl = tok0 / TT, t0 = tok0 - bl * TT;
            const int ppos = 8 * (fq & 1) + 4 * (fq >> 1);
            LAS unsigned char* vreg = lds + wid * 2304;
#pragma unroll
            for (int bj = 0; bj < 2; bj++)
#pragma unroll
                for (int n = 0; n < 2; n++)
#pragma unroll
                    for (int ai = 0; ai < 2; ai++) {
#pragma unroll
                        for (int m = 0; m < 4; m++) {
                            const f32x4 v = acc[ai][bj][m][n];
                            *(LAS u32x2*)(vreg + fr * LROW + m * 32 + ppos * 2) = (u32x2){pk2(v[0], v[1]), pk2(v[2], v[3])};
                        }
#pragma unroll
                        for (int i = 0; i < 2; i++) {
                            const int c = lane2 + 64 * i, r = c >> 3, ch = c & 7;
                            const int vcr = wc * 32 + n * 16 + r;
                            bf16_t* dr;
                            if (nt == 3) dr = (bj == 0 ? p.VtA() : p.VtC()) + ((size_t)(bl * 2 + (vcr >> 6)) * 64 + (vcr & 63)) * TT;
                            else { const int vc = (nt - 10) * 256 + bj * 128 + vcr; dr = p.VtB() + ((size_t)(bl * 4 + (vc >> 7)) * 128 + (vc & 127)) * TT; }
                            *(u32x4*)(dr + t0 + ai * 128 + wr * 64 + ch * 8) = *(const LAS u32x4*)(vreg + r * LROW + ch * 16);
                        }
                    }
        } else {
            gemm256<DM, DM>(Wt, p.H(), DM, nt * 256, mt * 256, acc, lds);
            const int tid2 = opaque_tid(), lane2 = tid2 & 63, fr = lane2 & 15, fq = lane2 >> 4;
#pragma unroll
            for (int ai = 0; ai < 2; ai++) {
                const int col0 = nb2ob(nt * 2 + ai) * 128 + wr * 64;
                int type;
                if (col0 < 512) type = 0; else if (col0 < 640) type = 1; else if (col0 < 1280) type = 3; else if (col0 < 2304) type = 2;
                else if (col0 < 3328) type = 3; else if (col0 < 3968) type = 2; else if (col0 < 4608) type = 3; else type = 4;
#pragma unroll
                for (int bj = 0; bj < 2; bj++)
#pragma unroll
                    for (int n = 0; n < 2; n++) {
                        const int tk = mt * 256 + bj * 128 + wc * 32 + n * 16 + fr;
                        const int bl = tk / TT, t = tk - bl * TT;
                        float v[4][4];
#pragma unroll
                        for (int m = 0; m < 4; m++)
#pragma unroll
                            for (int j = 0; j < 4; j++) v[m][j] = acc[ai][bj][m][n][j];
                        if (type <= 1) {
                            float ss = 0.f;
#pragma unroll
                            for (int m = 0; m < 4; m++)
#pragma unroll
                                for (int j = 0; j < 4; j++) ss += v[m][j] * v[m][j];
                            ss += __shfl_xor(ss, 16); ss += __shfl_xor(ss, 32);
                            const float rstd = rsqrtf(ss * (1.f / 64.f) + 1e-6f);
                            const float* gn = (type == 0 ? p.q_norm : p.k_norm) + layer * 64;
#pragma unroll
                            for (int m = 0; m < 4; m++) {
                                const float4 g4 = *(const float4*)(gn + m * 16 + fq * 4);
                                v[m][0] *= rstd * g4.x; v[m][1] *= rstd * g4.y; v[m][2] *= rstd * g4.z; v[m][3] *= rstd * g4.w;
                            }
                        }
                        if (type <= 2 && t >= CTXL) {
                            const int pos = t - CTXL;
#pragma unroll
                            for (int ax = 0; ax < 2; ax++) {
                                const int pp = (ax == 0) ? (pos >> 6) : (pos & 63);
                                const float4* rp = (const float4*)(p.ROPE() + (size_t)(pp * 16 + fq * 4) * 2);
                                const float4 c01 = rp[0], c23 = rp[1];
                                const float cs[4] = {c01.x, c01.z, c23.x, c23.z}, sn[4] = {c01.y, c01.w, c23.y, c23.w};
#pragma unroll
                                for (int j = 0; j < 4; j++) {
                                    const float x1 = v[2 * ax][j], x2 = v[2 * ax + 1][j];
                                    v[2 * ax][j] = x1 * cs[j] - x2 * sn[j];
                                    v[2 * ax + 1][j] = x2 * cs[j] + x1 * sn[j];
                                }
                            }
                        }
                        if (type == 3) {
#pragma unroll
                            for (int m = 0; m < 4; m++)
#pragma unroll
                                for (int j = 0; j < 4; j++) v[m][j] = silu_f(v[m][j]);
                        }
                        if (type == 4) {
                            const float* bm = p.b_mg + layer * 3072 + (col0 - INW);
#pragma unroll
                            for (int m = 0; m < 4; m++) {
                                const float4 b4 = *(const float4*)(bm + m * 16 + fq * 4);
                                v[m][0] = fmaxf(sigmoid_f(v[m][0] + b4.x), 5.96e-8f); v[m][1] = fmaxf(sigmoid_f(v[m][1] + b4.y), 5.96e-8f);
                                v[m][2] = fmaxf(sigmoid_f(v[m][2] + b4.z), 5.96e-8f); v[m][3] = fmaxf(sigmoid_f(v[m][3] + b4.w), 5.96e-8f);
                            }
                        }
                        if (type == 4) {
                            LAS unsigned char* srow = lds + wid * 9216 + ((bj * 2 + n) * 16 + fr) * 80 + fq * 4;
#pragma unroll
                            for (int m = 0; m < 4; m++) {
                                const unsigned q0 = (unsigned)fmaxf(__builtin_rintf(v[m][0] * 255.f), 1.f), q1 = (unsigned)fmaxf(__builtin_rintf(v[m][1] * 255.f), 1.f);
                                const unsigned q2 = (unsigned)fmaxf(__builtin_rintf(v[m][2] * 255.f), 1.f), q3 = (unsigned)fmaxf(__builtin_rintf(v[m][3] * 255.f), 1.f);
                                *(LAS unsigned*)(srow + m * 16) = q0 | (q1 << 8) | (q2 << 16) | (q3 << 24);
                            }
                        } else {
                        LAS unsigned char* srow = lds + wid * 9216 + ((bj * 2 + n) * 16 + fr) * LROW + fq * 8;
#pragma unroll
                        for (int m = 0; m < 4; m++)
                            *(LAS u32x2*)(srow + m * 32) = (u32x2){pk2(v[m][0], v[m][1]), pk2(v[m][2], v[m][3])};
                        }
                    }
                if (type == 4) {
                    unsigned char* dbase = (unsigned char*)p.G() + (col0 - INW);
#pragma unroll
                    for (int i = 0; i < 4; i++) {
                        const int c = lane2 + 64 * i, row = c >> 2, ch = c & 3;
                        const u32x4 w = *(const LAS u32x4*)(lds + wid * 9216 + row * 80 + ch * 16);
                        const int tk2 = mt * 256 + (row >> 5) * 128 + wc * 32 + (row & 31);
                        *(u32x4*)(dbase + (size_t)tk2 * 3072 + ch * 16) = w;
                    }
                } else {
                    bf16_t* dbase = p.PROJ() + col0;
                    const size_t dld = INW;
#pragma unroll
                    for (int i = 0; i < 8; i++) {
                        const int c = lane2 + 64 * i, row = c >> 3, ch = c & 7;
                        const u32x4 w = *(const LAS u32x4*)(lds + wid * 9216 + row * LROW + ch * 16);
                        const int tk2 = mt * 256 + (row >> 5) * 128 + wc * 32 + (row & 31);
                        *(u32x4*)(dbase + (size_t)tk2 * dld + ch * 8) = w;
                    }
                }
            }
        }
    }
}

template <int DV>
__device__ __forceinline__ void attn_tile(const unsigned char* Kl, const unsigned char* Vl, const bf16x8 (&qf)[4], f32x16 (&O)[DV / 32], float& m, float& l,
                                          int l31, int hh, bool domask, int qpos, int kpos0) {
    const float SL2 = 0.125f * LOG2E;
    const float THR = 8.f;
    f32x16 S[2];
#pragma unroll
    for (int sub = 0; sub < 2; sub++)
#pragma unroll
        for (int r = 0; r < 16; r++) S[sub][r] = 0.f;
#pragma unroll
    for (int kk = 0; kk < 4; kk++)
#pragma unroll
        for (int sub = 0; sub < 2; sub++) {
            const bf16x8 kf = *(const bf16x8*)(Kl + (sub * 32 + l31) * LROW + kk * 32 + hh * 16);
            S[sub] = MFMA(kf, qf[kk], S[sub]);
        }
    if (domask) {
#pragma unroll
        for (int sub = 0; sub < 2; sub++)
#pragma unroll
            for (int r = 0; r < 16; r++) {
                const int d = qpos - (kpos0 + sub * 32 + (r & 3) + 8 * (r >> 2) + 4 * hh);
                S[sub][r] = (d <= 128 && d >= -128) ? S[sub][r] : -1e30f;
            }
    }
    float mx = S[0][0];
#pragma unroll
    for (int sub = 0; sub < 2; sub++)
#pragma unroll
        for (int r = 0; r < 16; r++) mx = fmaxf(mx, S[sub][r]);
    mx = fmaxf(mx, __shfl_xor(mx, 32));
    const float mxs = mx * SL2;
    if (__any(mxs > m + THR)) {
        const float mnew = fmaxf(m, mxs);
        const float alpha = __builtin_amdgcn_exp2f(m - mnew);
        m = mnew; l *= alpha;
#pragma unroll
        for (int dt = 0; dt < DV / 32; dt++)
#pragma unroll
            for (int r = 0; r < 16; r++) O[dt][r] *= alpha;
    }
    float ps = 0.f;
#pragma unroll
    for (int sub = 0; sub < 2; sub++)
#pragma unroll
        for (int r = 0; r < 16; r++) { S[sub][r] = __builtin_amdgcn_exp2f(__builtin_fmaf(S[sub][r], SL2, -m)); ps += S[sub][r]; }
    l += ps;
    bf16x8 pb[2][2];
#pragma unroll
    for (int sub = 0; sub < 2; sub++)
#pragma unroll
        for (int s = 0; s < 2; s++) {
            u32x4 cv;
            cv[0] = pk2(S[sub][8 * s + 0], S[sub][8 * s + 1]); cv[1] = pk2(S[sub][8 * s + 2], S[sub][8 * s + 3]);
            cv[2] = pk2(S[sub][8 * s + 4], S[sub][8 * s + 5]); cv[3] = pk2(S[sub][8 * s + 6], S[sub][8 * s + 7]);
            pb[sub][s] = __builtin_bit_cast(bf16x8, cv);
        }
#pragma unroll
    for (int sub = 0; sub < 2; sub++)
#pragma unroll
        for (int s = 0; s < 2; s++)
#pragma unroll
            for (int dt = 0; dt < DV / 32; dt++) {
                const bf16x8 vf = *(const bf16x8*)(Vl + (dt * 32 + l31) * LROW + (sub * 4 + s * 2 + hh) * 16);
                O[dt] = MFMA(vf, pb[sub][s], O[dt]);
            }
}

template <bool DIFF>
__device__ __forceinline__ void attn_unit(const Params& p, int layer, int mode, int bl, int hidx, int qblk, bool isctx, unsigned char* lds) {
    constexpr int DV = DIFF ? 128 : 64;
    constexpr int NKM = DIFF ? 2 : 1;
    constexpr int KBYTES = NKM * 9216, VBYTES = DV * LROW, BUFB = KBYTES + VBYTES;
    const int tid = opaque_tid(), lane = tid & 63, wave = __builtin_amdgcn_readfirstlane(tid >> 6), l31 = lane & 31, hh = lane >> 5;
    int qcol, kcol, gcol, ucol, tq, head = 0, cm = 0, qs = 0;
    const bf16_t* vt;
    int qpos;
    if (DIFF) {
        cm = wave & 1; qs = wave >> 1;
        qcol = 1280 + hidx * 128 + cm * 64; kcol = 1792 + hidx * 128; gcol = 2816 + hidx * 128; ucol = NTC * 512 + hidx * 128;
        vt = p.VtB() + (size_t)(bl * 4 + hidx) * 128 * TT;
        qpos = qblk * 128 + qs * 32 + l31;
        tq = bl * TT + (isctx ? 0 : CTXL) + qpos;
    } else {
        head = hidx * 4 + (wave & 3);
        qpos = qblk * 64 + (wave >> 2) * 32 + l31;
        if (mode == 0) { qcol = head * 64; kcol = 512 + hidx * 64; gcol = 768 + head * 64; ucol = head * 64; vt = p.VtA() + (size_t)(bl * 2 + hidx) * 64 * TT; }
        else { qcol = 3328 + head * 64; kcol = 3840 + hidx * 64; gcol = 4096 + head * 64; ucol = 2 * NTC * 512 + head * 64; vt = p.VtC() + (size_t)(bl * 2 + hidx) * 64 * TT; }
        tq = bl * TT + (isctx ? 0 : CTXL) + qpos;
    }
    const bool win = (!DIFF) && (mode == 2) && !isctx;
    int n2, start2;
    if (isctx) { n2 = 0; start2 = 0; }
    else if (win) { const int q0 = qblk * 64; int lo = q0 - 128; if (lo < 0) lo = 0; int hi = q0 + 192; if (hi > SEQ) hi = SEQ; n2 = (hi - lo) >> 6; start2 = CTXL + lo; }
    else { n2 = 32; start2 = CTXL; }
    const int ntile = 4 + n2;

    const bf16_t* kp = p.PROJ() + (size_t)(bl * TT) * INW + kcol;
    const int lr = tid >> 3, lc = tid & 7;
    u32x4 kr[NKM], vr[DV / 64];
    bf16x8 qf[4];
    {
        unsigned char* qreg = lds + 73728 + wave * 4608;
        const int tqb = tq - l31;
#pragma unroll
        for (int i = 0; i < 4; i++) {
            const int c = lane + 64 * i, row = c >> 3, ch = c & 7;
            *(u32x4*)(qreg + row * LROW + ch * 16) = *(const u32x4*)(p.PROJ() + (size_t)(tqb + row) * INW + qcol + ch * 8);
        }
#pragma unroll
        for (int kk = 0; kk < 4; kk++) qf[kk] = *(const bf16x8*)(qreg + l31 * LROW + kk * 32 + hh * 16);
    }
    f32x16 O[DV / 32];
#pragma unroll
    for (int dt = 0; dt < DV / 32; dt++)
#pragma unroll
        for (int r = 0; r < 16; r++) O[dt][r] = 0.f;
    float m = -1e30f, l = 0.f;

    {
        const int t0 = 0;
#pragma unroll
        for (int i = 0; i < NKM; i++) kr[i] = *(const u32x4*)(kp + (size_t)(t0 + lr) * INW + i * 64 + lc * 8);
#pragma unroll
        for (int i = 0; i < DV / 64; i++) vr[i] = *(const u32x4*)(vt + (size_t)(lr + i * 64) * TT + t0 + lc * 8);
    }
    __syncthreads();
    {
        unsigned char* wb = lds + lr * LROW + lc * 16;
#pragma unroll
        for (int i = 0; i < NKM; i++) *(u32x4*)(wb + i * 9216) = kr[i];
#pragma unroll
        for (int i = 0; i < DV / 64; i++) *(u32x4*)(wb + KBYTES + i * 64 * LROW) = vr[i];
    }
    __syncthreads();
    for (int it = 0; it < ntile; it++) {
        const unsigned char* cur = lds + (it & 1) * BUFB;
        const bool more = (it + 1 < ntile);
        if (more) {
            const int t0 = (it + 1 < 4) ? (it + 1) * 64 : start2 + (it + 1 - 4) * 64;
#pragma unroll
            for (int i = 0; i < NKM; i++) kr[i] = *(const u32x4*)(kp + (size_t)(t0 + lr) * INW + i * 64 + lc * 8);
#pragma unroll
            for (int i = 0; i < DV / 64; i++) vr[i] = *(const u32x4*)(vt + (size_t)(lr + i * 64) * TT + t0 + lc * 8);
        }
        const int tcur = (it < 4) ? it * 64 : start2 + (it - 4) * 64;
        const int rel = (tcur - CTXL) - (DIFF ? 0 : (qblk * 64 + (wave >> 2) * 32));
        attn_tile<DV>(cur + cm * 9216, cur + KBYTES, qf, O, m, l, l31, hh, win && (it >= 4) && (rel < -97 || rel > 65), qpos, tcur - CTXL);
        if (more) {
            unsigned char* wb = lds + ((it + 1) & 1) * BUFB + lr * LROW + lc * 16;
#pragma unroll
            for (int i = 0; i < NKM; i++) *(u32x4*)(wb + i * 9216) = kr[i];
#pragma unroll
            for (int i = 0; i < DV / 64; i++) *(u32x4*)(wb + KBYTES + i * 64 * LROW) = vr[i];
        }
        __syncthreads();
    }
    float lt = l + __shfl_xor(l, 32);
    if (DIFF) {
        const float inv = 1.f / lt;
        float* xb = (float*)lds + qs * 128 * 32;
        if (cm == 1) {
#pragma unroll
            for (int dt = 0; dt < DV / 32; dt++)
#pragma unroll
                for (int r = 0; r < 16; r++) xb[(dt * 32 + (r & 3) + 8 * (r >> 2) + 4 * hh) * 32 + l31] = O[dt][r] * inv;
        }
        __syncthreads();
        if (cm == 0) {
            const float lam = p.LAM()[layer];
            const float om = 1.f - lam_init_of(layer);
            float ss = 0.f;
#pragma unroll
            for (int dt = 0; dt < DV / 32; dt++)
#pragma unroll
                for (int r = 0; r < 16; r++) {
                    const float o = O[dt][r] * inv - lam * xb[(dt * 32 + (r & 3) + 8 * (r >> 2) + 4 * hh) * 32 + l31];
                    O[dt][r] = o; ss += o * o;
                }
            ss += __shfl_xor(ss, 32);
            const float rstd = rsqrtf(ss * (1.f / 128.f) + 1e-5f) * om;
            unsigned char* sreg = lds + 65536 + wave * 9216;
            constexpr int RS = DV * 2 + 16, CPR = DV / 8;
            const int lane_e = opaque_tid() & 63;
            const int tqb = tq - l31;
#pragma unroll
            for (int i = 0; i < DV / 16; i++) {
                const int c = lane_e + 64 * i, row = c / CPR, ch = c % CPR;
                *(u32x4*)(sreg + row * RS + ch * 16) = *(const u32x4*)(p.PROJ() + (size_t)(tqb + row) * INW + gcol + ch * 8);
            }
#pragma unroll
            for (int dt = 0; dt < DV / 32; dt++)
#pragma unroll
                for (int rg = 0; rg < 4; rg++) {
                    const int d0 = dt * 32 + rg * 8 + hh * 4;
                    const float4 sg = *(const float4*)(p.subln + layer * 128 + d0);
                    u32x2* sp = (u32x2*)(sreg + l31 * RS + d0 * 2);
                    const u32x2 gw = *sp;
                    const float o0 = O[dt][rg * 4 + 0] * rstd * sg.x * bflo(gw[0]), o1 = O[dt][rg * 4 + 1] * rstd * sg.y * bfhi(gw[0]);
                    const float o2 = O[dt][rg * 4 + 2] * rstd * sg.z * bflo(gw[1]), o3 = O[dt][rg * 4 + 3] * rstd * sg.w * bfhi(gw[1]);
                    *sp = (u32x2){pk2(o0, o1), pk2(o2, o3)};
                }
#pragma unroll
            for (int i = 0; i < DV / 16; i++) {
                const int c = lane_e + 64 * i, row = c / CPR, ch = c % CPR;
                *(u32x4*)(p.U() + (size_t)(tqb + row) * 512 + ucol + ch * 8) = *(const u32x4*)(sreg + row * RS + ch * 16);
            }
        }
    } else {
        float a = 1.f;
        if (mode == 2) {
            const float s2 = p.sink[layer * 8 + head] * LOG2E;
            const float mf = fmaxf(m, s2);
            a = __builtin_amdgcn_exp2f(m - mf);
            lt = lt * a + __builtin_amdgcn_exp2f(s2 - mf);
        }
        const float inv = a / lt;
        unsigned char* sreg = lds + 65536 + wave * 9216;
        constexpr int RS = DV * 2 + 16, CPR = DV / 8;
        const int lane_e = opaque_tid() & 63;
        const int tqb = tq - l31;
#pragma unroll
        for (int i = 0; i < DV / 16; i++) {
            const int c = lane_e + 64 * i, row = c / CPR, ch = c % CPR;
            *(u32x4*)(sreg + row * RS + ch * 16) = *(const u32x4*)(p.PROJ() + (size_t)(tqb + row) * INW + gcol + ch * 8);
        }
#pragma unroll
        for (int dt = 0; dt < DV / 32; dt++)
#pragma unroll
            for (int rg = 0; rg < 4; rg++) {
                const int d0 = dt * 32 + rg * 8 + hh * 4;
                u32x2* sp = (u32x2*)(sreg + l31 * RS + d0 * 2);
                const u32x2 gw = *sp;
                const float o0 = O[dt][rg * 4 + 0] * inv * bflo(gw[0]), o1 = O[dt][rg * 4 + 1] * inv * bfhi(gw[0]);
                const float o2 = O[dt][rg * 4 + 2] * inv * bflo(gw[1]), o3 = O[dt][rg * 4 + 3] * inv * bfhi(gw[1]);
                *sp = (u32x2){pk2(o0, o1), pk2(o2, o3)};
            }
#pragma unroll
        for (int i = 0; i < DV / 16; i++) {
            const int c = lane_e + 64 * i, row = c / CPR, ch = c % CPR;
            *(u32x4*)(p.U() + (size_t)(tqb + row) * 512 + ucol + ch * 8) = *(const u32x4*)(sreg + row * RS + ch * 16);
        }
    }
}

__device__ __forceinline__ void phase_attn(const Params& p, int layer, unsigned char* lds) {
    const int nunits = 1536 + ((layer < NLAY - 1) ? 192 : 0);
    for (int u = blockIdx.x; u < nunits; u += gridDim.x) {
        int mode, bl, hidx, qb; bool isctx;
        if (u < 512) { const int x = u & 7, rest = u >> 3; qb = rest & 15; const int combo = (rest >> 4) * 8 + x; mode = 1; bl = combo >> 2; hidx = combo & 3; isctx = false; }
        else if (u < 1536) { const int u2 = (u - 512) & 511; const int x = u2 & 7, rest = u2 >> 3; qb = rest & 31; const int combo = (rest >> 5) * 8 + x;
            mode = (u < 1024) ? 0 : 2; bl = combo >> 1; hidx = combo & 1; isctx = false; }
        else if (u < 1600) { const int u2 = u - 1536; qb = u2 & 1; const int combo = u2 >> 1; mode = 1; bl = combo >> 2; hidx = combo & 3; isctx = true; }
        else { const int u2 = (u - 1600) & 63; qb = u2 & 3; const int combo = u2 >> 2; mode = (u < 1664) ? 0 : 2; bl = combo >> 1; hidx = combo & 1; isctx = true; }
        __syncthreads();
        if (mode == 1) attn_unit<true>(p, layer, mode, bl, hidx, qb, isctx, lds);
        else attn_unit<false>(p, layer, mode, bl, hidx, qb, isctx, lds);
    }
}

__device__ __forceinline__ float ub(unsigned w, int j) { return (float)((w >> (8 * j)) & 0xffu); }
struct GateHook {
    const unsigned char* G; int tok0, feat0;
    __device__ __forceinline__ void operator()(int seg, f32x4 (&acc)[2][2][4][2]) const {
        const int tid2 = opaque_tid(), lane2 = tid2 & 63, wid2 = __builtin_amdgcn_readfirstlane(tid2 >> 6), wr = wid2 >> 2, wc = wid2 & 3, fr = lane2 & 15, fq = lane2 >> 4;
#pragma unroll
        for (int bj = 0; bj < 2; bj++)
#pragma unroll
            for (int n = 0; n < 2; n++) {
                const int tk = tok0 + bj * 128 + wc * 32 + n * 16 + fr;
                const unsigned char* gprev = G + (size_t)tk * 3072 + (seg - 1) * 1024 + feat0 + wr * 64 + fq * 16;
#pragma unroll
                for (int ai = 0; ai < 2; ai++) {
                    const u32x4 gp = *(const u32x4*)(gprev + ai * 128), gn = *(const u32x4*)(gprev + 1024 + ai * 128);
#pragma unroll
                    for (int m = 0; m < 4; m++) {
                        f32x4& v = acc[ai][bj][m][n];
                        v[0] *= ub(gp[m], 0) * __builtin_amdgcn_rcpf(ub(gn[m], 0)); v[1] *= ub(gp[m], 1) * __builtin_amdgcn_rcpf(ub(gn[m], 1));
                        v[2] *= ub(gp[m], 2) * __builtin_amdgcn_rcpf(ub(gn[m], 2)); v[3] *= ub(gp[m], 3) * __builtin_amdgcn_rcpf(ub(gn[m], 3));
                    }
                }
            }
    }
};

__device__ __forceinline__ void phase_gemm2(const Params& p, int layer, LAS unsigned char* lds) {
    const int tid = opaque_tid(), wid = __builtin_amdgcn_readfirstlane(tid >> 6), wr = wid >> 2, wc = wid & 3;
    const int ntiles = (layer == NLAY - 1) ? 256 : 288;
    for (int L = blockIdx.x; L < ntiles; L += gridDim.x) {
        const int mt = panel_of(L >> 2), nt = L & 3;
        f32x4 acc[2][2][4][2];
        GateHook hk; hk.G = (const unsigned char*)p.G(); hk.tok0 = mt * 256; hk.feat0 = nt * 256;
        gemm256<512, 512, 8, GateHook>(p.Wbrt() + (size_t)(layer * 3) * DM * 512, p.U(), 1536, nt * 256, mt * 256, acc, lds,
                                       (size_t)DM * 512 * 2, (size_t)NTC * 512 * 2, hk);
        const int tid2 = opaque_tid(), lane2 = tid2 & 63, fr = lane2 & 15, fq = lane2 >> 4;
#pragma unroll
        for (int ai = 0; ai < 2; ai++) {
            const int f0 = nt * 256 + ai * 128 + wr * 64;
            epi_store_rows<true>(lds, wid, lane2, fr, fq, wc, mt, p.Mb() + f0, DM, [&](int bj, int n, int m) -> u32x2 {
                const int tk = mt * 256 + bj * 128 + wc * 32 + n * 16 + fr;
                const unsigned gw = *(const unsigned*)((const unsigned char*)p.G() + (size_t)tk * 3072 + 2048 + f0 + fq * 16 + m * 4);
                const f32x4 v = acc[ai][bj][m][n] * (1.f / 255.f);
                return (u32x2){pk2(v[0] * ub(gw, 0), v[1] * ub(gw, 1)), pk2(v[2] * ub(gw, 2), v[3] * ub(gw, 3))};
            });
        }
        asm volatile("s_waitcnt vmcnt(0)" ::: "memory");
        __syncthreads();
        if (threadIdx.x == 0) {
            __builtin_amdgcn_fence(__ATOMIC_RELEASE, "agent");
            asm volatile("s_waitcnt vmcnt(0)" ::: "memory");
            xb_add(&p.BAR()[G23_PC(mt)], 1u);
        }
    }
}

__device__ __forceinline__ void phase_gemm3(const Params& p, int layer, int inst, LAS unsigned char* lds, volatile LAS unsigned* bst) {
    const int tid = opaque_tid(), wid = __builtin_amdgcn_readfirstlane(tid >> 6), wr = wid >> 2, wc = wid & 3;
    const unsigned nvalid = (layer == NLAY - 1) ? 256u : 288u;
    for (;;) {
        __syncthreads();
        if (threadIdx.x == 0) {
            const unsigned tk = xb_add(&p.BAR()[G23_TK], 1u) - (544u * (unsigned)inst - (inst > 3 ? 32u : 0u));
            if (tk < nvalid) {
                const int pmt = panel_of((int)(tk >> 2));
                unsigned* pc = &p.BAR()[G23_PC(pmt)];
                const unsigned want = panel_want(pmt, inst);
                XB_SPIN_SLOW(xb_ld(pc) < want, p.BAR());
                __builtin_amdgcn_fence(__ATOMIC_ACQUIRE, "agent");
                asm volatile("s_waitcnt vmcnt(0)" ::: "memory");
            }
            bst[2] = tk;
        }
        __syncthreads();
        const unsigned L = (unsigned)__builtin_amdgcn_readfirstlane((int)bst[2]);
        if (L >= nvalid) break;
        const int mt = panel_of((int)(L >> 2)), nt = (int)(L & 3u);
        f32x4 acc[2][2][4][2];
        gemm256<DM, DM>(p.Woutt() + (size_t)layer * DM * DM, p.Mb(), DM, nt * 256, mt * 256, acc, lds);
        const int tid2 = opaque_tid(), lane2 = tid2 & 63, fr = lane2 & 15, fq = lane2 >> 4;
#pragma unroll
        for (int ai = 0; ai < 2; ai++)
            epi_store_rows(lds, wid, lane2, fr, fq, wc, mt, (bf16_t*)p.Y() + nt * 256 + ai * 128 + wr * 64, DM, [&](int bj, int n, int m) -> u32x2 {
                const f32x4 v = acc[ai][bj][m][n];
                return (u32x2){pk2(v[0], v[1]), pk2(v[2], v[3])};
            });
        asm volatile("s_waitcnt vmcnt(0)" ::: "memory");
        __syncthreads();
        if (threadIdx.x == 0) {
            __builtin_amdgcn_fence(__ATOMIC_RELEASE, "agent");
            asm volatile("s_waitcnt vmcnt(0)" ::: "memory");
            xb_add(&p.BAR()[G23_PC2(mt)], 1u);
        }
    }
}

__global__ void __launch_bounds__(512, 2) fwd_kernel(Params p) {
    extern __shared__ __attribute__((aligned(16))) unsigned char lds[];
    cg::grid_group grid = cg::this_grid();
    volatile LAS unsigned* bst = (volatile LAS unsigned*)((LAS unsigned char*)lds + LDS_BYTES);
    if (threadIdx.x == 0) { bst[0] = 0u; bst[1] = 0u; }
    __syncthreads();
    (void)xcd_barrier_post(p.BAR(), bst);
    phase_pro_a(p, lds);
    grid.sync();
    phase_pro_b(p);
    xcd_barrier(p.BAR(), bst);
    for (int chunk = 0; chunk < NB / CB; chunk++) {
        phase_norm(p, chunk, -1);
        xcd_barrier(p.BAR(), bst);
        for (int layer = 0; layer < NLAY; layer++) {
            phase_gemm1(p, layer, (LAS unsigned char*)lds);
            xcd_barrier(p.BAR(), bst);
            phase_attn(p, layer, lds);
            xcd_barrier(p.BAR(), bst);
            phase_gemm2(p, layer, (LAS unsigned char*)lds);
            phase_gemm3(p, layer, chunk * NLAY + layer, (LAS unsigned char*)lds, bst);
            phase_norm_ticketed(p, chunk, layer, chunk * NLAY + layer, bst);
            xcd_barrier(p.BAR(), bst);
        }
    }
}

extern "C" void kernel_launch(void* const* d_in, const int* in_sizes, int n_in, void* d_out, int out_size, void* d_ws, size_t ws_size, hipStream_t stream) {
    static int grid_blocks = 0;
    if (!grid_blocks) {
        int dev = 0, cus = 0, per_cu = 0;
        hipGetDevice(&dev);
        hipDeviceGetAttribute(&cus, hipDeviceAttributeMultiprocessorCount, dev);
        hipFuncSetAttribute((const void*)fwd_kernel, hipFuncAttributeMaxDynamicSharedMemorySize, LDS_BYTES + 16);
        hipOccupancyMaxActiveBlocksPerMultiprocessor(&per_cu, (const void*)fwd_kernel, NTHR, LDS_BYTES + 16);
        if (per_cu < 1) per_cu = 1;
        if (per_cu > 1) per_cu = 1;
        grid_blocks = cus * per_cu;
    }
    Params p{};
    const float* const* in = (const float* const*)d_in;
    p.x = in[0]; p.c = in[1]; p.ctx = in[2]; p.c_ctx = in[3]; p.w_ada = in[4]; p.b_ada = in[5]; p.g_pre = in[6]; p.g_post = in[7];
    p.w_in = in[8]; p.q_norm = in[9]; p.k_norm = in[10]; p.lam_q1 = in[11]; p.lam_k1 = in[12]; p.lam_q2 = in[13]; p.lam_k2 = in[14];
    p.subln = in[15]; p.sink = in[16]; p.w_br_a = in[17]; p.w_br_b = in[18]; p.w_br_c = in[19]; p.w_mg = in[20]; p.b_mg = in[21]; p.w_out = in[22];
    p.out = (float*)d_out;
    p.ws = (unsigned char*)d_ws;
    if (WS_END > ws_size) { fprintf(stderr, "kernel_launch: workspace too small: need %zu, have %zu\n", (size_t)WS_END, ws_size); return; }
    hipMemsetAsync((unsigned char*)d_ws + OFF_BAR, 0, ALL_BAR_WORDS * 4, stream);
    void* args[] = {&p};
    hipError_t e = hipLaunchCooperativeKernel((void*)fwd_kernel, dim3(grid_blocks), dim3(NTHR), args, LDS_BYTES + 16, stream);
    if (e != hipSuccess) fprintf(stderr, "cooperative launch failed: %s (grid %d)\n", hipGetErrorString(e), grid_blocks);
}
```

```cpp
#include <hip/hip_runtime.h>
#include <hip/hip_cooperative_groups.h>
#include <cstdio>
#include <cstdint>
namespace cg = cooperative_groups;

typedef unsigned short bf16_t;
typedef short bf16x8 __attribute__((ext_vector_type(8)));
typedef float f32x16 __attribute__((ext_vector_type(16)));
typedef unsigned u32x4 __attribute__((ext_vector_type(4)));
typedef float f32x4 __attribute__((ext_vector_type(4)));
typedef unsigned u32x2 __attribute__((ext_vector_type(2)));

constexpr int NB = 16, SEQ = 2048, CTXL = 256, TT = 2304, DM = 1024, NLAY = 4, INW = 4608, N1 = 7680;
constexpr int CB = 8, NTC = CB * TT;
constexpr int LDS_BYTES = 147456;
constexpr int NTHR = 512;
constexpr int LROW = 144;
constexpr float LOG2E = 1.4426950408889634f;

#define MFMA(a, b, c) __builtin_amdgcn_mfma_f32_32x32x16_bf16((a), (b), (c), 0, 0, 0)

constexpr size_t al256(size_t x) { return (x + 255) & ~(size_t)255; }
constexpr size_t OFF_W1T = 0;
constexpr size_t OFF_WBRT = OFF_W1T + al256((size_t)NLAY * N1 * DM * 2);
constexpr size_t OFF_WOUTT = OFF_WBRT + al256((size_t)NLAY * 3 * DM * 512 * 2);
constexpr size_t OFF_MODP = OFF_WOUTT + al256((size_t)NLAY * DM * DM * 2);
constexpr size_t OFF_MOD = OFF_MODP + al256((size_t)8 * NLAY * 17 * 3072 * 4);
constexpr size_t OFF_ROPE = OFF_MOD + al256((size_t)NLAY * 17 * 3072 * 4);
constexpr size_t OFF_LAM = OFF_ROPE + al256(64 * 16 * 2 * 4);
constexpr size_t OFF_BAR = OFF_LAM + 256;
constexpr size_t OFF_CX = OFF_BAR + al256((size_t)16384 * 4);
constexpr size_t OFF_H = OFF_CX + al256((size_t)NB * CTXL * DM * 4);
constexpr size_t OFF_U = OFF_H + al256((size_t)NTC * DM * 2);
constexpr size_t OFF_PROJ = OFF_U + al256((size_t)NTC * 1536 * 2);
constexpr size_t OFF_VTA = OFF_PROJ + al256((size_t)NTC * INW * 2);
constexpr size_t OFF_VTB = OFF_VTA + al256((size_t)CB * 2 * 64 * TT * 2);
constexpr size_t OFF_VTC = OFF_VTB + al256((size_t)CB * 4 * 128 * TT * 2);
constexpr size_t OFF_G = OFF_VTC + al256((size_t)CB * 2 * 64 * TT * 2);
constexpr size_t WS_END = OFF_G + al256((size_t)NTC * 3072 * 2);
constexpr size_t OFF_MB = OFF_PROJ;
constexpr size_t OFF_Y = OFF_PROJ + (size_t)NTC * DM * 2;

struct Params {
    const float *x, *c, *ctx, *c_ctx, *w_ada, *b_ada, *g_pre, *g_post, *w_in, *q_norm, *k_norm;
    const float *lam_q1, *lam_k1, *lam_q2, *lam_k2, *subln, *sink, *w_br_a, *w_br_b, *w_br_c, *w_mg, *b_mg, *w_out;
    float* out;
    unsigned char* ws;
    __device__ __forceinline__ bf16_t* W1t() const { return (bf16_t*)(ws + OFF_W1T); }
    __device__ __forceinline__ bf16_t* Wbrt() const { return (bf16_t*)(ws + OFF_WBRT); }
    __device__ __forceinline__ bf16_t* Woutt() const { return (bf16_t*)(ws + OFF_WOUTT); }
    __device__ __forceinline__ float* MODP() const { return (float*)(ws + OFF_MODP); }
    __device__ __forceinline__ float* MOD() const { return (float*)(ws + OFF_MOD); }
    __device__ __forceinline__ float* ROPE() const { return (float*)(ws + OFF_ROPE); }
    __device__ __forceinline__ float* LAM() const { return (float*)(ws + OFF_LAM); }
    __device__ __forceinline__ unsigned* BAR() const { return (unsigned*)(ws + OFF_BAR); }
    __device__ __forceinline__ float* CX() const { return (float*)(ws + OFF_CX); }
    __device__ __forceinline__ bf16_t* H() const { return (bf16_t*)(ws + OFF_H); }
    __device__ __forceinline__ bf16_t* U() const { return (bf16_t*)(ws + OFF_U); }
    __device__ __forceinline__ bf16_t* PROJ() const { return (bf16_t*)(ws + OFF_PROJ); }
    __device__ __forceinline__ bf16_t* VtA() const { return (bf16_t*)(ws + OFF_VTA); }
    __device__ __forceinline__ bf16_t* VtB() const { return (bf16_t*)(ws + OFF_VTB); }
    __device__ __forceinline__ bf16_t* VtC() const { return (bf16_t*)(ws + OFF_VTC); }
    __device__ __forceinline__ bf16_t* G() const { return (bf16_t*)(ws + OFF_G); }
    __device__ __forceinline__ bf16_t* Mb() const { return (bf16_t*)(ws + OFF_MB); }
    __device__ __forceinline__ float* Y() const { return (float*)(ws + OFF_Y); }
};

typedef __bf16 bf16x2_t __attribute__((ext_vector_type(2)));
typedef float f32x2_t __attribute__((ext_vector_type(2)));
__device__ __forceinline__ unsigned pk2(float lo, float hi) { const f32x2_t f = {lo, hi}; const bf16x2_t b = __builtin_convertvector(f, bf16x2_t); return __builtin_bit_cast(unsigned, b); }
__device__ __forceinline__ float bflo(unsigned w) { return __uint_as_float(w << 16); }
__device__ __forceinline__ float bfhi(unsigned w) { return __uint_as_float(w & 0xffff0000u); }
__device__ __forceinline__ float sigmoid_f(float v) { return __builtin_amdgcn_rcpf(1.f + __builtin_amdgcn_exp2f(-LOG2E * v)); }
__device__ __forceinline__ float silu_f(float v) { return v * sigmoid_f(v); }
__device__ __forceinline__ float wave_sum(float v) {
    v += __shfl_xor(v, 32); v += __shfl_xor(v, 16); v += __shfl_xor(v, 8); v += __shfl_xor(v, 4); v += __shfl_xor(v, 2); v += __shfl_xor(v, 1); return v;
}
__device__ __forceinline__ int opaque_tid() { int t = threadIdx.x; asm volatile("" : "+v"(t)); return t; }
__device__ __forceinline__ float lam_init_of(int l) { return 0.8f - 0.6f * expf(-0.3f * (float)l); }


#define XB_TMO      128
#define XB_XCNT(j)  (256  + 64 * (j))
#define XB_XSUB(j)  (1280 + 64 * (j))
#define XB_XGEN(j)  (2304 + 64 * (j))
#define XB_TOP      3328
#define XB_TOPGEN   3392
#define XCD_BAR_WORDS 3456
#define G23_PC(mt)   (XCD_BAR_WORDS + 64 * (mt))
#define G23_TK       (XCD_BAR_WORDS + 64 * 72)
#define G23_PC2(mt)  (XCD_BAR_WORDS + 64 * 73 + 64 * (mt))
#define G23_TK2      (XCD_BAR_WORDS + 64 * 145)
#define ALL_BAR_WORDS (XCD_BAR_WORDS + 64 * 146)
#define XB_SPIN_CAP (1u << 18)
#define LAS __attribute__((address_space(3)))
__device__ __forceinline__ unsigned xb_ld(unsigned* p)              { return __hip_atomic_load(p, __ATOMIC_RELAXED, __HIP_MEMORY_SCOPE_AGENT); }
__device__ __forceinline__ unsigned xb_add(unsigned* p, unsigned v) { return __hip_atomic_fetch_add(p, v, __ATOMIC_RELAXED, __HIP_MEMORY_SCOPE_AGENT); }
__device__ __forceinline__ unsigned xb_xcc_id() { return (unsigned)__builtin_amdgcn_s_getreg((3 << 11) | 20) & 0xFu; }
#define XB_SPIN(cond, bar) do { unsigned _sp = 0; while (cond) { __builtin_amdgcn_s_sleep(1); \
    if ((++_sp & 255u) == 0u) { if (xb_ld(&(bar)[XB_TMO])) break; if (_sp > XB_SPIN_CAP) { atomicAdd(&(bar)[XB_TMO], 1u); break; } } } } while (0)
#define XB_SPIN_SLOW(cond, bar) do { unsigned _sp = 0; while (cond) { __builtin_amdgcn_s_sleep(32); \
    if ((++_sp & 63u) == 0u) { if (xb_ld(&(bar)[XB_TMO])) break; if (_sp > (1u << 17)) { atomicAdd(&(bar)[XB_TMO], 1u); break; } } } } while (0)
struct XcdBarrier { unsigned* bar; unsigned x; volatile LAS unsigned* st; };
__device__ __forceinline__ XcdBarrier xcd_barrier_post(unsigned* bar, volatile LAS unsigned* st) {
    XcdBarrier b; b.bar = bar; b.x = xb_xcc_id(); b.st = st;
    if (threadIdx.x == 0) (void)xb_add(&bar[XB_XCNT(b.x)], 1u);
    return b;
}
__device__ __forceinline__ void xcd_barrier_complete(unsigned* bar, unsigned x, unsigned& nloc, unsigned& nx) {
    const unsigned G = gridDim.x * gridDim.y * gridDim.z;
    unsigned sum, cnt, mine, sp = 0u;
    for (;;) {
        sum = 0u; cnt = 0u; mine = 0u;
#pragma unroll
        for (unsigned j = 0; j < 16; ++j) { const unsigned c = xb_ld(&bar[XB_XCNT(j)]); sum += c; cnt += (c > 0u) ? 1u : 0u; mine = (j == x) ? c : mine; }
        if (sum == G) break;
        __builtin_amdgcn_s_sleep(1);
        if ((++sp & 255u) == 0u) { if (xb_ld(&bar[XB_TMO])) break; if (sp > XB_SPIN_CAP) { atomicAdd(&bar[XB_TMO], 1u); break; } }
    }
    nloc = mine > 0u ? mine : 1u; nx = cnt > 0u ? cnt : 1u;
}
__device__ __forceinline__ void xcd_barrier(unsigned* bar_, volatile LAS unsigned* st_) {
    XcdBarrier b; b.bar = bar_; b.x = xb_xcc_id(); b.st = st_;
    asm volatile("s_waitcnt vmcnt(0)" ::: "memory");
    __syncthreads();
    if (threadIdx.x == 0) {
        unsigned* bar = b.bar;
        __builtin_amdgcn_s_waitcnt(0);
        unsigned nloc = b.st[0], nx = b.st[1];
        if (nloc == 0u) { xcd_barrier_complete(bar, b.x, nloc, nx); b.st[0] = nloc; b.st[1] = nx; }
        const unsigned old = xb_add(&bar[XB_XSUB(b.x)], 1u);
        const unsigned gen = old / nloc;
        if (old + 1u == (gen + 1u) * nloc) {
            __builtin_amdgcn_fence(__ATOMIC_RELEASE, "agent");
            asm volatile("s_waitcnt vmcnt(0)" ::: "memory");
            const unsigned og = xb_add(&bar[XB_TOP], 1u);
            const unsigned tg = og / nx;
            if (og + 1u == (tg + 1u) * nx) xb_add(&bar[XB_TOPGEN], 1u);
            else XB_SPIN(xb_ld(&bar[XB_TOPGEN]) == tg, bar);
            __builtin_amdgcn_fence(__ATOMIC_ACQUIRE, "agent");
            xb_add(&bar[XB_XGEN(b.x)], 1u);
            asm volatile("s_waitcnt vmcnt(0)" ::: "memory");
        } else {
            XB_SPIN(xb_ld(&bar[XB_XGEN(b.x)]) == gen, bar);
            __builtin_amdgcn_fence(__ATOMIC_ACQUIRE, "agent");
            asm volatile("s_waitcnt vmcnt(0)" ::: "memory");
        }
    }
    __syncthreads();
}

template <int NY>
__device__ __forceinline__ void gemm_tile(const bf16_t* __restrict__ X, int ldx, const bf16_t* __restrict__ Y, int ldy, int K,
                                          f32x16 (&acc)[2][NY], unsigned char* lds, int tid) {
    const int lane = tid & 63, wave = tid >> 6, wm = wave >> 1, wn = wave & 1, l31 = lane & 31, hh = lane >> 5;
    const int lrow = tid >> 3, lc = tid & 7;
    const bf16_t* gx = X + (size_t)lrow * ldx + lc * 8;
    const bf16_t* gy = Y + (size_t)lrow * ldy + lc * 8;
    u32x4 rx[4], ry[2 * NY];
#pragma unroll
    for (int i = 0; i < 4; i++) rx[i] = *(const u32x4*)(gx + (size_t)(32 * i) * ldx);
#pragma unroll
    for (int i = 0; i < 2 * NY; i++) ry[i] = *(const u32x4*)(gy + (size_t)(32 * i) * ldy);
    __syncthreads();
    unsigned char* wx = lds + lrow * LROW + lc * 16;
#pragma unroll
    for (int i = 0; i < 4; i++) *(u32x4*)(wx + i * 32 * LROW) = rx[i];
#pragma unroll
    for (int i = 0; i < 2 * NY; i++) *(u32x4*)(wx + 18432 + i * 32 * LROW) = ry[i];
    __syncthreads();
    const int nk = K >> 6;
    const unsigned char* rxb = lds + (wm * 64 + l31) * LROW + hh * 16;
    const unsigned char* ryb = lds + 18432 + (wn * 32 * NY + l31) * LROW + hh * 16;
    for (int kt = 0; kt < nk; kt++) {
        const int cur = (kt & 1) * 36864;
        const bool more = (kt + 1 < nk);
        if (more) {
            const int ko = (kt + 1) * 64;
#pragma unroll
            for (int i = 0; i < 4; i++) rx[i] = *(const u32x4*)(gx + (size_t)(32 * i) * ldx + ko);
#pragma unroll
            for (int i = 0; i < 2 * NY; i++) ry[i] = *(const u32x4*)(gy + (size_t)(32 * i) * ldy + ko);
        }
#pragma unroll
        for (int kk = 0; kk < 4; kk++) {
            bf16x8 xf[2], yf[NY];
            xf[0] = *(const bf16x8*)(rxb + cur + kk * 32);
            xf[1] = *(const bf16x8*)(rxb + cur + 32 * LROW + kk * 32);
#pragma unroll
            for (int yi = 0; yi < NY; yi++) yf[yi] = *(const bf16x8*)(ryb + cur + yi * 32 * LROW + kk * 32);
#pragma unroll
            for (int xi = 0; xi < 2; xi++)
#pragma unroll
                for (int yi = 0; yi < NY; yi++) acc[xi][yi] = MFMA(xf[xi], yf[yi], acc[xi][yi]);
        }
        if (more) {
            unsigned char* w2 = wx + (36864 - cur);
#pragma unroll
            for (int i = 0; i < 4; i++) *(u32x4*)(w2 + i * 32 * LROW) = rx[i];
#pragma unroll
            for (int i = 0; i < 2 * NY; i++) *(u32x4*)(w2 + 18432 + i * 32 * LROW) = ry[i];
        }
        __syncthreads();
    }
}

template <int NY>
__device__ __forceinline__ void zero_acc(f32x16 (&acc)[2][NY]) {
#pragma unroll
    for (int a = 0; a < 2; a++)
#pragma unroll
        for (int b = 0; b < NY; b++)
#pragma unroll
            for (int r = 0; r < 16; r++) acc[a][b][r] = 0.f;
}

template <bool PERM = false>
__device__ __forceinline__ void transpose_tile(const float* __restrict__ src, int ldsrc, bf16_t* __restrict__ dst, int lddst, int k0, int n0, float* tile) {
    const int tid = opaque_tid();
    __syncthreads();
#pragma unroll
    for (int i = 0; i < 2; i++) {
        const int id = tid + i * 512, r = id >> 4, c4 = id & 15;
        const float4 v = *(const float4*)(src + (size_t)(k0 + r) * ldsrc + n0 + c4 * 4);
        float* tp = tile + r * 65 + c4 * 4;
        tp[0] = v.x; tp[1] = v.y; tp[2] = v.z; tp[3] = v.w;
    }
    __syncthreads();
    const int n = tid >> 3, kq = tid & 7;
    u32x4 w;
#pragma unroll
    for (int j = 0; j < 4; j++) w[j] = pk2(tile[(kq * 8 + 2 * j) * 65 + n], tile[(kq * 8 + 2 * j + 1) * 65 + n]);
    const int nrow = PERM ? (((n >> 2) & 3) * 16 + ((n >> 4) & 3) * 4 + (n & 3)) : n;
    *(u32x4*)(dst + (size_t)(n0 + nrow) * lddst + k0 + kq * 8) = w;
}

__device__ __forceinline__ int nb2ob(int nb) {
    if (nb < 4) return nb;
    if (nb == 4) return 4;
    if (nb == 5) return 30;
    if (nb == 6) return 5;
    if (nb == 7) return 31;
    if (nb < 32) return nb - 2;
    return nb;
}

__device__ __forceinline__ void phase_pro_a(const Params& p, unsigned char* lds) {
    const int tid = opaque_tid();
    float* tile = (float*)lds;
    const int NCONV = 2560 * NLAY;
    for (int j = blockIdx.x; j < NCONV + 192; j += gridDim.x) {
        if (j < NCONV) {
            const int l = j / 2560; int r = j - l * 2560;
            if (r < 1920) {
                const int kt = r / 120, nt = r - kt * 120;
                const int ob = nb2ob(nt >> 1), oc = ob * 128 + (nt & 1) * 64;
                bf16_t* dstw = p.W1t() + ((size_t)l * N1 + nt * 64) * DM;
                if (oc < INW) transpose_tile(p.w_in + (size_t)l * DM * INW + oc, INW, dstw, DM, kt * 64, 0, tile);
                else transpose_tile(p.w_mg + (size_t)l * DM * 3072 + (oc - INW), 3072, dstw, DM, kt * 64, 0, tile);
            }
            else if (r < 2304) { r -= 1920; const int which = r >> 7; r &= 127; const int kt = r >> 4, nt = r & 15;
                bf16_t* dstw = p.Wbrt() + (size_t)(l * 3 + which) * DM * 512;
                if (which == 0) transpose_tile<true>(p.w_br_a + (size_t)l * 512 * DM, DM, dstw, 512, kt * 64, nt * 64, tile);
                else if (which == 1) transpose_tile<true>(p.w_br_b + (size_t)l * 512 * DM, DM, dstw, 512, kt * 64, nt * 64, tile);
                else transpose_tile<true>(p.w_br_c + (size_t)l * 512 * DM, DM, dstw, 512, kt * 64, nt * 64, tile); }
            else { r -= 2304; const int kt = r >> 4, nt = r & 15;
                transpose_tile(p.w_out + (size_t)l * DM * DM, DM, p.Woutt() + (size_t)l * DM * DM, DM, kt * 64, nt * 64, tile); }
        } else {
            const int jj = j - NCONV; const int l = jj / 48; const int rr = jj - l * 48; const int kc = rr / 6, jb = rr - kc * 6;
            float* sc = (float*)lds;
            __syncthreads();
            for (int idx = tid; idx < 17 * 128; idx += NTHR) {
                const int r = idx >> 7, k = idx & 127;
                const float v = (r < 16) ? p.c[r * DM + kc * 128 + k] : p.c_ctx[kc * 128 + k];
                sc[idx] = v / (1.f + expf(-v));
            }
            __syncthreads();
            float a[17];
#pragma unroll
            for (int r = 0; r < 17; r++) a[r] = 0.f;
            const float* w = p.w_ada + ((size_t)l * DM + kc * 128) * 3072 + jb * NTHR + tid;
            for (int k = 0; k < 128; k++) {
                const float wv = w[(size_t)k * 3072];
#pragma unroll
                for (int r = 0; r < 17; r++) a[r] += sc[r * 128 + k] * wv;
            }
#pragma unroll
            for (int r = 0; r < 17; r++) p.MODP()[((size_t)(kc * 4 + l) * 17 + r) * 3072 + jb * NTHR + tid] = a[r];
        }
    }
}

__device__ const double ROPE_FREQ[16] = {1.0, 0.5623413251903491, 0.31622776601683794, 0.1778279410038923, 0.1, 0.05623413251903491,
    0.031622776601683794, 0.01778279410038923, 0.01, 0.005623413251903491, 0.0031622776601683794, 0.001778279410038923,
    0.001, 0.0005623413251903491, 0.00031622776601683794, 0.0001778279410038923};

__device__ __forceinline__ void sincos_d(double a, double& s, double& c) {
    const double n = rint(a * 0.6366197723675814);
    double r = fma(-n, 1.5707963267948966, a); r = fma(-n, 6.123233995736766e-17, r);
    const double r2 = r * r;
    const double sp = r * (1.0 + r2 * (-1.0 / 6.0 + r2 * (1.0 / 120.0 + r2 * (-1.0 / 5040.0 + r2 * (1.0 / 362880.0 + r2 * (-1.0 / 39916800.0 + r2 * (1.0 / 6227020800.0 + r2 * (-1.0 / 1307674368000.0))))))));
    const double cp = 1.0 + r2 * (-0.5 + r2 * (1.0 / 24.0 + r2 * (-1.0 / 720.0 + r2 * (1.0 / 40320.0 + r2 * (-1.0 / 3628800.0 + r2 * (1.0 / 479001600.0 + r2 * (-1.0 / 87178291200.0 + r2 * (1.0 / 20922789888000.0))))))));
    const int q = ((int)n) & 3;
    if (q == 0) { s = sp; c = cp; } else if (q == 1) { s = cp; c = -sp; } else if (q == 2) { s = -sp; c = -cp; } else { s = -cp; c = sp; }
}

__device__ __forceinline__ void phase_pro_b(const Params& p) {
    const int tid = opaque_tid(), lane = tid & 63, wave = tid >> 6;
    const int gsz = gridDim.x * NTHR;
    for (int idx = blockIdx.x * NTHR + tid; idx < NLAY * 17 * 3072; idx += gsz) {
        const int l = idx / (17 * 3072), j = idx % 3072;
        float s = p.b_ada[l * 3072 + j];
#pragma unroll
        for (int kc = 0; kc < 8; kc++) s += p.MODP()[(size_t)kc * (NLAY * 17 * 3072) + idx];
        p.MOD()[idx] = s;
    }
    if (blockIdx.x == 0 && wave < NLAY) {
        const int l = wave;
        float a = p.lam_q1[l * 64 + lane] * p.lam_k1[l * 64 + lane];
        float b = p.lam_q2[l * 64 + lane] * p.lam_k2[l * 64 + lane];
        a = wave_sum(a); b = wave_sum(b);
        if (lane == 0) p.LAM()[l] = expf(a) - expf(b) + lam_init_of(l);
    }
    if (blockIdx.x == (gridDim.x > 1 ? 1 : 0)) {
        for (int idx = tid; idx < 1024; idx += NTHR) {
            const int pp = idx >> 4, i = idx & 15;
            double s, c; sincos_d((double)pp * ROPE_FREQ[i], s, c);
            p.ROPE()[idx * 2] = (float)c; p.ROPE()[idx * 2 + 1] = (float)s;
        }
    }
}

__device__ __forceinline__ int panel_of(int pi) { return pi < 64 ? (pi >> 3) * 9 + 1 + (pi & 7) : (pi - 64) * 9; }
__device__ __forceinline__ unsigned panel_want(int mt, int inst) { return 4u * (unsigned)(inst + 1) - ((inst > 3 && (mt % 9) == 0) ? 4u : 0u); }
template <bool HOIST>
__device__ __forceinline__ void norm_rows(const Params& p, int chunk, int layer, int row_begin, int row_end, int row_step) {
    const int tid = opaque_tid(), lane = tid & 63, wave = tid >> 6;
    float4 gq[4], ga[4], sh[4];
    auto load_vecs = [&](int mr) {
        if (layer >= 0) {
            const float* gate = p.MOD() + ((size_t)layer * 17 + mr) * 3072 + 2048;
            const float* gp = p.g_post + layer * DM;
#pragma unroll
            for (int i = 0; i < 4; i++) { const int e = i * 256 + lane * 4; const float4 g = *(const float4*)(gate + e), q = *(const float4*)(gp + e);
                gq[i] = make_float4(g.x * q.x, g.y * q.y, g.z * q.z, g.w * q.w); }
        }
        if (layer < NLAY - 1) {
            const int nl = layer + 1;
            const float* md = p.MOD() + ((size_t)nl * 17 + mr) * 3072;
            const float* gpre = p.g_pre + nl * DM;
#pragma unroll
            for (int i = 0; i < 4; i++) { const int e = i * 256 + lane * 4; const float4 s4 = *(const float4*)(md + e), scl = *(const float4*)(md + 1024 + e), g = *(const float4*)(gpre + e);
                ga[i] = make_float4(g.x * (1.f + scl.x), g.y * (1.f + scl.y), g.z * (1.f + scl.z), g.w * (1.f + scl.w)); sh[i] = s4; }
        }
    };
    if (HOIST) { const int bl0 = row_begin / TT, t0 = row_begin - bl0 * TT; load_vecs(t0 < CTXL ? 16 : chunk * CB + bl0); }
    for (int row = row_begin + wave; row < row_end; row += row_step) {
        const int bl = row / TT, t = row - bl * TT, b = chunk * CB + bl;
        const bool isctx = t < CTXL;
        if (layer == NLAY - 1 && isctx) continue;
        const float* xin; float* xst; int mr;
        if (isctx) { const size_t o = ((size_t)b * CTXL + t) * DM; xin = (layer <= 0 ? p.ctx : (const float*)p.CX()) + o; xst = p.CX() + o; mr = 16; }
        else { const size_t o = ((size_t)b * SEQ + (t - CTXL)) * DM; xin = (layer <= 0 ? p.x : (const float*)p.out) + o; xst = p.out + o; mr = b; }
        if (!HOIST) load_vecs(mr);
        float4 xv[4];
#pragma unroll
        for (int i = 0; i < 4; i++) xv[i] = *(const float4*)(xin + i * 256 + lane * 4);
        if (layer >= 0) {
            const bf16_t* yr = (const bf16_t*)p.Y() + (size_t)row * DM;
            float4 yv[4]; float ss = 0.f;
#pragma unroll
            for (int i = 0; i < 4; i++) { const uint2 w = *(const uint2*)(yr + i * 256 + lane * 4); yv[i] = make_float4(bflo(w.x), bfhi(w.x), bflo(w.y), bfhi(w.y));
                ss += yv[i].x * yv[i].x + yv[i].y * yv[i].y + yv[i].z * yv[i].z + yv[i].w * yv[i].w; }
            ss = wave_sum(ss);
            const float rstd = rsqrtf(ss * (1.f / DM) + 1e-6f);
#pragma unroll
            for (int i = 0; i < 4; i++) {
                const int e = i * 256 + lane * 4;
                xv[i].x += gq[i].x * (yv[i].x * rstd); xv[i].y += gq[i].y * (yv[i].y * rstd);
                xv[i].z += gq[i].z * (yv[i].z * rstd); xv[i].w += gq[i].w * (yv[i].w * rstd);
                *(float4*)(xst + e) = xv[i];
            }
        }
        if (layer < NLAY - 1) {
            float ss = 0.f;
#pragma unroll
            for (int i = 0; i < 4; i++) ss += xv[i].x * xv[i].x + xv[i].y * xv[i].y + xv[i].z * xv[i].z + xv[i].w * xv[i].w;
            ss = wave_sum(ss);
            const float rstd = rsqrtf(ss * (1.f / DM) + 1e-6f);
#pragma unroll
            for (int i = 0; i < 4; i++) {
                const int e = i * 256 + lane * 4;
                const float h0 = xv[i].x * rstd * ga[i].x + sh[i].x, h1 = xv[i].y * rstd * ga[i].y + sh[i].y;
                const float h2 = xv[i].z * rstd * ga[i].z + sh[i].z, h3 = xv[i].w * rstd * ga[i].w + sh[i].w;
                *(uint2*)(p.H() + (size_t)row * DM + e) = make_uint2(pk2(h0, h1), pk2(h2, h3));
            }
        }
    }
}
__device__ __forceinline__ void phase_norm(const Params& p, int chunk, int layer) {
    norm_rows<false>(p, chunk, layer, blockIdx.x * 8, NTC, gridDim.x * 8);
}
__device__ __forceinline__ void phase_norm_ticketed(const Params& p, int chunk, int layer, int inst, volatile LAS unsigned* bst) {
    for (;;) {
        __syncthreads();
        if (threadIdx.x == 0) {
            const unsigned tk = xb_add(&p.BAR()[G23_TK2], 1u) - 544u * (unsigned)inst;
            if (tk < 288u && !(layer == NLAY - 1 && ((int)(tk >> 2) % 9) == 0)) {
                unsigned* pc = &p.BAR()[G23_PC2(tk >> 2)];
                const unsigned want = panel_want((int)(tk >> 2), inst);
                XB_SPIN_SLOW(xb_ld(pc) < want, p.BAR());
                __builtin_amdgcn_fence(__ATOMIC_ACQUIRE, "agent");
                asm volatile("s_waitcnt vmcnt(0)" ::: "memory");
            }
            bst[2] = tk;
        }
        __syncthreads();
        const unsigned it = (unsigned)__builtin_amdgcn_readfirstlane((int)bst[2]);
        if (it >= 288u) break;
        norm_rows<true>(p, chunk, layer, (int)it * 64, (int)it * 64 + 64, 8);
    }
}

__device__ __forceinline__ int lds_byte(int r, int c) {
    const int st = (r >> 4) * 2 + (c >> 5), rr = r & 15, cc = c & 31, ob = rr * 64 + cc * 2;
    return st * 1024 + (ob ^ (((ob >> 9) & 1) << 5));
}
__device__ __forceinline__ void stage_rc(int b, int& R, int& C) {
    const int st = b / 1024, sb = b % 1024, swz = sb ^ (((sb >> 9) & 1) << 5);
    R = (st >> 1) * 16 + swz / 64; C = (st & 1) * 32 + (swz % 64) / 2;
}
struct NoHook { __device__ __forceinline__ void operator()(int, f32x4 (&)[2][2][4][2]) const {} };
template <int LDA, int LDB, int KSEG = 0, class Hook = NoHook>
__device__ __forceinline__ void gemm256(const bf16_t* __restrict__ A, const bf16_t* __restrict__ Bt, const int K, const int brow, const int bcol,
                                        f32x4 (&acc)[2][2][4][2], LAS unsigned char* lds, const size_t segA = 0, const size_t segB = 0, const Hook hook = Hook()) {
    constexpr int BK = 64, HALF = 128, HTB = HALF * BK * 2;
    const int tid = opaque_tid(), wid = __builtin_amdgcn_readfirstlane(tid >> 6), lane = tid & 63, wr = wid >> 2, wc = wid & 3, fr = lane & 15, fq = lane >> 4;
    unsigned voffA[2], voffB[2];
#pragma unroll
    for (int i = 0; i < 2; ++i) { int R, C; stage_rc(tid * 16 + i * 8192, R, C); voffA[i] = (unsigned)(R * LDA + C) * 2u; voffB[i] = (unsigned)(R * LDB + C) * 2u; }
    const size_t kstep = (size_t)(BK * 2);
    const size_t hstepA = (size_t)HALF * LDA * 2, hstepB = (size_t)HALF * LDB * 2;
    const unsigned ldsw = (unsigned)wid * 1024u;
    const int aoff = lds_byte(wr * 64 + fr, fq * 8), boff = lds_byte(wc * 32 + fr, fq * 8);
    const char* cA = (const char*)(A + (size_t)brow * LDA);
    const char* cB = (const char*)(Bt + (size_t)bcol * LDB);
    auto pA = [&](int T) -> const char* { return KSEG ? cA + (size_t)(T / (KSEG ? KSEG : 1)) * segA + (size_t)(T % (KSEG ? KSEG : 1)) * kstep : cA + (size_t)T * kstep; };
    auto pB = [&](int T) -> const char* { return KSEG ? cB + (size_t)(T / (KSEG ? KSEG : 1)) * segB + (size_t)(T % (KSEG ? KSEG : 1)) * kstep : cB + (size_t)T * kstep; };
#define SA(b, h) (((b) * 2 + (h)) * HTB)
#define SB(b, h) ((4 + (b) * 2 + (h)) * HTB)
#define STAGE(bufoff, gbase, voff) do { _Pragma("unroll") for (int _i = 0; _i < 2; ++_i) \
        __builtin_amdgcn_global_load_lds((const unsigned*)((const char*)(gbase) + voff[_i]), (LAS unsigned*)(lds + (bufoff) + ldsw + _i * 8192), 16, 0, 0); } while (0)
#define LDA(dst, b, h) do { _Pragma("unroll") for (int m = 0; m < 4; ++m) _Pragma("unroll") for (int k = 0; k < 2; ++k) dst[m][k] = *(const LAS bf16x8*)(lds + SA(b, h) + aoff + m * 2048 + k * 1024); } while (0)
#define LDB(dst, b, h) do { _Pragma("unroll") for (int n = 0; n < 2; ++n) _Pragma("unroll") for (int k = 0; k < 2; ++k) dst[n][k] = *(const LAS bf16x8*)(lds + SB(b, h) + boff + n * 2048 + k * 1024); } while (0)
#define MMA(ai, bj, At, Bx) do { __builtin_amdgcn_s_setprio(1); _Pragma("unroll") for (int m = 0; m < 4; ++m) _Pragma("unroll") for (int n = 0; n < 2; ++n) _Pragma("unroll") for (int k = 0; k < 2; ++k) \
      acc[ai][bj][m][n] = __builtin_amdgcn_mfma_f32_16x16x32_bf16(At[m][k], Bx[n][k], acc[ai][bj][m][n], 0, 0, 0); \
    __builtin_amdgcn_s_setprio(0); } while (0)
#define WAIT_V(n) asm volatile("s_waitcnt vmcnt(" #n ")" ::: "memory")
#define WAIT_L(n) asm volatile("s_waitcnt lgkmcnt(" #n ")" ::: "memory")
#define BAR __builtin_amdgcn_s_barrier()
#define SCHED __builtin_amdgcn_sched_barrier(0)
#pragma unroll
    for (int a = 0; a < 2; a++)
#pragma unroll
        for (int b = 0; b < 2; b++)
#pragma unroll
            for (int m = 0; m < 4; m++)
#pragma unroll
                for (int n = 0; n < 2; n++) acc[a][b][m][n] = (f32x4){0.f, 0.f, 0.f, 0.f};
    bf16x8 At[4][2], B0[2][2], B1[2][2];
    const int nt = K / BK;
    WAIT_V(0); WAIT_L(0);
    __syncthreads();
    STAGE(SB(0, 0), cB, voffB); STAGE(SA(0, 0), cA, voffA); STAGE(SB(0, 1), cB + hstepB, voffB); STAGE(SA(0, 1), cA + hstepA, voffA);
    if (wr == 1) BAR;
    WAIT_V(4); BAR;
    STAGE(SB(1, 0), pB(1), voffB); STAGE(SA(1, 0), pA(1), voffA); STAGE(SB(1, 1), pB(1) + hstepB, voffB);
    WAIT_V(6); BAR;
    for (int t = 0; t < nt - 2; t += 2) {
        if (KSEG && t > 0 && (t % (KSEG ? KSEG : 1)) == 0) hook(t / (KSEG ? KSEG : 1), acc);
        const char* a1 = pA(t + 1); const char* a2 = pA(t + 2); const char* a3 = pA(t + 3);
        const char* b2 = pB(t + 2); const char* b3 = pB(t + 3);
        LDB(B0, 0, 0); SCHED; LDA(At, 0, 0); STAGE(SA(1, 1), a1 + hstepA, voffA);
        WAIT_L(8); BAR; WAIT_L(0); MMA(0, 0, At, B0); BAR; SCHED;
        LDB(B1, 0, 1); STAGE(SB(0, 0), b2, voffB);
        BAR; WAIT_L(0); MMA(0, 1, At, B1); BAR;
        LDA(At, 0, 1); STAGE(SA(0, 0), a2, voffA);
        BAR; WAIT_L(0); MMA(1, 0, At, B0); BAR; SCHED;
        STAGE(SB(0, 1), b2 + hstepB, voffB);
        WAIT_V(6); BAR; MMA(1, 1, At, B1); BAR;
        LDB(B0, 1, 0); SCHED; LDA(At, 1, 0); STAGE(SA(0, 1), a2 + hstepA, voffA);
        WAIT_L(8); BAR; WAIT_L(0); MMA(0, 0, At, B0); BAR; SCHED;
        LDB(B1, 1, 1); STAGE(SB(1, 0), b3, voffB);
        BAR; WAIT_L(0); MMA(0, 1, At, B1); BAR;
        LDA(At, 1, 1); STAGE(SA(1, 0), a3, voffA);
        BAR; WAIT_L(0); MMA(1, 0, At, B0); BAR; SCHED;
        STAGE(SB(1, 1), b3 + hstepB, voffB);
        WAIT_V(6); BAR; MMA(1, 1, At, B1); BAR;
    }
    { LDB(B0, 0, 0); LDA(At, 0, 0); STAGE(SA(1, 1), pA(nt - 1) + hstepA, voffA);
      BAR; WAIT_L(0); MMA(0, 0, At, B0); BAR;
      LDB(B1, 0, 1); BAR; WAIT_L(0); MMA(0, 1, At, B1); BAR;
      LDA(At, 0, 1); WAIT_V(4); BAR; WAIT_L(0); MMA(1, 0, At, B0); MMA(1, 1, At, B1); BAR; }
    { LDB(B0, 1, 0); LDA(At, 1, 0); WAIT_V(2); BAR; WAIT_L(0); MMA(0, 0, At, B0); BAR;
      LDB(B1, 1, 1); WAIT_V(0); BAR; WAIT_L(0); MMA(0, 1, At, B1); BAR;
      LDA(At, 1, 1); BAR; WAIT_L(0); MMA(1, 0, At, B0); MMA(1, 1, At, B1); BAR; }
    if (wr == 0) BAR;
#undef SA
#undef SB
#undef STAGE
#undef LDA
#undef LDB
#undef MMA
#undef WAIT_V
#undef WAIT_L
#undef BAR
#undef SCHED
}

template <bool PERMF = false, class F>
__device__ __forceinline__ void epi_store_rows(LAS unsigned char* lds, int wid, int lane2, int fr, int fq, int wc, int mt, bf16_t* dbase, size_t dld, F getpk) {
    LAS unsigned char* reg = lds + wid * 9216;
#pragma unroll
    for (int bj = 0; bj < 2; bj++)
#pragma unroll
        for (int n = 0; n < 2; n++)
#pragma unroll
            for (int m = 0; m < 4; m++) *(LAS u32x2*)(reg + ((bj * 2 + n) * 16 + fr) * LROW + (PERMF ? fq * 32 + m * 8 : fq * 8 + m * 32)) = getpk(bj, n, m);
#pragma unroll
    for (int i = 0; i < 8; i++) {
        const int c = lane2 + 64 * i, row = c >> 3, ch = c & 7;
        const u32x4 w = *(const LAS u32x4*)(reg + row * LROW + ch * 16);
        const int tk2 = mt * 256 + (row >> 5) * 128 + wc * 32 + (row & 31);
        *(u32x4*)(dbase + (size_t)tk2 * dld + ch * 8) = w;
    }
}

__device__ __forceinline__ void phase_gemm1(const Params& p, int layer, LAS unsigned char* lds) {
    const int tid = opaque_tid(), wid = __builtin_amdgcn_readfirstlane(tid >> 6), wr = wid >> 2, wc = wid & 3;
    const bf16_t* Wt = p.W1t() + (size_t)layer * N1 * DM;
    const bool lastl = (layer == NLAY - 1);
    const int nslots = lastl ? (1920 + 48) : 6 * 48 * 8;
    for (int L = blockIdx.x; L < nslots; L += gridDim.x) {
        int mt, nt;
        if (lastl && L >= 1920) {
            const int c = L - 1920, cp = c / 6, k = c - cp * 6;
            mt = cp * 9; nt = (k < 2) ? 2 + k : 6 + k;
        } else {
            const int xc = L & 7, q = L >> 3, pidx = q / 48, w = q - pidx * 48, gp = pidx * 8 + xc;
            if (gp >= 45) continue;
            const int pmp = gp / 5, pnp = gp - pmp * 5;
            const int pr = pmp * 8 + (w & 7);
            mt = lastl ? (pr >> 3) * 9 + 1 + (pr & 7) : pr;
            nt = pnp * 6 + (w >> 3);
        }
        const bool isV = (nt == 3) || (nt == 10) || (nt == 11);
        f32x4 acc[2][2][4][2];
        if (isV) {
            gemm256<DM, DM>(p.H(), Wt, DM, mt * 256, nt * 256, acc, lds);
            const int tid2 = opaque_tid(), lane2 = tid2 & 63, fr = lane2 & 15, fq = lane2 >> 4;
            const int tok0 = mt * 256; const int bl = tok0 / TT, t0 = tok0 - bl * TT;
            const int ppos = 8 * (fq & 1) + 4 * (fq >> 1);
            LAS unsigned char* vreg = lds + wid * 2304;
#pragma unroll
            for (int bj = 0; bj < 2; bj++)
#pragma unroll
                for (int n = 0; n < 2; n++)
#pragma unroll
                    for (int ai = 0; ai < 2; ai++) {
#pragma unroll
                        for (int m = 0; m < 4; m++) {
                            const f32x4 v = acc[ai][bj][m][n];
                            *(LAS u32x2*)(vreg + fr * LROW + m * 32 + ppos * 2) = (u32x2){pk2(v[0], v[1]), pk2(v[2], v[3])};
                        }
#pragma unroll
                        for (int i = 0; i < 2; i++) {
                            const int c = lane2 + 64 * i, r = c >> 3, ch = c & 7;
                            const int vcr = wc * 32 + n * 16 + r;
                            bf16_t* dr;
                            if (nt == 3) dr = (bj == 0 ? p.VtA() : p.VtC()) + ((size_t)(bl * 2 + (vcr >> 6)) * 64 + (vcr & 63)) * TT;
                            else { const int vc = (nt - 10) * 256 + bj * 128 + vcr; dr = p.VtB() + ((size_t)(bl * 4 + (vc >> 7)) * 128 + (vc & 127)) * TT; }
                            *(u32x4*)(dr + t0 + ai * 128 + wr * 64 + ch * 8) = *(const LAS u32x4*)(vreg + r * LROW + ch * 16);
                        }
                    }
        } else {
            gemm256<DM, DM>(Wt, p.H(), DM, nt * 256, mt * 256, acc, lds);
            const int tid2 = opaque_tid(), lane2 = tid2 & 63, fr = lane2 & 15, fq = lane2 >> 4;
#pragma unroll
            for (int ai = 0; ai < 2; ai++) {
                const int col0 = nb2ob(nt * 2 + ai) * 128 + wr * 64;
                int type;
                if (col0 < 512) type = 0; else if (col0 < 640) type = 1; else if (col0 < 1280) type = 3; else if (col0 < 2304) type = 2;
                else if (col0 < 3328) type = 3; else if (col0 < 3968) type = 2; else if (col0 < 4608) type = 3; else type = 4;
#pragma unroll
                for (int bj = 0; bj < 2; bj++)
#pragma unroll
                    for (int n = 0; n < 2; n++) {
                        const int tk = mt * 256 + bj * 128 + wc * 32 + n * 16 + fr;
                        const int bl = tk / TT, t = tk - bl * TT;
                        float v[4][4];
#pragma unroll
                        for (int m = 0; m < 4; m++)
#pragma unroll
                            for (int j = 0; j < 4; j++) v[m][j] = acc[ai][bj][m][n][j];
                        if (type <= 1) {
                            float ss = 0.f;
#pragma unroll
                            for (int m = 0; m < 4; m++)
#pragma unroll
                                for (int j = 0; j < 4; j++) ss += v[m][j] * v[m][j];
                            ss += __shfl_xor(ss, 16); ss += __shfl_xor(ss, 32);
                            const float rstd = rsqrtf(ss * (1.f / 64.f) + 1e-6f);
                            const float* gn = (type == 0 ? p.q_norm : p.k_norm) + layer * 64;
#pragma unroll
                            for (int m = 0; m < 4; m++) {
                                const float4 g4 = *(const float4*)(gn + m * 16 + fq * 4);
                                v[m][0] *= rstd * g4.x; v[m][1] *= rstd * g4.y; v[m][2] *= rstd * g4.z; v[m][3] *= rstd * g4.w;
                            }
                        }
                        if (type <= 2 && t >= CTXL) {
                            const int pos = t - CTXL;
#pragma unroll
                            for (int ax = 0; ax < 2; ax++) {
                                const int pp = (ax == 0) ? (pos >> 6) : (pos & 63);
                                const float4* rp = (const float4*)(p.ROPE() + (size_t)(pp * 16 + fq * 4) * 2);
                                const float4 c01 = rp[0], c23 = rp[1];
                                const float cs[4] = {c01.x, c01.z, c23.x, c23.z}, sn[4] = {c01.y, c01.w, c23.y, c23.w};
#pragma unroll
                                for (int j = 0; j < 4; j++) {
                                    const float x1 = v[2 * ax][j], x2 = v[2 * ax + 1][j];
                                    v[2 * ax][j] = x1 * cs[j] - x2 * sn[j];
                                    v[2 * ax + 1][j] = x2 * cs[j] + x1 * sn[j];
                                }
                            }
                        }
                        if (col0 < 512 || (col0 >= 3328 && col0 < 3840)) {
#pragma unroll
                            for (int m = 0; m < 4; m++)
#pragma unroll
                                for (int j = 0; j < 4; j++) v[m][j] *= 0.125f * LOG2E;
                        }
                        if (type == 3) {
#pragma unroll
                            for (int m = 0; m < 4; m++)
#pragma unroll
                                for (int j = 0; j < 4; j++) v[m][j] = silu_f(v[m][j]);
                        }
                        if (type == 4) {
                            const float* bm = p.b_mg + layer * 3072 + (col0 - INW);
#pragma unroll
                            for (int m = 0; m < 4; m++) {
                                const float4 b4 = *(const float4*)(bm + m * 16 + fq * 4);
                                v[m][0] = fmaxf(sigmoid_f(v[m][0] + b4.x), 5.96e-8f); v[m][1] = fmaxf(sigmoid_f(v[m][1] + b4.y), 5.96e-8f);
                                v[m][2] = fmaxf(sigmoid_f(v[m][2] + b4.z), 5.96e-8f); v[m][3] = fmaxf(sigmoid_f(v[m][3] + b4.w), 5.96e-8f);
                            }
                        }
                        if (type == 4) {
                            LAS unsigned char* srow = lds + wid * 9216 + ((bj * 2 + n) * 16 + fr) * 80 + fq * 4;
#pragma unroll
                            for (int m = 0; m < 4; m++) {
                                const unsigned q0 = (unsigned)fmaxf(__builtin_rintf(v[m][0] * 255.f), 1.f), q1 = (unsigned)fmaxf(__builtin_rintf(v[m][1] * 255.f), 1.f);
                                const unsigned q2 = (unsigned)fmaxf(__builtin_rintf(v[m][2] * 255.f), 1.f), q3 = (unsigned)fmaxf(__builtin_rintf(v[m][3] * 255.f), 1.f);
                                *(LAS unsigned*)(srow + m * 16) = q0 | (q1 << 8) | (q2 << 16) | (q3 << 24);
                            }
                        } else {
                        LAS unsigned char* srow = lds + wid * 9216 + ((bj * 2 + n) * 16 + fr) * LROW + fq * 8;
#pragma unroll
                        for (int m = 0; m < 4; m++)
                            *(LAS u32x2*)(srow + m * 32) = (u32x2){pk2(v[m][0], v[m][1]), pk2(v[m][2], v[m][3])};
                        }
                    }
                if (type == 4) {
                    unsigned char* dbase = (unsigned char*)p.G() + (col0 - INW);
#pragma unroll
                    for (int i = 0; i < 4; i++) {
                        const int c = lane2 + 64 * i, row = c >> 2, ch = c & 3;
                        const u32x4 w = *(const LAS u32x4*)(lds + wid * 9216 + row * 80 + ch * 16);
                        const int tk2 = mt * 256 + (row >> 5) * 128 + wc * 32 + (row & 31);
                        *(u32x4*)(dbase + (size_t)tk2 * 3072 + ch * 16) = w;
                    }
                } else {
                    bf16_t* dbase = p.PROJ() + col0;
                    const size_t dld = INW;
#pragma unroll
                    for (int i = 0; i < 8; i++) {
                        const int c = lane2 + 64 * i, row = c >> 3, ch = c & 7;
                        const u32x4 w = *(const LAS u32x4*)(lds + wid * 9216 + row * LROW + ch * 16);
                        const int tk2 = mt * 256 + (row >> 5) * 128 + wc * 32 + (row & 31);
                        *(u32x4*)(dbase + (size_t)tk2 * dld + ch * 8) = w;
                    }
                }
            }
        }
    }
}

template <int DV>
__device__ __forceinline__ void attn_tile(const unsigned char* Kl, const unsigned char* Vl, const bf16x8 (&qf)[4], f32x16 (&O)[DV / 32], float& m, float& l,
                                          int l31, int hh, bool domask, int qpos, int kpos0) {
    const float SL2 = 0.125f * LOG2E;
    const float THR = 8.f;
    f32x16 S[2];
#pragma unroll
    for (int sub = 0; sub < 2; sub++)
#pragma unroll
        for (int r = 0; r < 16; r++) S[sub][r] = 0.f;
#pragma unroll
    for (int kk = 0; kk < 4; kk++)
#pragma unroll
        for (int sub = 0; sub < 2; sub++) {
            const bf16x8 kf = *(const bf16x8*)(Kl + (sub * 32 + l31) * LROW + kk * 32 + hh * 16);
            S[sub] = MFMA(kf, qf[kk], S[sub]);
        }
    if (domask) {
#pragma unroll
        for (int sub = 0; sub < 2; sub++)
#pragma unroll
            for (int r = 0; r < 16; r++) {
                const int d = qpos - (kpos0 + sub * 32 + (r & 3) + 8 * (r >> 2) + 4 * hh);
                S[sub][r] = (d <= 128 && d >= -128) ? S[sub][r] : -1e30f;
            }
    }
    float mx = S[0][0];
#pragma unroll
    for (int sub = 0; sub < 2; sub++)
#pragma unroll
        for (int r = 0; r < 16; r++) mx = fmaxf(mx, S[sub][r]);
    mx = fmaxf(mx, __shfl_xor(mx, 32));
    const float mxs = mx * SL2;
    if (__any(mxs > m + THR)) {
        const float mnew = fmaxf(m, mxs);
        const float alpha = __builtin_amdgcn_exp2f(m - mnew);
        m = mnew; l *= alpha;
#pragma unroll
        for (int dt = 0; dt < DV / 32; dt++)
#pragma unroll
            for (int r = 0; r < 16; r++) O[dt][r] *= alpha;
    }
    float ps = 0.f;
#pragma unroll
    for (int sub = 0; sub < 2; sub++)
#pragma unroll
        for (int r = 0; r < 16; r++) { S[sub][r] = __builtin_amdgcn_exp2f(__builtin_fmaf(S[sub][r], SL2, -m)); ps += S[sub][r]; }
    l += ps;
    bf16x8 pb[2][2];
#pragma unroll
    for (int sub = 0; sub < 2; sub++)
#pragma unroll
        for (int s = 0; s < 2; s++) {
            u32x4 cv;
            cv[0] = pk2(S[sub][8 * s + 0], S[sub][8 * s + 1]); cv[1] = pk2(S[sub][8 * s + 2], S[sub][8 * s + 3]);
            cv[2] = pk2(S[sub][8 * s + 4], S[sub][8 * s + 5]); cv[3] = pk2(S[sub][8 * s + 6], S[sub][8 * s + 7]);
            pb[sub][s] = __builtin_bit_cast(bf16x8, cv);
        }
#pragma unroll
    for (int sub = 0; sub < 2; sub++)
#pragma unroll
        for (int s = 0; s < 2; s++)
#pragma unroll
            for (int dt = 0; dt < DV / 32; dt++) {
                const bf16x8 vf = *(const bf16x8*)(Vl + (dt * 32 + l31) * LROW + (sub * 4 + s * 2 + hh) * 16);
                O[dt] = MFMA(vf, pb[sub][s], O[dt]);
            }
}

template <int DV>
__device__ __forceinline__ void attn_tile_rel(const unsigned char* Kl, const unsigned char* Vl, const bf16x8 (&qf)[4], f32x16 (&O)[DV / 32], float& m, float& l, f32x16& NEGM,
                                              bool first, int l31, int hh, bool domask, int qpos, int kpos0) {
    const float THR = 8.f;
    f32x16 S[2];
#pragma unroll
    for (int sub = 0; sub < 2; sub++) {
        const bf16x8 kf = *(const bf16x8*)(Kl + (sub * 32 + l31) * LROW + hh * 16);
        S[sub] = MFMA(kf, qf[0], NEGM);
    }
#pragma unroll
    for (int kk = 1; kk < 4; kk++)
#pragma unroll
        for (int sub = 0; sub < 2; sub++) {
            const bf16x8 kf = *(const bf16x8*)(Kl + (sub * 32 + l31) * LROW + kk * 32 + hh * 16);
            S[sub] = MFMA(kf, qf[kk], S[sub]);
        }
    if (domask) {
#pragma unroll
        for (int sub = 0; sub < 2; sub++)
#pragma unroll
            for (int r = 0; r < 16; r++) {
                const int d = qpos - (kpos0 + sub * 32 + (r & 3) + 8 * (r >> 2) + 4 * hh);
                S[sub][r] = (d <= 128 && d >= -128) ? S[sub][r] : -1e30f;
            }
    }
    float mx = S[0][0];
#pragma unroll
    for (int sub = 0; sub < 2; sub++)
#pragma unroll
        for (int r = 0; r < 16; r++) mx = fmaxf(mx, S[sub][r]);
    mx = fmaxf(mx, __shfl_xor(mx, 32));
    if (first || __any(mx > THR)) {
        const float d = first ? mx : fmaxf(mx, 0.f);
        const float alpha = __builtin_amdgcn_exp2f(-d);
        m += d; l *= alpha;
#pragma unroll
        for (int dt = 0; dt < DV / 32; dt++)
#pragma unroll
            for (int r = 0; r < 16; r++) O[dt][r] *= alpha;
#pragma unroll
        for (int r = 0; r < 16; r++) NEGM[r] -= d;
#pragma unroll
        for (int sub = 0; sub < 2; sub++)
#pragma unroll
            for (int r = 0; r < 16; r++) S[sub][r] -= d;
    }
    float ps = 0.f;
#pragma unroll
    for (int sub = 0; sub < 2; sub++)
#pragma unroll
        for (int r = 0; r < 16; r++) { S[sub][r] = __builtin_amdgcn_exp2f(S[sub][r]); ps += S[sub][r]; }
    l += ps;
#pragma unroll
    for (int sub = 0; sub < 2; sub++)
#pragma unroll
        for (int s = 0; s < 2; s++) {
            u32x4 cv;
            cv[0] = pk2(S[sub][8 * s + 0], S[sub][8 * s + 1]); cv[1] = pk2(S[sub][8 * s + 2], S[sub][8 * s + 3]);
            cv[2] = pk2(S[sub][8 * s + 4], S[sub][8 * s + 5]); cv[3] = pk2(S[sub][8 * s + 6], S[sub][8 * s + 7]);
            const bf16x8 pb = __builtin_bit_cast(bf16x8, cv);
#pragma unroll
            for (int dt = 0; dt < DV / 32; dt++) {
                const bf16x8 vf = *(const bf16x8*)(Vl + (dt * 32 + l31) * LROW + (sub * 4 + s * 2 + hh) * 16);
                O[dt] = MFMA(vf, pb, O[dt]);
            }
        }
}

template <bool DIFF>
__device__ __forceinline__ void attn_unit(const Params& p, int layer, int mode, int bl, int hidx, int qblk, bool isctx, unsigned char* lds) {
    constexpr int DV = DIFF ? 128 : 64;
    constexpr int NKM = DIFF ? 2 : 1;
    constexpr int KBYTES = NKM * 9216, VBYTES = DV * LROW, BUFB = KBYTES + VBYTES;
    const int tid = opaque_tid(), lane = tid & 63, wave = __builtin_amdgcn_readfirstlane(tid >> 6), l31 = lane & 31, hh = lane >> 5;
    int qcol, kcol, gcol, ucol, tq, head = 0, cm = 0, qs = 0;
    const bf16_t* vt;
    int qpos;
    if (DIFF) {
        cm = wave & 1; qs = wave >> 1;
        qcol = 1280 + hidx * 128 + cm * 64; kcol = 1792 + hidx * 128; gcol = 2816 + hidx * 128; ucol = NTC * 512 + hidx * 128;
        vt = p.VtB() + (size_t)(bl * 4 + hidx) * 128 * TT;
        qpos = qblk * 128 + qs * 32 + l31;
        tq = bl * TT + (isctx ? 0 : CTXL) + qpos;
    } else {
        head = hidx * 4 + (wave & 3);
        qpos = qblk * 64 + (wave >> 2) * 32 + l31;
        if (mode == 0) { qcol = head * 64; kcol = 512 + hidx * 64; gcol = 768 + head * 64; ucol = head * 64; vt = p.VtA() + (size_t)(bl * 2 + hidx) * 64 * TT; }
        else { qcol = 3328 + head * 64; kcol = 3840 + hidx * 64; gcol = 4096 + head * 64; ucol = 2 * NTC * 512 + head * 64; vt = p.VtC() + (size_t)(bl * 2 + hidx) * 64 * TT; }
        tq = bl * TT + (isctx ? 0 : CTXL) + qpos;
    }
    const bool win = (!DIFF) && (mode == 2) && !isctx;
    int n2, start2;
    if (isctx) { n2 = 0; start2 = 0; }
    else if (win) { const int q0 = qblk * 64; int lo = q0 - 128; if (lo < 0) lo = 0; int hi = q0 + 192; if (hi > SEQ) hi = SEQ; n2 = (hi - lo) >> 6; start2 = CTXL + lo; }
    else { n2 = 32; start2 = CTXL; }
    const int ntile = 4 + n2;

    const bf16_t* kp = p.PROJ() + (size_t)(bl * TT) * INW + kcol;
    const int lr = tid >> 3, lc = tid & 7;
    u32x4 kr[NKM], vr[DV / 64];
    bf16x8 qf[4];
    {
        unsigned char* qreg = lds + 73728 + wave * 4608;
        const int tqb = tq - l31;
#pragma unroll
        for (int i = 0; i < 4; i++) {
            const int c = lane + 64 * i, row = c >> 3, ch = c & 7;
            *(u32x4*)(qreg + row * LROW + ch * 16) = *(const u32x4*)(p.PROJ() + (size_t)(tqb + row) * INW + qcol + ch * 8);
        }
#pragma unroll
        for (int kk = 0; kk < 4; kk++) qf[kk] = *(const bf16x8*)(qreg + l31 * LROW + kk * 32 + hh * 16);
    }
    f32x16 O[DV / 32];
#pragma unroll
    for (int dt = 0; dt < DV / 32; dt++)
#pragma unroll
        for (int r = 0; r < 16; r++) O[dt][r] = 0.f;
    float m = DIFF ? -1e30f : 0.f, l = 0.f;
    f32x16 NEGM;
#pragma unroll
    for (int r = 0; r < 16; r++) NEGM[r] = 0.f;

    {
        const int t0 = 0;
#pragma unroll
        for (int i = 0; i < NKM; i++) kr[i] = *(const u32x4*)(kp + (size_t)(t0 + lr) * INW + i * 64 + lc * 8);
#pragma unroll
        for (int i = 0; i < DV / 64; i++) vr[i] = *(const u32x4*)(vt + (size_t)(lr + i * 64) * TT + t0 + lc * 8);
    }
    __syncthreads();
    {
        unsigned char* wb = lds + lr * LROW + lc * 16;
#pragma unroll
        for (int i = 0; i < NKM; i++) *(u32x4*)(wb + i * 9216) = kr[i];
#pragma unroll
        for (int i = 0; i < DV / 64; i++) *(u32x4*)(wb + KBYTES + i * 64 * LROW) = vr[i];
    }
    __syncthreads();
    for (int it = 0; it < ntile; it++) {
        const unsigned char* cur = lds + (it & 1) * BUFB;
        const bool more = (it + 1 < ntile);
        if (more) {
            const int t0 = (it + 1 < 4) ? (it + 1) * 64 : start2 + (it + 1 - 4) * 64;
#pragma unroll
            for (int i = 0; i < NKM; i++) kr[i] = *(const u32x4*)(kp + (size_t)(t0 + lr) * INW + i * 64 + lc * 8);
#pragma unroll
            for (int i = 0; i < DV / 64; i++) vr[i] = *(const u32x4*)(vt + (size_t)(lr + i * 64) * TT + t0 + lc * 8);
        }
        const int tcur = (it < 4) ? it * 64 : start2 + (it - 4) * 64;
        const int rel = (tcur - CTXL) - (DIFF ? 0 : (qblk * 64 + (wave >> 2) * 32));
        if (DIFF) attn_tile<DV>(cur + cm * 9216, cur + KBYTES, qf, O, m, l, l31, hh, false, qpos, tcur - CTXL);
        else attn_tile_rel<DV>(cur, cur + KBYTES, qf, O, m, l, NEGM, it == 0, l31, hh, win && (it >= 4) && (rel < -97 || rel > 65), qpos, tcur - CTXL);
        if (more) {
            unsigned char* wb = lds + ((it + 1) & 1) * BUFB + lr * LROW + lc * 16;
#pragma unroll
            for (int i = 0; i < NKM; i++) *(u32x4*)(wb + i * 9216) = kr[i];
#pragma unroll
            for (int i = 0; i < DV / 64; i++) *(u32x4*)(wb + KBYTES + i * 64 * LROW) = vr[i];
        }
        __syncthreads();
    }
    float lt = l + __shfl_xor(l, 32);
    if (DIFF) {
        const float inv = 1.f / lt;
        float* xb = (float*)lds + qs * 128 * 32;
        if (cm == 1) {
#pragma unroll
            for (int dt = 0; dt < DV / 32; dt++)
#pragma unroll
                for (int r = 0; r < 16; r++) xb[(dt * 32 + (r & 3) + 8 * (r >> 2) + 4 * hh) * 32 + l31] = O[dt][r] * inv;
        }
        __syncthreads();
        if (cm == 0) {
            const float lam = p.LAM()[layer];
            const float om = 1.f - lam_init_of(layer);
            float ss = 0.f;
#pragma unroll
            for (int dt = 0; dt < DV / 32; dt++)
#pragma unroll
                for (int r = 0; r < 16; r++) {
                    const float o = O[dt][r] * inv - lam * xb[(dt * 32 + (r & 3) + 8 * (r >> 2) + 4 * hh) * 32 + l31];
                    O[dt][r] = o; ss += o * o;
                }
            ss += __shfl_xor(ss, 32);
            const float rstd = rsqrtf(ss * (1.f / 128.f) + 1e-5f) * om;
            unsigned char* sreg = lds + 65536 + wave * 9216;
            constexpr int RS = DV * 2 + 16, CPR = DV / 8;
            const int lane_e = opaque_tid() & 63;
            const int tqb = tq - l31;
#pragma unroll
            for (int i = 0; i < DV / 16; i++) {
                const int c = lane_e + 64 * i, row = c / CPR, ch = c % CPR;
                *(u32x4*)(sreg + row * RS + ch * 16) = *(const u32x4*)(p.PROJ() + (size_t)(tqb + row) * INW + gcol + ch * 8);
                if ((i & 1) == 1) asm volatile("" ::: "memory");
            }
#pragma unroll
            for (int dt = 0; dt < DV / 32; dt++)
#pragma unroll
                for (int rg = 0; rg < 4; rg++) {
                    const int d0 = dt * 32 + rg * 8 + hh * 4;
                    const float4 sg = *(const float4*)(p.subln + layer * 128 + d0);
                    u32x2* sp = (u32x2*)(sreg + l31 * RS + d0 * 2);
                    const u32x2 gw = *sp;
                    const float o0 = O[dt][rg * 4 + 0] * rstd * sg.x * bflo(gw[0]), o1 = O[dt][rg * 4 + 1] * rstd * sg.y * bfhi(gw[0]);
                    const float o2 = O[dt][rg * 4 + 2] * rstd * sg.z * bflo(gw[1]), o3 = O[dt][rg * 4 + 3] * rstd * sg.w * bfhi(gw[1]);
                    *sp = (u32x2){pk2(o0, o1), pk2(o2, o3)};
                }
#pragma unroll
            for (int i = 0; i < DV / 16; i++) {
                const int c = lane_e + 64 * i, row = c / CPR, ch = c % CPR;
                *(u32x4*)(p.U() + (size_t)(tqb + row) * 512 + ucol + ch * 8) = *(const u32x4*)(sreg + row * RS + ch * 16);
                if ((i & 1) == 1) asm volatile("" ::: "memory");
            }
        }
    } else {
        float a = 1.f;
        if (mode == 2) {
            const float s2 = p.sink[layer * 8 + head] * LOG2E;
            const float mf = fmaxf(m, s2);
            a = __builtin_amdgcn_exp2f(m - mf);
            lt = lt * a + __builtin_amdgcn_exp2f(s2 - mf);
        }
        const float inv = a / lt;
        unsigned char* sreg = lds + 65536 + wave * 9216;
        constexpr int RS = DV * 2 + 16, CPR = DV / 8;
        const int lane_e = opaque_tid() & 63;
        const int tqb = tq - l31;
#pragma unroll
        for (int i = 0; i < DV / 16; i++) {
            const int c = lane_e + 64 * i, row = c / CPR, ch = c % CPR;
            *(u32x4*)(sreg + row * RS + ch * 16) = *(const u32x4*)(p.PROJ() + (size_t)(tqb + row) * INW + gcol + ch * 8);
        }
#pragma unroll
        for (int dt = 0; dt < DV / 32; dt++)
#pragma unroll
            for (int rg = 0; rg < 4; rg++) {
                const int d0 = dt * 32 + rg * 8 + hh * 4;
                u32x2* sp = (u32x2*)(sreg + l31 * RS + d0 * 2);
                const u32x2 gw = *sp;
                const float o0 = O[dt][rg * 4 + 0] * inv * bflo(gw[0]), o1 = O[dt][rg * 4 + 1] * inv * bfhi(gw[0]);
                const float o2 = O[dt][rg * 4 + 2] * inv * bflo(gw[1]), o3 = O[dt][rg * 4 + 3] * inv * bfhi(gw[1]);
                *sp = (u32x2){pk2(o0, o1), pk2(o2, o3)};
            }
#pragma unroll
        for (int i = 0; i < DV / 16; i++) {
            const int c = lane_e + 64 * i, row = c / CPR, ch = c % CPR;
            *(u32x4*)(p.U() + (size_t)(tqb + row) * 512 + ucol + ch * 8) = *(const u32x4*)(sreg + row * RS + ch * 16);
        }
    }
}

__device__ __forceinline__ void phase_attn(const Params& p, int layer, unsigned char* lds) {
    const int nunits = 1536 + ((layer < NLAY - 1) ? 192 : 0);
    for (int u = blockIdx.x; u < nunits; u += gridDim.x) {
        int mode, bl, hidx, qb; bool isctx;
        if (u < 512) { const int x = u & 7, rest = u >> 3; qb = rest & 15; const int combo = (rest >> 4) * 8 + x; mode = 1; bl = combo >> 2; hidx = combo & 3; isctx = false; }
        else if (u < 1536) { const int u2 = (u - 512) & 511; const int x = u2 & 7, rest = u2 >> 3; qb = rest & 31; const int combo = (rest >> 5) * 8 + x;
            mode = (u < 1024) ? 0 : 2; bl = combo >> 1; hidx = combo & 1; isctx = false; }
        else if (u < 1600) { const int u2 = u - 1536; qb = u2 & 1; const int combo = u2 >> 1; mode = 1; bl = combo >> 2; hidx = combo & 3; isctx = true; }
        else { const int u2 = (u - 1600) & 63; qb = u2 & 3; const int combo = u2 >> 2; mode = (u < 1664) ? 0 : 2; bl = combo >> 1; hidx = combo & 1; isctx = true; }
        __syncthreads();
        if (mode == 1) attn_unit<true>(p, layer, mode, bl, hidx, qb, isctx, lds);
        else attn_unit<false>(p, layer, mode, bl, hidx, qb, isctx, lds);
    }
}

__device__ __forceinline__ float ub(unsigned w, int j) { return (float)((w >> (8 * j)) & 0xffu); }
struct GateHook {
    const unsigned char* G; int tok0, feat0;
    __device__ __forceinline__ void operator()(int seg, f32x4 (&acc)[2][2][4][2]) const {
        const int tid2 = opaque_tid(), lane2 = tid2 & 63, wid2 = __builtin_amdgcn_readfirstlane(tid2 >> 6), wr = wid2 >> 2, wc = wid2 & 3, fr = lane2 & 15, fq = lane2 >> 4;
#pragma unroll
        for (int bj = 0; bj < 2; bj++)
#pragma unroll
            for (int n = 0; n < 2; n++) {
                const int tk = tok0 + bj * 128 + wc * 32 + n * 16 + fr;
                const unsigned char* gprev = G + (size_t)tk * 3072 + (seg - 1) * 1024 + feat0 + wr * 64 + fq * 16;
#pragma unroll
                for (int ai = 0; ai < 2; ai++) {
                    const u32x4 gp = *(const u32x4*)(gprev + ai * 128), gn = *(const u32x4*)(gprev + 1024 + ai * 128);
#pragma unroll
                    for (int m = 0; m < 4; m++) {
                        f32x4& v = acc[ai][bj][m][n];
                        v[0] *= ub(gp[m], 0) * __builtin_amdgcn_rcpf(ub(gn[m], 0)); v[1] *= ub(gp[m], 1) * __builtin_amdgcn_rcpf(ub(gn[m], 1));
                        v[2] *= ub(gp[m], 2) * __builtin_amdgcn_rcpf(ub(gn[m], 2)); v[3] *= ub(gp[m], 3) * __builtin_amdgcn_rcpf(ub(gn[m], 3));
                    }
                }
            }
    }
};

__device__ __forceinline__ void phase_gemm2(const Params& p, int layer, LAS unsigned char* lds) {
    const int tid = opaque_tid(), wid = __builtin_amdgcn_readfirstlane(tid >> 6), wr = wid >> 2, wc = wid & 3;
    const int ntiles = (layer == NLAY - 1) ? 256 : 288;
    for (int L = blockIdx.x; L < ntiles; L += gridDim.x) {
        const int mt = panel_of(L >> 2), nt = L & 3;
        f32x4 acc[2][2][4][2];
        GateHook hk; hk.G = (const unsigned char*)p.G(); hk.tok0 = mt * 256; hk.feat0 = nt * 256;
        gemm256<512, 512, 8, GateHook>(p.Wbrt() + (size_t)(layer * 3) * DM * 512, p.U(), 1536, nt * 256, mt * 256, acc, lds,
                                       (size_t)DM * 512 * 2, (size_t)NTC * 512 * 2, hk);
        const int tid2 = opaque_tid(), lane2 = tid2 & 63, fr = lane2 & 15, fq = lane2 >> 4;
#pragma unroll
        for (int ai = 0; ai < 2; ai++) {
            const int f0 = nt * 256 + ai * 128 + wr * 64;
            epi_store_rows<true>(lds, wid, lane2, fr, fq, wc, mt, p.Mb() + f0, DM, [&](int bj, int n, int m) -> u32x2 {
                const int tk = mt * 256 + bj * 128 + wc * 32 + n * 16 + fr;
                const unsigned gw = *(const unsigned*)((const unsigned char*)p.G() + (size_t)tk * 3072 + 2048 + f0 + fq * 16 + m * 4);
                const f32x4 v = acc[ai][bj][m][n] * (1.f / 255.f);
                return (u32x2){pk2(v[0] * ub(gw, 0), v[1] * ub(gw, 1)), pk2(v[2] * ub(gw, 2), v[3] * ub(gw, 3))};
            });
        }
        asm volatile("s_waitcnt vmcnt(0)" ::: "memory");
        __syncthreads();
        if (threadIdx.x == 0) {
            __builtin_amdgcn_fence(__ATOMIC_RELEASE, "agent");
            asm volatile("s_waitcnt vmcnt(0)" ::: "memory");
            xb_add(&p.BAR()[G23_PC(mt)], 1u);
        }
    }
}

__device__ __forceinline__ void phase_gemm3(const Params& p, int layer, int inst, LAS unsigned char* lds, volatile LAS unsigned* bst) {
    const int tid = opaque_tid(), wid = __builtin_amdgcn_readfirstlane(tid >> 6), wr = wid >> 2, wc = wid & 3;
    const unsigned nvalid = (layer == NLAY - 1) ? 256u : 288u;
    for (;;) {
        __syncthreads();
        if (threadIdx.x == 0) {
            const unsigned tk = xb_add(&p.BAR()[G23_TK], 1u) - (544u * (unsigned)inst - (inst > 3 ? 32u : 0u));
            if (tk < nvalid) {
                const int pmt = panel_of((int)(tk >> 2));
                unsigned* pc = &p.BAR()[G23_PC(pmt)];
                const unsigned want = panel_want(pmt, inst);
                XB_SPIN_SLOW(xb_ld(pc) < want, p.BAR());
                __builtin_amdgcn_fence(__ATOMIC_ACQUIRE, "agent");
                asm volatile("s_waitcnt vmcnt(0)" ::: "memory");
            }
            bst[2] = tk;
        }
        __syncthreads();
        const unsigned L = (unsigned)__builtin_amdgcn_readfirstlane((int)bst[2]);
        if (L >= nvalid) break;
        const int mt = panel_of((int)(L >> 2)), nt = (int)(L & 3u);
        f32x4 acc[2][2][4][2];
        gemm256<DM, DM>(p.Woutt() + (size_t)layer * DM * DM, p.Mb(), DM, nt * 256, mt * 256, acc, lds);
        const int tid2 = opaque_tid(), lane2 = tid2 & 63, fr = lane2 & 15, fq = lane2 >> 4;
#pragma unroll
        for (int ai = 0; ai < 2; ai++)
            epi_store_rows(lds, wid, lane2, fr, fq, wc, mt, (bf16_t*)p.Y() + nt * 256 + ai * 128 + wr * 64, DM, [&](int bj, int n, int m) -> u32x2 {
                const f32x4 v = acc[ai][bj][m][n];
                return (u32x2){pk2(v[0], v[1]), pk2(v[2], v[3])};
            });
        asm volatile("s_waitcnt vmcnt(0)" ::: "memory");
        __syncthreads();
        if (threadIdx.x == 0) {
            __builtin_amdgcn_fence(__ATOMIC_RELEASE, "agent");
            asm volatile("s_waitcnt vmcnt(0)" ::: "memory");
            xb_add(&p.BAR()[G23_PC2(mt)], 1u);
        }
    }
}

__global__ void __launch_bounds__(512, 2) fwd_kernel(Params p) {
    extern __shared__ __attribute__((aligned(16))) unsigned char lds[];
    cg::grid_group grid = cg::this_grid();
    volatile LAS unsigned* bst = (volatile LAS unsigned*)((LAS unsigned char*)lds + LDS_BYTES);
    if (threadIdx.x == 0) { bst[0] = 0u; bst[1] = 0u; }
    __syncthreads();
    (void)xcd_barrier_post(p.BAR(), bst);
    phase_pro_a(p, lds);
    grid.sync();
    phase_pro_b(p);
    xcd_barrier(p.BAR(), bst);
    for (int chunk = 0; chunk < NB / CB; chunk++) {
        phase_norm(p, chunk, -1);
        xcd_barrier(p.BAR(), bst);
        for (int layer = 0; layer < NLAY; layer++) {
            phase_gemm1(p, layer, (LAS unsigned char*)lds);
            xcd_barrier(p.BAR(), bst);
            phase_attn(p, layer, lds);
            xcd_barrier(p.BAR(), bst);
            phase_gemm2(p, layer, (LAS unsigned char*)lds);
            phase_gemm3(p, layer, chunk * NLAY + layer, (LAS unsigned char*)lds, bst);
            phase_norm_ticketed(p, chunk, layer, chunk * NLAY + layer, bst);
            xcd_barrier(p.BAR(), bst);
        }
    }
}

extern "C" void kernel_launch(void* const* d_in, const int* in_sizes, int n_in, void* d_out, int out_size, void* d_ws, size_t ws_size, hipStream_t stream) {
    static int grid_blocks = 0;
    if (!grid_blocks) {
        int dev = 0, cus = 0, per_cu = 0;
        hipGetDevice(&dev);
        hipDeviceGetAttribute(&cus, hipDeviceAttributeMultiprocessorCount, dev);
        hipFuncSetAttribute((const void*)fwd_kernel, hipFuncAttributeMaxDynamicSharedMemorySize, LDS_BYTES + 16);
        hipOccupancyMaxActiveBlocksPerMultiprocessor(&per_cu, (const void*)fwd_kernel, NTHR, LDS_BYTES + 16);
        if (per_cu < 1) per_cu = 1;
        if (per_cu > 1) per_cu = 1;
        grid_blocks = cus * per_cu;
    }
    Params p{};
    const float* const* in = (const float* const*)d_in;
    p.x = in[0]; p.c = in[1]; p.ctx = in[2]; p.c_ctx = in[3]; p.w_ada = in[4]; p.b_ada = in[5]; p.g_pre = in[6]; p.g_post = in[7];
    p.w_in = in[8]; p.q_norm = in[9]; p.k_norm = in[10]; p.lam_q1 = in[11]; p.lam_k1 = in[12]; p.lam_q2 = in[13]; p.lam_k2 = in[14];
    p.subln = in[15]; p.sink = in[16]; p.w_br_a = in[17]; p.w_br_b = in[18]; p.w_br_c = in[19]; p.w_mg = in[20]; p.b_mg = in[21]; p.w_out = in[22];
    p.out = (float*)d_out;
    p.ws = (unsigned char*)d_ws;
    if (WS_END > ws_size) { fprintf(stderr, "kernel_launch: workspace too small: need %zu, have %zu\n", (size_t)WS_END, ws_size); return; }
    hipMemsetAsync((unsigned char*)d_ws + OFF_BAR, 0, ALL_BAR_WORDS * 4, stream);
    void* args[] = {&p};
    hipError_t e = hipLaunchCooperativeKernel((void*)fwd_kernel, dim3(grid_blocks), dim3(NTHR), args, LDS_BYTES + 16, stream);
    if (e != hipSuccess) fprintf(stderr, "cooperative launch failed: %s (grid %d)\n", hipGetErrorString(e), grid_blocks);
}
```

```cpp
#include <hip/hip_runtime.h>
#include <hip/hip_cooperative_groups.h>
#include <cstdio>
#include <cstdint>
namespace cg = cooperative_groups;

typedef unsigned short bf16_t;
typedef short bf16x8 __attribute__((ext_vector_type(8)));
typedef float f32x16 __attribute__((ext_vector_type(16)));
typedef unsigned u32x4 __attribute__((ext_vector_type(4)));
typedef float f32x4 __attribute__((ext_vector_type(4)));
typedef unsigned u32x2 __attribute__((ext_vector_type(2)));

constexpr int NB = 16, SEQ = 2048, CTXL = 256, TT = 2304, DM = 1024, NLAY = 4, INW = 4608, N1 = 7680;
constexpr int CB = 8, NTC = CB * TT;
constexpr int LDS_BYTES = 147456;
constexpr int NTHR = 512;
constexpr int LROW = 144;
constexpr float LOG2E = 1.4426950408889634f;

#define MFMA(a, b, c) __builtin_amdgcn_mfma_f32_32x32x16_bf16((a), (b), (c), 0, 0, 0)

constexpr size_t al256(size_t x) { return (x + 255) & ~(size_t)255; }
constexpr size_t OFF_W1T = 0;
constexpr size_t OFF_WBRT = OFF_W1T + al256((size_t)NLAY * N1 * DM * 2);
constexpr size_t OFF_WOUTT = OFF_WBRT + al256((size_t)NLAY * 3 * DM * 512 * 2);
constexpr size_t OFF_MODP = OFF_WOUTT + al256((size_t)NLAY * DM * DM * 2);
constexpr size_t OFF_MOD = OFF_MODP + al256((size_t)8 * NLAY * 17 * 3072 * 4);
constexpr size_t OFF_ROPE = OFF_MOD + al256((size_t)NLAY * 17 * 3072 * 4);
constexpr size_t OFF_LAM = OFF_ROPE + al256(64 * 16 * 2 * 4);
constexpr size_t OFF_BAR = OFF_LAM + 256;
constexpr size_t OFF_CX = OFF_BAR + al256((size_t)16384 * 4);
constexpr size_t OFF_H = OFF_CX + al256((size_t)NB * CTXL * DM * 4);
constexpr size_t OFF_U = OFF_H + al256((size_t)NTC * DM * 2);
constexpr size_t OFF_PROJ = OFF_U + al256((size_t)NTC * 1536 * 2);
constexpr size_t OFF_VTA = OFF_PROJ + al256((size_t)NTC * INW * 2);
constexpr size_t OFF_VTB = OFF_VTA + al256((size_t)CB * 2 * 64 * TT * 2);
constexpr size_t OFF_VTC = OFF_VTB + al256((size_t)CB * 4 * 128 * TT * 2);
constexpr size_t OFF_G = OFF_VTC + al256((size_t)CB * 2 * 64 * TT * 2);
constexpr size_t WS_END = OFF_G + al256((size_t)NTC * 3072 * 2);
constexpr size_t OFF_MB = OFF_PROJ;
constexpr size_t OFF_Y = OFF_PROJ + (size_t)NTC * DM * 2;

struct Params {
    const float *x, *c, *ctx, *c_ctx, *w_ada, *b_ada, *g_pre, *g_post, *w_in, *q_norm, *k_norm;
    const float *lam_q1, *lam_k1, *lam_q2, *lam_k2, *subln, *sink, *w_br_a, *w_br_b, *w_br_c, *w_mg, *b_mg, *w_out;
    float* out;
    unsigned char* ws;
    __device__ __forceinline__ bf16_t* W1t() const { return (bf16_t*)(ws + OFF_W1T); }
    __device__ __forceinline__ bf16_t* Wbrt() const { return (bf16_t*)(ws + OFF_WBRT); }
    __device__ __forceinline__ bf16_t* Woutt() const { return (bf16_t*)(ws + OFF_WOUTT); }
    __device__ __forceinline__ float* MODP() const { return (float*)(ws + OFF_MODP); }
    __device__ __forceinline__ float* MOD() const { return (float*)(ws + OFF_MOD); }
    __device__ __forceinline__ float* ROPE() const { return (float*)(ws + OFF_ROPE); }
    __device__ __forceinline__ float* LAM() const { return (float*)(ws + OFF_LAM); }
    __device__ __forceinline__ unsigned* BAR() const { return (unsigned*)(ws + OFF_BAR); }
    __device__ __forceinline__ float* CX() const { return (float*)(ws + OFF_CX); }
    __device__ __forceinline__ bf16_t* H() const { return (bf16_t*)(ws + OFF_H); }
    __device__ __forceinline__ bf16_t* U() const { return (bf16_t*)(ws + OFF_U); }
    __device__ __forceinline__ bf16_t* PROJ() const { return (bf16_t*)(ws + OFF_PROJ); }
    __device__ __forceinline__ bf16_t* VtA() const { return (bf16_t*)(ws + OFF_VTA); }
    __device__ __forceinline__ bf16_t* VtB() const { return (bf16_t*)(ws + OFF_VTB); }
    __device__ __forceinline__ bf16_t* VtC() const { return (bf16_t*)(ws + OFF_VTC); }
    __device__ __forceinline__ bf16_t* G() const { return (bf16_t*)(ws + OFF_G); }
    __device__ __forceinline__ bf16_t* Mb() const { return (bf16_t*)(ws + OFF_MB); }
    __device__ __forceinline__ float* Y() const { return (float*)(ws + OFF_Y); }
};

typedef __bf16 bf16x2_t __attribute__((ext_vector_type(2)));
typedef float f32x2_t __attribute__((ext_vector_type(2)));
__device__ __forceinline__ unsigned pk2(float lo, float hi) { const f32x2_t f = {lo, hi}; const bf16x2_t b = __builtin_convertvector(f, bf16x2_t); return __builtin_bit_cast(unsigned, b); }
__device__ __forceinline__ float bflo(unsigned w) { return __uint_as_float(w << 16); }
__device__ __forceinline__ float bfhi(unsigned w) { return __uint_as_float(w & 0xffff0000u); }
__device__ __forceinline__ float sigmoid_f(float v) { return __builtin_amdgcn_rcpf(1.f + __builtin_amdgcn_exp2f(-LOG2E * v)); }
__device__ __forceinline__ float silu_f(float v) { return v * sigmoid_f(v); }
__device__ __forceinline__ float wave_sum(float v) {
    v += __shfl_xor(v, 32); v += __shfl_xor(v, 16); v += __shfl_xor(v, 8); v += __shfl_xor(v, 4); v += __shfl_xor(v, 2); v += __shfl_xor(v, 1); return v;
}
__device__ __forceinline__ int opaque_tid() { int t = threadIdx.x; asm volatile("" : "+v"(t)); return t; }
__device__ __forceinline__ float lam_init_of(int l) { return 0.8f - 0.6f * expf(-0.3f * (float)l); }


#define XB_TMO      128
#define XB_XCNT(j)  (256  + 64 * (j))
#define XB_XSUB(j)  (1280 + 64 * (j))
#define XB_XGEN(j)  (2304 + 64 * (j))
#define XB_TOP      3328
#define XB_TOPGEN   3392
#define XCD_BAR_WORDS 3456
#define G23_PC(mt)   (XCD_BAR_WORDS + 64 * (mt))
#define G23_TK       (XCD_BAR_WORDS + 64 * 72)
#define G23_PC2(mt)  (XCD_BAR_WORDS + 64 * 73 + 64 * (mt))
#define G23_TK2      (XCD_BAR_WORDS + 64 * 145)
#define ALL_BAR_WORDS (XCD_BAR_WORDS + 64 * 146)
#define XB_SPIN_CAP (1u << 18)
#define LAS __attribute__((address_space(3)))
__device__ __forceinline__ unsigned xb_ld(unsigned* p)              { return __hip_atomic_load(p, __ATOMIC_RELAXED, __HIP_MEMORY_SCOPE_AGENT); }
__device__ __forceinline__ unsigned xb_add(unsigned* p, unsigned v) { return __hip_atomic_fetch_add(p, v, __ATOMIC_RELAXED, __HIP_MEMORY_SCOPE_AGENT); }
__device__ __forceinline__ unsigned xb_xcc_id() { return (unsigned)__builtin_amdgcn_s_getreg((3 << 11) | 20) & 0xFu; }
#define XB_SPIN(cond, bar) do { unsigned _sp = 0; while (cond) { __builtin_amdgcn_s_sleep(1); \
    if ((++_sp & 255u) == 0u) { if (xb_ld(&(bar)[XB_TMO])) break; if (_sp > XB_SPIN_CAP) { atomicAdd(&(bar)[XB_TMO], 1u); break; } } } } while (0)
#define XB_SPIN_SLOW(cond, bar) do { unsigned _sp = 0; while (cond) { __builtin_amdgcn_s_sleep(32); \
    if ((++_sp & 63u) == 0u) { if (xb_ld(&(bar)[XB_TMO])) break; if (_sp > (1u << 17)) { atomicAdd(&(bar)[XB_TMO], 1u); break; } } } } while (0)
struct XcdBarrier { unsigned* bar; unsigned x; volatile LAS unsigned* st; };
__device__ __forceinline__ XcdBarrier xcd_barrier_post(unsigned* bar, volatile LAS unsigned* st) {
    XcdBarrier b; b.bar = bar; b.x = xb_xcc_id(); b.st = st;
    if (threadIdx.x == 0) (void)xb_add(&bar[XB_XCNT(b.x)], 1u);
    return b;
}
__device__ __forceinline__ void xcd_barrier_complete(unsigned* bar, unsigned x, unsigned& nloc, unsigned& nx) {
    const unsigned G = gridDim.x * gridDim.y * gridDim.z;
    unsigned sum, cnt, mine, sp = 0u;
    for (;;) {
        sum = 0u; cnt = 0u; mine = 0u;
#pragma unroll
        for (unsigned j = 0; j < 16; ++j) { const unsigned c = xb_ld(&bar[XB_XCNT(j)]); sum += c; cnt += (c > 0u) ? 1u : 0u; mine = (j == x) ? c : mine; }
        if (sum == G) break;
        __builtin_amdgcn_s_sleep(1);
        if ((++sp & 255u) == 0u) { if (xb_ld(&bar[XB_TMO])) break; if (sp > XB_SPIN_CAP) { atomicAdd(&bar[XB_TMO], 1u); break; } }
    }
    nloc = mine > 0u ? mine : 1u; nx = cnt > 0u ? cnt : 1u;
}
__device__ __forceinline__ void xcd_barrier(unsigned* bar_, volatile LAS unsigned* st_) {
    XcdBarrier b; b.bar = bar_; b.x = xb_xcc_id(); b.st = st_;
    asm volatile("s_waitcnt vmcnt(0)" ::: "memory");
    __syncthreads();
    if (threadIdx.x == 0) {
        unsigned* bar = b.bar;
        __builtin_amdgcn_s_waitcnt(0);
        unsigned nloc = b.st[0], nx = b.st[1];
        if (nloc == 0u) { xcd_barrier_complete(bar, b.x, nloc, nx); b.st[0] = nloc; b.st[1] = nx; }
        const unsigned old = xb_add(&bar[XB_XSUB(b.x)], 1u);
        const unsigned gen = old / nloc;
        if (old + 1u == (gen + 1u) * nloc) {
            __builtin_amdgcn_fence(__ATOMIC_RELEASE, "agent");
            asm volatile("s_waitcnt vmcnt(0)" ::: "memory");
            const unsigned og = xb_add(&bar[XB_TOP], 1u);
            const unsigned tg = og / nx;
            if (og + 1u == (tg + 1u) * nx) xb_add(&bar[XB_TOPGEN], 1u);
            else XB_SPIN(xb_ld(&bar[XB_TOPGEN]) == tg, bar);
            __builtin_amdgcn_fence(__ATOMIC_ACQUIRE, "agent");
            xb_add(&bar[XB_XGEN(b.x)], 1u);
            asm volatile("s_waitcnt vmcnt(0)" ::: "memory");
        } else {
            XB_SPIN(xb_ld(&bar[XB_XGEN(b.x)]) == gen, bar);
            __builtin_amdgcn_fence(__ATOMIC_ACQUIRE, "agent");
            asm volatile("s_waitcnt vmcnt(0)" ::: "memory");
        }
    }
    __syncthreads();
}

template <int NY>
__device__ __forceinline__ void gemm_tile(const bf16_t* __restrict__ X, int ldx, const bf16_t* __restrict__ Y, int ldy, int K,
                                          f32x16 (&acc)[2][NY], unsigned char* lds, int tid) {
    const int lane = tid & 63, wave = tid >> 6, wm = wave >> 1, wn = wave & 1, l31 = lane & 31, hh = lane >> 5;
    const int lrow = tid >> 3, lc = tid & 7;
    const bf16_t* gx = X + (size_t)lrow * ldx + lc * 8;
    const bf16_t* gy = Y + (size_t)lrow * ldy + lc * 8;
    u32x4 rx[4], ry[2 * NY];
#pragma unroll
    for (int i = 0; i < 4; i++) rx[i] = *(const u32x4*)(gx + (size_t)(32 * i) * ldx);
#pragma unroll
    for (int i = 0; i < 2 * NY; i++) ry[i] = *(const u32x4*)(gy + (size_t)(32 * i) * ldy);
    __syncthreads();
    unsigned char* wx = lds + lrow * LROW + lc * 16;
#pragma unroll
    for (int i = 0; i < 4; i++) *(u32x4*)(wx + i * 32 * LROW) = rx[i];
#pragma unroll
    for (int i = 0; i < 2 * NY; i++) *(u32x4*)(wx + 18432 + i * 32 * LROW) = ry[i];
    __syncthreads();
    const int nk = K >> 6;
    const unsigned char* rxb = lds + (wm * 64 + l31) * LROW + hh * 16;
    const unsigned char* ryb = lds + 18432 + (wn * 32 * NY + l31) * LROW + hh * 16;
    for (int kt = 0; kt < nk; kt++) {
        const int cur = (kt & 1) * 36864;
        const bool more = (kt + 1 < nk);
        if (more) {
            const int ko = (kt + 1) * 64;
#pragma unroll
            for (int i = 0; i < 4; i++) rx[i] = *(const u32x4*)(gx + (size_t)(32 * i) * ldx + ko);
#pragma unroll
            for (int i = 0; i < 2 * NY; i++) ry[i] = *(const u32x4*)(gy + (size_t)(32 * i) * ldy + ko);
        }
#pragma unroll
        for (int kk = 0; kk < 4; kk++) {
            bf16x8 xf[2], yf[NY];
            xf[0] = *(const bf16x8*)(rxb + cur + kk * 32);
            xf[1] = *(const bf16x8*)(rxb + cur + 32 * LROW + kk * 32);
#pragma unroll
            for (int yi = 0; yi < NY; yi++) yf[yi] = *(const bf16x8*)(ryb + cur + yi * 32 * LROW + kk * 32);
#pragma unroll
            for (int xi = 0; xi < 2; xi++)
#pragma unroll
                for (int yi = 0; yi < NY; yi++) acc[xi][yi] = MFMA(xf[xi], yf[yi], acc[xi][yi]);
        }
        if (more) {
            unsigned char* w2 = wx + (36864 - cur);
#pragma unroll
            for (int i = 0; i < 4; i++) *(u32x4*)(w2 + i * 32 * LROW) = rx[i];
#pragma unroll
            for (int i = 0; i < 2 * NY; i++) *(u32x4*)(w2 + 18432 + i * 32 * LROW) = ry[i];
        }
        __syncthreads();
    }
}

template <int NY>
__device__ __forceinline__ void zero_acc(f32x16 (&acc)[2][NY]) {
#pragma unroll
    for (int a = 0; a < 2; a++)
#pragma unroll
        for (int b = 0; b < NY; b++)
#pragma unroll
            for (int r = 0; r < 16; r++) acc[a][b][r] = 0.f;
}

template <bool PERM = false>
__device__ __forceinline__ void transpose_tile(const float* __restrict__ src, int ldsrc, bf16_t* __restrict__ dst, int lddst, int k0, int n0, float* tile) {
    const int tid = opaque_tid();
    __syncthreads();
#pragma unroll
    for (int i = 0; i < 2; i++) {
        const int id = tid + i * 512, r = id >> 4, c4 = id & 15;
        const float4 v = *(const float4*)(src + (size_t)(k0 + r) * ldsrc + n0 + c4 * 4);
        float* tp = tile + r * 65 + c4 * 4;
        tp[0] = v.x; tp[1] = v.y; tp[2] = v.z; tp[3] = v.w;
    }
    __syncthreads();
    const int n = tid >> 3, kq = tid & 7;
    u32x4 w;
#pragma unroll
    for (int j = 0; j < 4; j++) w[j] = pk2(tile[(kq * 8 + 2 * j) * 65 + n], tile[(kq * 8 + 2 * j + 1) * 65 + n]);
    const int nrow = PERM ? (((n >> 2) & 3) * 16 + ((n >> 4) & 3) * 4 + (n & 3)) : n;
    *(u32x4*)(dst + (size_t)(n0 + nrow) * lddst + k0 + kq * 8) = w;
}

__device__ __forceinline__ int nb2ob(int nb) {
    if (nb < 4) return nb;
    if (nb == 4) return 4;
    if (nb == 5) return 30;
    if (nb == 6) return 5;
    if (nb == 7) return 31;
    if (nb < 32) return nb - 2;
    return nb;
}

__device__ __forceinline__ void phase_pro_a(const Params& p, unsigned char* lds) {
    const int tid = opaque_tid();
    float* tile = (float*)lds;
    const int NCONV = 2560 * NLAY;
    for (int j = blockIdx.x; j < NCONV + 192; j += gridDim.x) {
        if (j < NCONV) {
            const int l = j / 2560; int r = j - l * 2560;
            if (r < 1920) {
                const int kt = r / 120, nt = r - kt * 120;
                const int ob = nb2ob(nt >> 1), oc = ob * 128 + (nt & 1) * 64;
                bf16_t* dstw = p.W1t() + ((size_t)l * N1 + nt * 64) * DM;
                if (oc < INW) transpose_tile(p.w_in + (size_t)l * DM * INW + oc, INW, dstw, DM, kt * 64, 0, tile);
                else transpose_tile(p.w_mg + (size_t)l * DM * 3072 + (oc - INW), 3072, dstw, DM, kt * 64, 0, tile);
            }
            else if (r < 2304) { r -= 1920; const int which = r >> 7; r &= 127; const int kt = r >> 4, nt = r & 15;
                bf16_t* dstw = p.Wbrt() + (size_t)(l * 3 + which) * DM * 512;
                if (which == 0) transpose_tile<true>(p.w_br_a + (size_t)l * 512 * DM, DM, dstw, 512, kt * 64, nt * 64, tile);
                else if (which == 1) transpose_tile<true>(p.w_br_b + (size_t)l * 512 * DM, DM, dstw, 512, kt * 64, nt * 64, tile);
                else transpose_tile<true>(p.w_br_c + (size_t)l * 512 * DM, DM, dstw, 512, kt * 64, nt * 64, tile); }
            else { r -= 2304; const int kt = r >> 4, nt = r & 15;
                transpose_tile(p.w_out + (size_t)l * DM * DM, DM, p.Woutt() + (size_t)l * DM * DM, DM, kt * 64, nt * 64, tile); }
        } else {
            const int jj = j - NCONV; const int l = jj / 48; const int rr = jj - l * 48; const int kc = rr / 6, jb = rr - kc * 6;
            float* sc = (float*)lds;
            __syncthreads();
            for (int idx = tid; idx < 17 * 128; idx += NTHR) {
                const int r = idx >> 7, k = idx & 127;
                const float v = (r < 16) ? p.c[r * DM + kc * 128 + k] : p.c_ctx[kc * 128 + k];
                sc[idx] = v / (1.f + expf(-v));
            }
            __syncthreads();
            float a[17];
#pragma unroll
            for (int r = 0; r < 17; r++) a[r] = 0.f;
            const float* w = p.w_ada + ((size_t)l * DM + kc * 128) * 3072 + jb * NTHR + tid;
            for (int k = 0; k < 128; k++) {
                const float wv = w[(size_t)k * 3072];
#pragma unroll
                for (int r = 0; r < 17; r++) a[r] += sc[r * 128 + k] * wv;
            }
#pragma unroll
            for (int r = 0; r < 17; r++) p.MODP()[((size_t)(kc * 4 + l) * 17 + r) * 3072 + jb * NTHR + tid] = a[r];
        }
    }
}

__device__ const double ROPE_FREQ[16] = {1.0, 0.5623413251903491, 0.31622776601683794, 0.1778279410038923, 0.1, 0.05623413251903491,
    0.031622776601683794, 0.01778279410038923, 0.01, 0.005623413251903491, 0.0031622776601683794, 0.001778279410038923,
    0.001, 0.0005623413251903491, 0.00031622776601683794, 0.0001778279410038923};

__device__ __forceinline__ void sincos_d(double a, double& s, double& c) {
    const double n = rint(a * 0.6366197723675814);
    double r = fma(-n, 1.5707963267948966, a); r = fma(-n, 6.123233995736766e-17, r);
    const double r2 = r * r;
    const double sp = r * (1.0 + r2 * (-1.0 / 6.0 + r2 * (1.0 / 120.0 + r2 * (-1.0 / 5040.0 + r2 * (1.0 / 362880.0 + r2 * (-1.0 / 39916800.0 + r2 * (1.0 / 6227020800.0 + r2 * (-1.0 / 1307674368000.0))))))));
    const double cp = 1.0 + r2 * (-0.5 + r2 * (1.0 / 24.0 + r2 * (-1.0 / 720.0 + r2 * (1.0 / 40320.0 + r2 * (-1.0 / 3628800.0 + r2 * (1.0 / 479001600.0 + r2 * (-1.0 / 87178291200.0 + r2 * (1.0 / 20922789888000.0))))))));
    const int q = ((int)n) & 3;
    if (q == 0) { s = sp; c = cp; } else if (q == 1) { s = cp; c = -sp; } else if (q == 2) { s = -sp; c = -cp; } else { s = -cp; c = sp; }
}

__device__ __forceinline__ void phase_pro_b(const Params& p) {
    const int tid = opaque_tid(), lane = tid & 63, wave = tid >> 6;
    const int gsz = gridDim.x * NTHR;
    for (int idx = blockIdx.x * NTHR + tid; idx < NLAY * 17 * 3072; idx += gsz) {
        const int l = idx / (17 * 3072), j = idx % 3072;
        float s = p.b_ada[l * 3072 + j];
#pragma unroll
        for (int kc = 0; kc < 8; kc++) s += p.MODP()[(size_t)kc * (NLAY * 17 * 3072) + idx];
        p.MOD()[idx] = s;
    }
    if (blockIdx.x == 0 && wave < NLAY) {
        const int l = wave;
        float a = p.lam_q1[l * 64 + lane] * p.lam_k1[l * 64 + lane];
        float b = p.lam_q2[l * 64 + lane] * p.lam_k2[l * 64 + lane];
        a = wave_sum(a); b = wave_sum(b);
        if (lane == 0) p.LAM()[l] = expf(a) - expf(b) + lam_init_of(l);
    }
    if (blockIdx.x == (gridDim.x > 1 ? 1 : 0)) {
        for (int idx = tid; idx < 1024; idx += NTHR) {
            const int pp = idx >> 4, i = idx & 15;
            double s, c; sincos_d((double)pp * ROPE_FREQ[i], s, c);
            p.ROPE()[idx * 2] = (float)c; p.ROPE()[idx * 2 + 1] = (float)s;
        }
    }
}

__device__ __forceinline__ int panel_of(int pi) { return pi < 64 ? (pi >> 3) * 9 + 1 + (pi & 7) : (pi - 64) * 9; }
__device__ __forceinline__ unsigned panel_want(int mt, int inst) { return 4u * (unsigned)(inst + 1) - ((inst > 3 && (mt % 9) == 0) ? 4u : 0u); }
template <bool HOIST>
__device__ __forceinline__ void norm_rows(const Params& p, int chunk, int layer, int row_begin, int row_end, int row_step) {
    const int tid = opaque_tid(), lane = tid & 63, wave = tid >> 6;
    float4 gq[4], ga[4], sh[4];
    auto load_vecs = [&](int mr) {
        if (layer >= 0) {
            const float* gate = p.MOD() + ((size_t)layer * 17 + mr) * 3072 + 2048;
            const float* gp = p.g_post + layer * DM;
#pragma unroll
            for (int i = 0; i < 4; i++) { const int e = i * 256 + lane * 4; const float4 g = *(const float4*)(gate + e), q = *(const float4*)(gp + e);
                gq[i] = make_float4(g.x * q.x, g.y * q.y, g.z * q.z, g.w * q.w); }
        }
        if (layer < NLAY - 1) {
            const int nl = layer + 1;
            const float* md = p.MOD() + ((size_t)nl * 17 + mr) * 3072;
            const float* gpre = p.g_pre + nl * DM;
#pragma unroll
            for (int i = 0; i < 4; i++) { const int e = i * 256 + lane * 4; const float4 s4 = *(const float4*)(md + e), scl = *(const float4*)(md + 1024 + e), g = *(const float4*)(gpre + e);
                ga[i] = make_float4(g.x * (1.f + scl.x), g.y * (1.f + scl.y), g.z * (1.f + scl.z), g.w * (1.f + scl.w)); sh[i] = s4; }
        }
    };
    if (HOIST) { const int bl0 = row_begin / TT, t0 = row_begin - bl0 * TT; load_vecs(t0 < CTXL ? 16 : chunk * CB + bl0); }
    for (int row = row_begin + wave; row < row_end; row += row_step) {
        const int bl = row / TT, t = row - bl * TT, b = chunk * CB + bl;
        const bool isctx = t < CTXL;
        if (layer == NLAY - 1 && isctx) continue;
        const float* xin; float* xst; int mr;
        if (isctx) { const size_t o = ((size_t)b * CTXL + t) * DM; xin = (layer <= 0 ? p.ctx : (const float*)p.CX()) + o; xst = p.CX() + o; mr = 16; }
        else { const size_t o = ((size_t)b * SEQ + (t - CTXL)) * DM; xin = (layer <= 0 ? p.x : (const float*)p.out) + o; xst = p.out + o; mr = b; }
        if (!HOIST) load_vecs(mr);
        float4 xv[4];
#pragma unroll
        for (int i = 0; i < 4; i++) { const f32x4 t4 = __builtin_nontemporal_load((const f32x4*)(xin + i * 256 + lane * 4)); xv[i] = make_float4(t4[0], t4[1], t4[2], t4[3]); }
        if (layer >= 0) {
            const bf16_t* yr = (const bf16_t*)p.Y() + (size_t)row * DM;
            float4 yv[4]; float ss = 0.f;
#pragma unroll
            for (int i = 0; i < 4; i++) { const u32x2 w = __builtin_nontemporal_load((const u32x2*)(yr + i * 256 + lane * 4)); yv[i] = make_float4(bflo(w[0]), bfhi(w[0]), bflo(w[1]), bfhi(w[1]));
                ss += yv[i].x * yv[i].x + yv[i].y * yv[i].y + yv[i].z * yv[i].z + yv[i].w * yv[i].w; }
            ss = wave_sum(ss);
            const float rstd = rsqrtf(ss * (1.f / DM) + 1e-6f);
#pragma unroll
            for (int i = 0; i < 4; i++) {
                const int e = i * 256 + lane * 4;
                xv[i].x += gq[i].x * (yv[i].x * rstd); xv[i].y += gq[i].y * (yv[i].y * rstd);
                xv[i].z += gq[i].z * (yv[i].z * rstd); xv[i].w += gq[i].w * (yv[i].w * rstd);
                *(float4*)(xst + e) = xv[i];
            }
        }
        if (layer < NLAY - 1) {
            float ss = 0.f;
#pragma unroll
            for (int i = 0; i < 4; i++) ss += xv[i].x * xv[i].x + xv[i].y * xv[i].y + xv[i].z * xv[i].z + xv[i].w * xv[i].w;
            ss = wave_sum(ss);
            const float rstd = rsqrtf(ss * (1.f / DM) + 1e-6f);
#pragma unroll
            for (int i = 0; i < 4; i++) {
                const int e = i * 256 + lane * 4;
                const float h0 = xv[i].x * rstd * ga[i].x + sh[i].x, h1 = xv[i].y * rstd * ga[i].y + sh[i].y;
                const float h2 = xv[i].z * rstd * ga[i].z + sh[i].z, h3 = xv[i].w * rstd * ga[i].w + sh[i].w;
                *(uint2*)(p.H() + (size_t)row * DM + e) = make_uint2(pk2(h0, h1), pk2(h2, h3));
            }
        }
    }
}
__device__ __forceinline__ void phase_norm(const Params& p, int chunk, int layer) {
    norm_rows<false>(p, chunk, layer, blockIdx.x * 8, NTC, gridDim.x * 8);
}
__device__ __forceinline__ void phase_norm_ticketed(const Params& p, int chunk, int layer, int inst, volatile LAS unsigned* bst) {
    for (;;) {
        __syncthreads();
        if (threadIdx.x == 0) {
            const unsigned tk = xb_add(&p.BAR()[G23_TK2], 1u) - 544u * (unsigned)inst;
            if (tk < 288u && !(layer == NLAY - 1 && ((int)(tk >> 2) % 9) == 0)) {
                unsigned* pc = &p.BAR()[G23_PC2(tk >> 2)];
                const unsigned want = panel_want((int)(tk >> 2), inst);
                XB_SPIN_SLOW(xb_ld(pc) < want, p.BAR());
                __builtin_amdgcn_fence(__ATOMIC_ACQUIRE, "agent");
                asm volatile("s_waitcnt vmcnt(0)" ::: "memory");
            }
            bst[2] = tk;
        }
        __syncthreads();
        const unsigned it = (unsigned)__builtin_amdgcn_readfirstlane((int)bst[2]);
        if (it >= 288u) break;
        norm_rows<true>(p, chunk, layer, (int)it * 64, (int)it * 64 + 64, 8);
    }
}

__device__ __forceinline__ int lds_byte(int r, int c) {
    const int st = (r >> 4) * 2 + (c >> 5), rr = r & 15, cc = c & 31, ob = rr * 64 + cc * 2;
    return st * 1024 + (ob ^ (((ob >> 9) & 1) << 5));
}
__device__ __forceinline__ void stage_rc(int b, int& R, int& C) {
    const int st = b / 1024, sb = b % 1024, swz = sb ^ (((sb >> 9) & 1) << 5);
    R = (st >> 1) * 16 + swz / 64; C = (st & 1) * 32 + (swz % 64) / 2;
}
struct NoHook { __device__ __forceinline__ void operator()(int, f32x4 (&)[2][2][4][2]) const {} };
template <int LDA, int LDB, int KSEG = 0, class Hook = NoHook>
__device__ __forceinline__ void gemm256(const bf16_t* __restrict__ A, const bf16_t* __restrict__ Bt, const int K, const int brow, const int bcol,
                                        f32x4 (&acc)[2][2][4][2], LAS unsigned char* lds, const size_t segA = 0, const size_t segB = 0, const Hook hook = Hook()) {
    constexpr int BK = 64, HALF = 128, HTB = HALF * BK * 2;
    const int tid = opaque_tid(), wid = __builtin_amdgcn_readfirstlane(tid >> 6), lane = tid & 63, wr = wid >> 2, wc = wid & 3, fr = lane & 15, fq = lane >> 4;
    unsigned voffA[2], voffB[2];
#pragma unroll
    for (int i = 0; i < 2; ++i) { int R, C; stage_rc(tid * 16 + i * 8192, R, C); voffA[i] = (unsigned)(R * LDA + C) * 2u; voffB[i] = (unsigned)(R * LDB + C) * 2u; }
    const size_t kstep = (size_t)(BK * 2);
    const size_t hstepA = (size_t)HALF * LDA * 2, hstepB = (size_t)HALF * LDB * 2;
    const unsigned ldsw = (unsigned)wid * 1024u;
    const int aoff = lds_byte(wr * 64 + fr, fq * 8), boff = lds_byte(wc * 32 + fr, fq * 8);
    const char* cA = (const char*)(A + (size_t)brow * LDA);
    const char* cB = (const char*)(Bt + (size_t)bcol * LDB);
    auto pA = [&](int T) -> const char* { return KSEG ? cA + (size_t)(T / (KSEG ? KSEG : 1)) * segA + (size_t)(T % (KSEG ? KSEG : 1)) * kstep : cA + (size_t)T * kstep; };
    auto pB = [&](int T) -> const char* { return KSEG ? cB + (size_t)(T / (KSEG ? KSEG : 1)) * segB + (size_t)(T % (KSEG ? KSEG : 1)) * kstep : cB + (size_t)T * kstep; };
#define SA(b, h) (((b) * 2 + (h)) * HTB)
#define SB(b, h) ((4 + (b) * 2 + (h)) * HTB)
#define STAGE(bufoff, gbase, voff) do { _Pragma("unroll") for (int _i = 0; _i < 2; ++_i) \
        __builtin_amdgcn_global_load_lds((const unsigned*)((const char*)(gbase) + voff[_i]), (LAS unsigned*)(lds + (bufoff) + ldsw + _i * 8192), 16, 0, 0); } while (0)
#define LDA(dst, b, h) do { _Pragma("unroll") for (int m = 0; m < 4; ++m) _Pragma("unroll") for (int k = 0; k < 2; ++k) dst[m][k] = *(const LAS bf16x8*)(lds + SA(b, h) + aoff + m * 2048 + k * 1024); } while (0)
#define LDB(dst, b, h) do { _Pragma("unroll") for (int n = 0; n < 2; ++n) _Pragma("unroll") for (int k = 0; k < 2; ++k) dst[n][k] = *(const LAS bf16x8*)(lds + SB(b, h) + boff + n * 2048 + k * 1024); } while (0)
#define MMA(ai, bj, At, Bx) do { __builtin_amdgcn_s_setprio(1); _Pragma("unroll") for (int m = 0; m < 4; ++m) _Pragma("unroll") for (int n = 0; n < 2; ++n) _Pragma("unroll") for (int k = 0; k < 2; ++k) \
      acc[ai][bj][m][n] = __builtin_amdgcn_mfma_f32_16x16x32_bf16(At[m][k], Bx[n][k], acc[ai][bj][m][n], 0, 0, 0); \
    __builtin_amdgcn_s_setprio(0); } while (0)
#define WAIT_V(n) asm volatile("s_waitcnt vmcnt(" #n ")" ::: "memory")
#define WAIT_L(n) asm volatile("s_waitcnt lgkmcnt(" #n ")" ::: "memory")
#define BAR __builtin_amdgcn_s_barrier()
#define SCHED __builtin_amdgcn_sched_barrier(0)
#pragma unroll
    for (int a = 0; a < 2; a++)
#pragma unroll
        for (int b = 0; b < 2; b++)
#pragma unroll
            for (int m = 0; m < 4; m++)
#pragma unroll
                for (int n = 0; n < 2; n++) acc[a][b][m][n] = (f32x4){0.f, 0.f, 0.f, 0.f};
    bf16x8 At[4][2], B0[2][2], B1[2][2];
    const int nt = K / BK;
    WAIT_V(0); WAIT_L(0);
    __syncthreads();
    STAGE(SB(0, 0), cB, voffB); STAGE(SA(0, 0), cA, voffA); STAGE(SB(0, 1), cB + hstepB, voffB); STAGE(SA(0, 1), cA + hstepA, voffA);
    if (wr == 1) BAR;
    WAIT_V(4); BAR;
    STAGE(SB(1, 0), pB(1), voffB); STAGE(SA(1, 0), pA(1), voffA); STAGE(SB(1, 1), pB(1) + hstepB, voffB);
    WAIT_V(6); BAR;
    for (int t = 0; t < nt - 2; t += 2) {
        if (KSEG && t > 0 && (t % (KSEG ? KSEG : 1)) == 0) hook(t / (KSEG ? KSEG : 1), acc);
        const char* a1 = pA(t + 1); const char* a2 = pA(t + 2); const char* a3 = pA(t + 3);
        const char* b2 = pB(t + 2); const char* b3 = pB(t + 3);
        LDB(B0, 0, 0); SCHED; LDA(At, 0, 0); STAGE(SA(1, 1), a1 + hstepA, voffA);
        WAIT_L(8); BAR; WAIT_L(0); MMA(0, 0, At, B0); BAR; SCHED;
        LDB(B1, 0, 1); STAGE(SB(0, 0), b2, voffB);
        BAR; WAIT_L(0); MMA(0, 1, At, B1); BAR;
        LDA(At, 0, 1); STAGE(SA(0, 0), a2, voffA);
        BAR; WAIT_L(0); MMA(1, 0, At, B0); BAR; SCHED;
        STAGE(SB(0, 1), b2 + hstepB, voffB);
        WAIT_V(6); BAR; MMA(1, 1, At, B1); BAR;
        LDB(B0, 1, 0); SCHED; LDA(At, 1, 0); STAGE(SA(0, 1), a2 + hstepA, voffA);
        WAIT_L(8); BAR; WAIT_L(0); MMA(0, 0, At, B0); BAR; SCHED;
        LDB(B1, 1, 1); STAGE(SB(1, 0), b3, voffB);
        BAR; WAIT_L(0); MMA(0, 1, At, B1); BAR;
        LDA(At, 1, 1); STAGE(SA(1, 0), a3, voffA);
        BAR; WAIT_L(0); MMA(1, 0, At, B0); BAR; SCHED;
        STAGE(SB(1, 1), b3 + hstepB, voffB);
        WAIT_V(6); BAR; MMA(1, 1, At, B1); BAR;
    }
    { LDB(B0, 0, 0); LDA(At, 0, 0); STAGE(SA(1, 1), pA(nt - 1) + hstepA, voffA);
      BAR; WAIT_L(0); MMA(0, 0, At, B0); BAR;
      LDB(B1, 0, 1); BAR; WAIT_L(0); MMA(0, 1, At, B1); BAR;
      LDA(At, 0, 1); WAIT_V(4); BAR; WAIT_L(0); MMA(1, 0, At, B0); MMA(1, 1, At, B1); BAR; }
    { LDB(B0, 1, 0); LDA(At, 1, 0); WAIT_V(2); BAR; WAIT_L(0); MMA(0, 0, At, B0); BAR;
      LDB(B1, 1, 1); WAIT_V(0); BAR; WAIT_L(0); MMA(0, 1, At, B1); BAR;
      LDA(At, 1, 1); BAR; WAIT_L(0); MMA(1, 0, At, B0); MMA(1, 1, At, B1); BAR; }
    if (wr == 0) BAR;
#undef SA
#undef SB
#undef STAGE
#undef LDA
#undef LDB
#undef MMA
#undef WAIT_V
#undef WAIT_L
#undef BAR
#undef SCHED
}

template <bool PERMF = false, class F>
__device__ __forceinline__ void epi_store_rows(LAS unsigned char* lds, int wid, int lane2, int fr, int fq, int wc, int mt, bf16_t* dbase, size_t dld, F getpk) {
    LAS unsigned char* reg = lds + wid * 9216;
#pragma unroll
    for (int bj = 0; bj < 2; bj++)
#pragma unroll
        for (int n = 0; n < 2; n++)
#pragma unroll
            for (int m = 0; m < 4; m++) *(LAS u32x2*)(reg + ((bj * 2 + n) * 16 + fr) * LROW + (PERMF ? fq * 32 + m * 8 : fq * 8 + m * 32)) = getpk(bj, n, m);
#pragma unroll
    for (int i = 0; i < 8; i++) {
        const int c = lane2 + 64 * i, row = c >> 3, ch = c & 7;
        const u32x4 w = *(const LAS u32x4*)(reg + row * LROW + ch * 16);
        const int tk2 = mt * 256 + (row >> 5) * 128 + wc * 32 + (row & 31);
        *(u32x4*)(dbase + (size_t)tk2 * dld + ch * 8) = w;
    }
}

__device__ __forceinline__ void phase_gemm1(const Params& p, int layer, LAS unsigned char* lds) {
    const int tid = opaque_tid(), wid = __builtin_amdgcn_readfirstlane(tid >> 6), wr = wid >> 2, wc = wid & 3;
    const bf16_t* Wt = p.W1t() + (size_t)layer * N1 * DM;
    const bool lastl = (layer == NLAY - 1);
    const int nslots = lastl ? (1920 + 48) : 6 * 48 * 8;
    for (int L = blockIdx.x; L < nslots; L += gridDim.x) {
        int mt, nt;
        if (lastl && L >= 1920) {
            const int c = L - 1920, cp = c / 6, k = c - cp * 6;
            mt = cp * 9; nt = (k < 2) ? 2 + k : 6 + k;
        } else {
            const int xc = L & 7, q = L >> 3, pidx = q / 48, w = q - pidx * 48, gp = pidx * 8 + xc;
            if (gp >= 45) continue;
            const int pmp = gp / 5, pnp = gp - pmp * 5;
            const int pr = pmp * 8 + (w & 7);
            mt = lastl ? (pr >> 3) * 9 + 1 + (pr & 7) : pr;
            nt = pnp * 6 + (w >> 3);
        }
        const bool isV = (nt == 3) || (nt == 10) || (nt == 11);
        f32x4 acc[2][2][4][2];
        if (isV) {
            gemm256<DM, DM>(p.H(), Wt, DM, mt * 256, nt * 256, acc, lds);
            const int tid2 = opaque_tid(), lane2 = tid2 & 63, fr = lane2 & 15, fq = lane2 >> 4;
            const int tok0 = mt * 256; const int bl = tok0 / TT, t0 = tok0 - bl * TT;
            const int ppos = 8 * (fq & 1) + 4 * (fq >> 1);
            LAS unsigned char* vreg = lds + wid * 2304;
#pragma unroll
            for (int bj = 0; bj < 2; bj++)
#pragma unroll
                for (int n = 0; n < 2; n++)
#pragma unroll
                    for (int ai = 0; ai < 2; ai++) {
#pragma unroll
                        for (int m = 0; m < 4; m++) {
                            const f32x4 v = acc[ai][bj][m][n];
                            *(LAS u32x2*)(vreg + fr * LROW + m * 32 + ppos * 2) = (u32x2){pk2(v[0], v[1]), pk2(v[2], v[3])};
                        }
#pragma unroll
                        for (int i = 0; i < 2; i++) {
                            const int c = lane2 + 64 * i, r = c >> 3, ch = c & 7;
                            const int vcr = wc * 32 + n * 16 + r;
                            bf16_t* dr;
                            if (nt == 3) dr = (bj == 0 ? p.VtA() : p.VtC()) + ((size_t)(bl * 2 + (vcr >> 6)) * 64 + (vcr & 63)) * TT;
                            else { const int vc = (nt - 10) * 256 + bj * 128 + vcr; dr = p.VtB() + ((size_t)(bl * 4 + (vc >> 7)) * 128 + (vc & 127)) * TT; }
                            *(u32x4*)(dr + t0 + ai * 128 + wr * 64 + ch * 8) = *(const LAS u32x4*)(vreg + r * LROW + ch * 16);
                        }
                    }
        } else {
            gemm256<DM, DM>(Wt, p.H(), DM, nt * 256, mt * 256, acc, lds);
            const int tid2 = opaque_tid(), lane2 = tid2 & 63, fr = lane2 & 15, fq = lane2 >> 4;
#pragma unroll
            for (int ai = 0; ai < 2; ai++) {
                const int col0 = nb2ob(nt * 2 + ai) * 128 + wr * 64;
                int type;
                if (col0 < 512) type = 0; else if (col0 < 640) type = 1; else if (col0 < 1280) type = 3; else if (col0 < 2304) type = 2;
                else if (col0 < 3328) type = 3; else if (col0 < 3968) type = 2; else if (col0 < 4608) type = 3; else type = 4;
#pragma unroll
                for (int bj = 0; bj < 2; bj++)
#pragma unroll
                    for (int n = 0; n < 2; n++) {
                        const int tk = mt * 256 + bj * 128 + wc * 32 + n * 16 + fr;
                        const int bl = tk / TT, t = tk - bl * TT;
                        float v[4][4];
#pragma unroll
                        for (int m = 0; m < 4; m++)
#pragma unroll
                            for (int j = 0; j < 4; j++) v[m][j] = acc[ai][bj][m][n][j];
                        if (type <= 1) {
                            float ss = 0.f;
#pragma unroll
                            for (int m = 0; m < 4; m++)
#pragma unroll
                                for (int j = 0; j < 4; j++) ss += v[m][j] * v[m][j];
                            ss += __shfl_xor(ss, 16); ss += __shfl_xor(ss, 32);
                            const float rstd = rsqrtf(ss * (1.f / 64.f) + 1e-6f);
                            const float* gn = (type == 0 ? p.q_norm : p.k_norm) + layer * 64;
#pragma unroll
                            for (int m = 0; m < 4; m++) {
                                const float4 g4 = *(const float4*)(gn + m * 16 + fq * 4);
                                v[m][0] *= rstd * g4.x; v[m][1] *= rstd * g4.y; v[m][2] *= rstd * g4.z; v[m][3] *= rstd * g4.w;
                            }
                        }
                        if (type <= 2 && t >= CTXL) {
                            const int pos = t - CTXL;
#pragma unroll
                            for (int ax = 0; ax < 2; ax++) {
                                const int pp = (ax == 0) ? (pos >> 6) : (pos & 63);
                                const float4* rp = (const float4*)(p.ROPE() + (size_t)(pp * 16 + fq * 4) * 2);
                                const float4 c01 = rp[0], c23 = rp[1];
                                const float cs[4] = {c01.x, c01.z, c23.x, c23.z}, sn[4] = {c01.y, c01.w, c23.y, c23.w};
#pragma unroll
                                for (int j = 0; j < 4; j++) {
                                    const float x1 = v[2 * ax][j], x2 = v[2 * ax + 1][j];
                                    v[2 * ax][j] = x1 * cs[j] - x2 * sn[j];
                                    v[2 * ax + 1][j] = x2 * cs[j] + x1 * sn[j];
                                }
                            }
                        }
                        if (col0 < 512 || (col0 >= 3328 && col0 < 3840)) {
#pragma unroll
                            for (int m = 0; m < 4; m++)
#pragma unroll
                                for (int j = 0; j < 4; j++) v[m][j] *= 0.125f * LOG2E;
                        }
                        if (type == 3) {
#pragma unroll
                            for (int m = 0; m < 4; m++)
#pragma unroll
                                for (int j = 0; j < 4; j++) v[m][j] = silu_f(v[m][j]);
                        }
                        if (type == 4) {
                            const float* bm = p.b_mg + layer * 3072 + (col0 - INW);
#pragma unroll
                            for (int m = 0; m < 4; m++) {
                                const float4 b4 = *(const float4*)(bm + m * 16 + fq * 4);
                                v[m][0] = fmaxf(sigmoid_f(v[m][0] + b4.x), 5.96e-8f); v[m][1] = fmaxf(sigmoid_f(v[m][1] + b4.y), 5.96e-8f);
                                v[m][2] = fmaxf(sigmoid_f(v[m][2] + b4.z), 5.96e-8f); v[m][3] = fmaxf(sigmoid_f(v[m][3] + b4.w), 5.96e-8f);
                            }
                        }
                        if (type == 4) {
                            LAS unsigned char* srow = lds + wid * 9216 + ((bj * 2 + n) * 16 + fr) * 80 + fq * 4;
#pragma unroll
                            for (int m = 0; m < 4; m++) {
                                const unsigned q0 = (unsigned)fmaxf(__builtin_rintf(v[m][0] * 255.f), 1.f), q1 = (unsigned)fmaxf(__builtin_rintf(v[m][1] * 255.f), 1.f);
                                const unsigned q2 = (unsigned)fmaxf(__builtin_rintf(v[m][2] * 255.f), 1.f), q3 = (unsigned)fmaxf(__builtin_rintf(v[m][3] * 255.f), 1.f);
                                *(LAS unsigned*)(srow + m * 16) = q0 | (q1 << 8) | (q2 << 16) | (q3 << 24);
                            }
                        } else {
                        LAS unsigned char* srow = lds + wid * 9216 + ((bj * 2 + n) * 16 + fr) * LROW + fq * 8;
#pragma unroll
                        for (int m = 0; m < 4; m++)
                            *(LAS u32x2*)(srow + m * 32) = (u32x2){pk2(v[m][0], v[m][1]), pk2(v[m][2], v[m][3])};
                        }
                    }
                if (type == 4) {
                    unsigned char* dbase = (unsigned char*)p.G() + (col0 - INW);
#pragma unroll
                    for (int i = 0; i < 4; i++) {
                        const int c = lane2 + 64 * i, row = c >> 2, ch = c & 3;
                        const u32x4 w = *(const LAS u32x4*)(lds + wid * 9216 + row * 80 + ch * 16);
                        const int tk2 = mt * 256 + (row >> 5) * 128 + wc * 32 + (row & 31);
                        *(u32x4*)(dbase + (size_t)tk2 * 3072 + ch * 16) = w;
                    }
                } else {
                    bf16_t* dbase = p.PROJ() + col0;
                    const size_t dld = INW;
#pragma unroll
                    for (int i = 0; i < 8; i++) {
                        const int c = lane2 + 64 * i, row = c >> 3, ch = c & 7;
                        const u32x4 w = *(const LAS u32x4*)(lds + wid * 9216 + row * LROW + ch * 16);
                        const int tk2 = mt * 256 + (row >> 5) * 128 + wc * 32 + (row & 31);
                        *(u32x4*)(dbase + (size_t)tk2 * dld + ch * 8) = w;
                    }
                }
            }
        }
    }
}

template <int DV>
__device__ __forceinline__ void attn_tile(const unsigned char* Kl, const unsigned char* Vl, const bf16x8 (&qf)[4], f32x16 (&O)[DV / 32], float& m, float& l,
                                          int l31, int hh, bool domask, int qpos, int kpos0) {
    const float SL2 = 0.125f * LOG2E;
    const float THR = 8.f;
    f32x16 S[2];
#pragma unroll
    for (int sub = 0; sub < 2; sub++)
#pragma unroll
        for (int r = 0; r < 16; r++) S[sub][r] = 0.f;
#pragma unroll
    for (int kk = 0; kk < 4; kk++)
#pragma unroll
        for (int sub = 0; sub < 2; sub++) {
            const bf16x8 kf = *(const bf16x8*)(Kl + (sub * 32 + l31) * LROW + kk * 32 + hh * 16);
            S[sub] = MFMA(kf, qf[kk], S[sub]);
        }
    if (domask) {
#pragma unroll
        for (int sub = 0; sub < 2; sub++)
#pragma unroll
            for (int r = 0; r < 16; r++) {
                const int d = qpos - (kpos0 + sub * 32 + (r & 3) + 8 * (r >> 2) + 4 * hh);
                S[sub][r] = (d <= 128 && d >= -128) ? S[sub][r] : -1e30f;
            }
    }
    float mx = S[0][0];
#pragma unroll
    for (int sub = 0; sub < 2; sub++)
#pragma unroll
        for (int r = 0; r < 16; r++) mx = fmaxf(mx, S[sub][r]);
    mx = fmaxf(mx, __shfl_xor(mx, 32));
    const float mxs = mx * SL2;
    if (__any(mxs > m + THR)) {
        const float mnew = fmaxf(m, mxs);
        const float alpha = __builtin_amdgcn_exp2f(m - mnew);
        m = mnew; l *= alpha;
#pragma unroll
        for (int dt = 0; dt < DV / 32; dt++)
#pragma unroll
            for (int r = 0; r < 16; r++) O[dt][r] *= alpha;
    }
    float ps = 0.f;
#pragma unroll
    for (int sub = 0; sub < 2; sub++)
#pragma unroll
        for (int r = 0; r < 16; r++) { S[sub][r] = __builtin_amdgcn_exp2f(__builtin_fmaf(S[sub][r], SL2, -m)); ps += S[sub][r]; }
    l += ps;
    bf16x8 pb[2][2];
#pragma unroll
    for (int sub = 0; sub < 2; sub++)
#pragma unroll
        for (int s = 0; s < 2; s++) {
            u32x4 cv;
            cv[0] = pk2(S[sub][8 * s + 0], S[sub][8 * s + 1]); cv[1] = pk2(S[sub][8 * s + 2], S[sub][8 * s + 3]);
            cv[2] = pk2(S[sub][8 * s + 4], S[sub][8 * s + 5]); cv[3] = pk2(S[sub][8 * s + 6], S[sub][8 * s + 7]);
            pb[sub][s] = __builtin_bit_cast(bf16x8, cv);
        }
#pragma unroll
    for (int sub = 0; sub < 2; sub++)
#pragma unroll
        for (int s = 0; s < 2; s++)
#pragma unroll
            for (int dt = 0; dt < DV / 32; dt++) {
                const bf16x8 vf = *(const bf16x8*)(Vl + (dt * 32 + l31) * LROW + (sub * 4 + s * 2 + hh) * 16);
                O[dt] = MFMA(vf, pb[sub][s], O[dt]);
            }
}

template <int DV>
__device__ __forceinline__ void attn_tile_rel(const unsigned char* Kl, const unsigned char* Vl, const bf16x8 (&qf)[4], f32x16 (&O)[DV / 32], float& m, float& l, f32x16& NEGM,
                                              bool first, int l31, int hh, bool domask, int qpos, int kpos0) {
    const float THR = 8.f;
    f32x16 S[2];
#pragma unroll
    for (int sub = 0; sub < 2; sub++) {
        const bf16x8 kf = *(const bf16x8*)(Kl + (sub * 32 + l31) * LROW + hh * 16);
        S[sub] = MFMA(kf, qf[0], NEGM);
    }
#pragma unroll
    for (int kk = 1; kk < 4; kk++)
#pragma unroll
        for (int sub = 0; sub < 2; sub++) {
            const bf16x8 kf = *(const bf16x8*)(Kl + (sub * 32 + l31) * LROW + kk * 32 + hh * 16);
            S[sub] = MFMA(kf, qf[kk], S[sub]);
        }
    if (domask) {
#pragma unroll
        for (int sub = 0; sub < 2; sub++)
#pragma unroll
            for (int r = 0; r < 16; r++) {
                const int d = qpos - (kpos0 + sub * 32 + (r & 3) + 8 * (r >> 2) + 4 * hh);
                S[sub][r] = (d <= 128 && d >= -128) ? S[sub][r] : -1e30f;
            }
    }
    float mx = S[0][0];
#pragma unroll
    for (int sub = 0; sub < 2; sub++)
#pragma unroll
        for (int r = 0; r < 16; r++) mx = fmaxf(mx, S[sub][r]);
    mx = fmaxf(mx, __shfl_xor(mx, 32));
    if (first || __any(mx > THR)) {
        const float d = first ? mx : fmaxf(mx, 0.f);
        const float alpha = __builtin_amdgcn_exp2f(-d);
        m += d; l *= alpha;
#pragma unroll
        for (int dt = 0; dt < DV / 32; dt++)
#pragma unroll
            for (int r = 0; r < 16; r++) O[dt][r] *= alpha;
#pragma unroll
        for (int r = 0; r < 16; r++) NEGM[r] -= d;
#pragma unroll
        for (int sub = 0; sub < 2; sub++)
#pragma unroll
            for (int r = 0; r < 16; r++) S[sub][r] -= d;
    }
    float ps = 0.f;
#pragma unroll
    for (int sub = 0; sub < 2; sub++)
#pragma unroll
        for (int r = 0; r < 16; r++) { S[sub][r] = __builtin_amdgcn_exp2f(S[sub][r]); ps += S[sub][r]; }
    l += ps;
#pragma unroll
    for (int sub = 0; sub < 2; sub++)
#pragma unroll
        for (int s = 0; s < 2; s++) {
            u32x4 cv;
            cv[0] = pk2(S[sub][8 * s + 0], S[sub][8 * s + 1]); cv[1] = pk2(S[sub][8 * s + 2], S[sub][8 * s + 3]);
            cv[2] = pk2(S[sub][8 * s + 4], S[sub][8 * s + 5]); cv[3] = pk2(S[sub][8 * s + 6], S[sub][8 * s + 7]);
            const bf16x8 pb = __builtin_bit_cast(bf16x8, cv);
#pragma unroll
            for (int dt = 0; dt < DV / 32; dt++) {
                const bf16x8 vf = *(const bf16x8*)(Vl + (dt * 32 + l31) * LROW + (sub * 4 + s * 2 + hh) * 16);
                O[dt] = MFMA(vf, pb, O[dt]);
            }
        }
}

template <bool DIFF>
__device__ __forceinline__ void attn_unit(const Params& p, int layer, int mode, int bl, int hidx, int qblk, bool isctx, unsigned char* lds) {
    constexpr int DV = DIFF ? 128 : 64;
    constexpr int NKM = DIFF ? 2 : 1;
    constexpr int KBYTES = NKM * 9216, VBYTES = DV * LROW, BUFB = KBYTES + VBYTES;
    const int tid = opaque_tid(), lane = tid & 63, wave = __builtin_amdgcn_readfirstlane(tid >> 6), l31 = lane & 31, hh = lane >> 5;
    int qcol, kcol, gcol, ucol, tq, head = 0, cm = 0, qs = 0;
    const bf16_t* vt;
    int qpos;
    if (DIFF) {
        cm = wave & 1; qs = wave >> 1;
        qcol = 1280 + hidx * 128 + cm * 64; kcol = 1792 + hidx * 128; gcol = 2816 + hidx * 128; ucol = NTC * 512 + hidx * 128;
        vt = p.VtB() + (size_t)(bl * 4 + hidx) * 128 * TT;
        qpos = qblk * 128 + qs * 32 + l31;
        tq = bl * TT + (isctx ? 0 : CTXL) + qpos;
    } else {
        head = hidx * 4 + (wave & 3);
        qpos = qblk * 64 + (wave >> 2) * 32 + l31;
        if (mode == 0) { qcol = head * 64; kcol = 512 + hidx * 64; gcol = 768 + head * 64; ucol = head * 64; vt = p.VtA() + (size_t)(bl * 2 + hidx) * 64 * TT; }
        else { qcol = 3328 + head * 64; kcol = 3840 + hidx * 64; gcol = 4096 + head * 64; ucol = 2 * NTC * 512 + head * 64; vt = p.VtC() + (size_t)(bl * 2 + hidx) * 64 * TT; }
        tq = bl * TT + (isctx ? 0 : CTXL) + qpos;
    }
    const bool win = (!DIFF) && (mode == 2) && !isctx;
    int n2, start2;
    if (isctx) { n2 = 0; start2 = 0; }
    else if (win) { const int q0 = qblk * 64; int lo = q0 - 128; if (lo < 0) lo = 0; int hi = q0 + 192; if (hi > SEQ) hi = SEQ; n2 = (hi - lo) >> 6; start2 = CTXL + lo; }
    else { n2 = 32; start2 = CTXL; }
    const int ntile = 4 + n2;

    const bf16_t* kp = p.PROJ() + (size_t)(bl * TT) * INW + kcol;
    const int lr = tid >> 3, lc = tid & 7;
    u32x4 kr[NKM], vr[DV / 64];
    bf16x8 qf[4];
    {
        unsigned char* qreg = lds + 73728 + wave * 4608;
        const int tqb = tq - l31;
#pragma unroll
        for (int i = 0; i < 4; i++) {
            const int c = lane + 64 * i, row = c >> 3, ch = c & 7;
            *(u32x4*)(qreg + row * LROW + ch * 16) = *(const u32x4*)(p.PROJ() + (size_t)(tqb + row) * INW + qcol + ch * 8);
        }
#pragma unroll
        for (int kk = 0; kk < 4; kk++) qf[kk] = *(const bf16x8*)(qreg + l31 * LROW + kk * 32 + hh * 16);
    }
    f32x16 O[DV / 32];
#pragma unroll
    for (int dt = 0; dt < DV / 32; dt++)
#pragma unroll
        for (int r = 0; r < 16; r++) O[dt][r] = 0.f;
    float m = DIFF ? -1e30f : 0.f, l = 0.f;
    f32x16 NEGM;
#pragma unroll
    for (int r = 0; r < 16; r++) NEGM[r] = 0.f;

    {
        const int t0 = 0;
#pragma unroll
        for (int i = 0; i < NKM; i++) kr[i] = *(const u32x4*)(kp + (size_t)(t0 + lr) * INW + i * 64 + lc * 8);
#pragma unroll
        for (int i = 0; i < DV / 64; i++) vr[i] = *(const u32x4*)(vt + (size_t)(lr + i * 64) * TT + t0 + lc * 8);
    }
    __syncthreads();
    {
        unsigned char* wb = lds + lr * LROW + lc * 16;
#pragma unroll
        for (int i = 0; i < NKM; i++) *(u32x4*)(wb + i * 9216) = kr[i];
#pragma unroll
        for (int i = 0; i < DV / 64; i++) *(u32x4*)(wb + KBYTES + i * 64 * LROW) = vr[i];
    }
    __syncthreads();
    for (int it = 0; it < ntile; it++) {
        const unsigned char* cur = lds + (it & 1) * BUFB;
        const bool more = (it + 1 < ntile);
        if (more) {
            const int t0 = (it + 1 < 4) ? (it + 1) * 64 : start2 + (it + 1 - 4) * 64;
#pragma unroll
            for (int i = 0; i < NKM; i++) kr[i] = *(const u32x4*)(kp + (size_t)(t0 + lr) * INW + i * 64 + lc * 8);
#pragma unroll
            for (int i = 0; i < DV / 64; i++) vr[i] = *(const u32x4*)(vt + (size_t)(lr + i * 64) * TT + t0 + lc * 8);
        }
        const int tcur = (it < 4) ? it * 64 : start2 + (it - 4) * 64;
        const int rel = (tcur - CTXL) - (DIFF ? 0 : (qblk * 64 + (wave >> 2) * 32));
        if (DIFF) attn_tile<DV>(cur + cm * 9216, cur + KBYTES, qf, O, m, l, l31, hh, false, qpos, tcur - CTXL);
        else attn_tile_rel<DV>(cur, cur + KBYTES, qf, O, m, l, NEGM, it == 0, l31, hh, win && (it >= 4) && (rel < -97 || rel > 65), qpos, tcur - CTXL);
        if (more) {
            unsigned char* wb = lds + ((it + 1) & 1) * BUFB + lr * LROW + lc * 16;
#pragma unroll
            for (int i = 0; i < NKM; i++) *(u32x4*)(wb + i * 9216) = kr[i];
#pragma unroll
            for (int i = 0; i < DV / 64; i++) *(u32x4*)(wb + KBYTES + i * 64 * LROW) = vr[i];
        }
        __syncthreads();
    }
    float lt = l + __shfl_xor(l, 32);
    if (DIFF) {
        const float inv = 1.f / lt;
        float* xb = (float*)lds + qs * 128 * 32;
        if (cm == 1) {
#pragma unroll
            for (int dt = 0; dt < DV / 32; dt++)
#pragma unroll
                for (int r = 0; r < 16; r++) xb[(dt * 32 + (r & 3) + 8 * (r >> 2) + 4 * hh) * 32 + l31] = O[dt][r] * inv;
        }
        __syncthreads();
        if (cm == 0) {
            const float lam = p.LAM()[layer];
            const float om = 1.f - lam_init_of(layer);
            float ss = 0.f;
#pragma unroll
            for (int dt = 0; dt < DV / 32; dt++)
#pragma unroll
                for (int r = 0; r < 16; r++) {
                    const float o = O[dt][r] * inv - lam * xb[(dt * 32 + (r & 3) + 8 * (r >> 2) + 4 * hh) * 32 + l31];
                    O[dt][r] = o; ss += o * o;
                }
            ss += __shfl_xor(ss, 32);
            const float rstd = rsqrtf(ss * (1.f / 128.f) + 1e-5f) * om;
            unsigned char* sreg = lds + 65536 + wave * 9216;
            constexpr int RS = DV * 2 + 16, CPR = DV / 8;
            const int lane_e = opaque_tid() & 63;
            const int tqb = tq - l31;
#pragma unroll
            for (int i = 0; i < DV / 16; i++) {
                const int c = lane_e + 64 * i, row = c / CPR, ch = c % CPR;
                *(u32x4*)(sreg + row * RS + ch * 16) = __builtin_nontemporal_load((const u32x4*)(p.PROJ() + (size_t)(tqb + row) * INW + gcol + ch * 8));
                if ((i & 1) == 1) asm volatile("" ::: "memory");
            }
#pragma unroll
            for (int dt = 0; dt < DV / 32; dt++)
#pragma unroll
                for (int rg = 0; rg < 4; rg++) {
                    const int d0 = dt * 32 + rg * 8 + hh * 4;
                    const float4 sg = *(const float4*)(p.subln + layer * 128 + d0);
                    u32x2* sp = (u32x2*)(sreg + l31 * RS + d0 * 2);
                    const u32x2 gw = *sp;
                    const float o0 = O[dt][rg * 4 + 0] * rstd * sg.x * bflo(gw[0]), o1 = O[dt][rg * 4 + 1] * rstd * sg.y * bfhi(gw[0]);
                    const float o2 = O[dt][rg * 4 + 2] * rstd * sg.z * bflo(gw[1]), o3 = O[dt][rg * 4 + 3] * rstd * sg.w * bfhi(gw[1]);
                    *sp = (u32x2){pk2(o0, o1), pk2(o2, o3)};
                }
#pragma unroll
            for (int i = 0; i < DV / 16; i++) {
                const int c = lane_e + 64 * i, row = c / CPR, ch = c % CPR;
                *(u32x4*)(p.U() + (size_t)(tqb + row) * 512 + ucol + ch * 8) = *(const u32x4*)(sreg + row * RS + ch * 16);
                if ((i & 1) == 1) asm volatile("" ::: "memory");
            }
        }
    } else {
        float a = 1.f;
        if (mode == 2) {
            const float s2 = p.sink[layer * 8 + head] * LOG2E;
            const float mf = fmaxf(m, s2);
            a = __builtin_amdgcn_exp2f(m - mf);
            lt = lt * a + __builtin_amdgcn_exp2f(s2 - mf);
        }
        const float inv = a / lt;
        unsigned char* sreg = lds + 65536 + wave * 9216;
        constexpr int RS = DV * 2 + 16, CPR = DV / 8;
        const int lane_e = opaque_tid() & 63;
        const int tqb = tq - l31;
#pragma unroll
        for (int i = 0; i < DV / 16; i++) {
            const int c = lane_e + 64 * i, row = c / CPR, ch = c % CPR;
            *(u32x4*)(sreg + row * RS + ch * 16) = __builtin_nontemporal_load((const u32x4*)(p.PROJ() + (size_t)(tqb + row) * INW + gcol + ch * 8));
        }
#pragma unroll
        for (int dt = 0; dt < DV / 32; dt++)
#pragma unroll
            for (int rg = 0; rg < 4; rg++) {
                const int d0 = dt * 32 + rg * 8 + hh * 4;
                u32x2* sp = (u32x2*)(sreg + l31 * RS + d0 * 2);
                const u32x2 gw = *sp;
                const float o0 = O[dt][rg * 4 + 0] * inv * bflo(gw[0]), o1 = O[dt][rg * 4 + 1] * inv * bfhi(gw[0]);
                const float o2 = O[dt][rg * 4 + 2] * inv * bflo(gw[1]), o3 = O[dt][rg * 4 + 3] * inv * bfhi(gw[1]);
                *sp = (u32x2){pk2(o0, o1), pk2(o2, o3)};
            }
#pragma unroll
        for (int i = 0; i < DV / 16; i++) {
            const int c = lane_e + 64 * i, row = c / CPR, ch = c % CPR;
            *(u32x4*)(p.U() + (size_t)(tqb + row) * 512 + ucol + ch * 8) = *(const u32x4*)(sreg + row * RS + ch * 16);
        }
    }
}

__device__ __forceinline__ void phase_attn(const Params& p, int layer, unsigned char* lds) {
    const int nunits = 1536 + ((layer < NLAY - 1) ? 192 : 0);
    for (int u = blockIdx.x; u < nunits; u += gridDim.x) {
        int mode, bl, hidx, qb; bool isctx;
        if (u < 512) { const int x = u & 7, rest = u >> 3; qb = rest & 15; const int combo = (rest >> 4) * 8 + x; mode = 1; bl = combo >> 2; hidx = combo & 3; isctx = false; }
        else if (u < 1536) { const int u2 = (u - 512) & 511; const int x = u2 & 7, rest = u2 >> 3; qb = rest & 31; const int combo = (rest >> 5) * 8 + x;
            mode = (u < 1024) ? 0 : 2; bl = combo >> 1; hidx = combo & 1; isctx = false; }
        else if (u < 1600) { const int u2 = u - 1536; qb = u2 & 1; const int combo = u2 >> 1; mode = 1; bl = combo >> 2; hidx = combo & 3; isctx = true; }
        else { const int u2 = (u - 1600) & 63; qb = u2 & 3; const int combo = u2 >> 2; mode = (u < 1664) ? 0 : 2; bl = combo >> 1; hidx = combo & 1; isctx = true; }
        __syncthreads();
        if (mode == 1) attn_unit<true>(p, layer, mode, bl, hidx, qb, isctx, lds);
        else attn_unit<false>(p, layer, mode, bl, hidx, qb, isctx, lds);
    }
}

__device__ __forceinline__ float ub(unsigned w, int j) { return (float)((w >> (8 * j)) & 0xffu); }
struct GateHook {
    const unsigned char* G; int tok0, feat0;
    __device__ __forceinline__ void operator()(int seg, f32x4 (&acc)[2][2][4][2]) const {
        const int tid2 = opaque_tid(), lane2 = tid2 & 63, wid2 = __builtin_amdgcn_readfirstlane(tid2 >> 6), wr = wid2 >> 2, wc = wid2 & 3, fr = lane2 & 15, fq = lane2 >> 4;
#pragma unroll
        for (int bj = 0; bj < 2; bj++)
#pragma unroll
            for (int n = 0; n < 2; n++) {
                const int tk = tok0 + bj * 128 + wc * 32 + n * 16 + fr;
                const unsigned char* gprev = G + (size_t)tk * 3072 + (seg - 1) * 1024 + feat0 + wr * 64 + fq * 16;
#pragma unroll
                for (int ai = 0; ai < 2; ai++) {
                    const u32x4 gp = *(const u32x4*)(gprev + ai * 128), gn = *(const u32x4*)(gprev + 1024 + ai * 128);
#pragma unroll
                    for (int m = 0; m < 4; m++) {
                        f32x4& v = acc[ai][bj][m][n];
                        v[0] *= ub(gp[m], 0) * __builtin_amdgcn_rcpf(ub(gn[m], 0)); v[1] *= ub(gp[m], 1) * __builtin_amdgcn_rcpf(ub(gn[m], 1));
                        v[2] *= ub(gp[m], 2) * __builtin_amdgcn_rcpf(ub(gn[m], 2)); v[3] *= ub(gp[m], 3) * __builtin_amdgcn_rcpf(ub(gn[m], 3));
                    }
                }
            }
    }
};

__device__ __forceinline__ void phase_gemm2(const Params& p, int layer, LAS unsigned char* lds) {
    const int tid = opaque_tid(), wid = __builtin_amdgcn_readfirstlane(tid >> 6), wr = wid >> 2, wc = wid & 3;
    const int ntiles = (layer == NLAY - 1) ? 256 : 288;
    for (int L = blockIdx.x; L < ntiles; L += gridDim.x) {
        const int mt = panel_of(L >> 2), nt = L & 3;
        f32x4 acc[2][2][4][2];
        GateHook hk; hk.G = (const unsigned char*)p.G(); hk.tok0 = mt * 256; hk.feat0 = nt * 256;
        gemm256<512, 512, 8, GateHook>(p.Wbrt() + (size_t)(layer * 3) * DM * 512, p.U(), 1536, nt * 256, mt * 256, acc, lds,
                                       (size_t)DM * 512 * 2, (size_t)NTC * 512 * 2, hk);
        const int tid2 = opaque_tid(), lane2 = tid2 & 63, fr = lane2 & 15, fq = lane2 >> 4;
#pragma unroll
        for (int ai = 0; ai < 2; ai++) {
            const int f0 = nt * 256 + ai * 128 + wr * 64;
            epi_store_rows<true>(lds, wid, lane2, fr, fq, wc, mt, p.Mb() + f0, DM, [&](int bj, int n, int m) -> u32x2 {
                const int tk = mt * 256 + bj * 128 + wc * 32 + n * 16 + fr;
                const unsigned gw = *(const unsigned*)((const unsigned char*)p.G() + (size_t)tk * 3072 + 2048 + f0 + fq * 16 + m * 4);
                const f32x4 v = acc[ai][bj][m][n] * (1.f / 255.f);
                return (u32x2){pk2(v[0] * ub(gw, 0), v[1] * ub(gw, 1)), pk2(v[2] * ub(gw, 2), v[3] * ub(gw, 3))};
            });
        }
        asm volatile("s_waitcnt vmcnt(0)" ::: "memory");
        __syncthreads();
        if (threadIdx.x == 0) {
            __builtin_amdgcn_fence(__ATOMIC_RELEASE, "agent");
            asm volatile("s_waitcnt vmcnt(0)" ::: "memory");
            xb_add(&p.BAR()[G23_PC(mt)], 1u);
        }
    }
}

__device__ __forceinline__ void phase_gemm3(const Params& p, int layer, int inst, LAS unsigned char* lds, volatile LAS unsigned* bst) {
    const int tid = opaque_tid(), wid = __builtin_amdgcn_readfirstlane(tid >> 6), wr = wid >> 2, wc = wid & 3;
    const unsigned nvalid = (layer == NLAY - 1) ? 256u : 288u;
    for (;;) {
        __syncthreads();
        if (threadIdx.x == 0) {
            const unsigned tk = xb_add(&p.BAR()[G23_TK], 1u) - (544u * (unsigned)inst - (inst > 3 ? 32u : 0u));
            if (tk < nvalid) {
                const int pmt = panel_of((int)(tk >> 2));
                unsigned* pc = &p.BAR()[G23_PC(pmt)];
                const unsigned want = panel_want(pmt, inst);
                XB_SPIN_SLOW(xb_ld(pc) < want, p.BAR());
                __builtin_amdgcn_fence(__ATOMIC_ACQUIRE, "agent");
                asm volatile("s_waitcnt vmcnt(0)" ::: "memory");
            }
            bst[2] = tk;
        }
        __syncthreads();
        const unsigned L = (unsigned)__builtin_amdgcn_readfirstlane((int)bst[2]);
        if (L >= nvalid) break;
        const int mt = panel_of((int)(L >> 2)), nt = (int)(L & 3u);
        f32x4 acc[2][2][4][2];
        gemm256<DM, DM>(p.Woutt() + (size_t)layer * DM * DM, p.Mb(), DM, nt * 256, mt * 256, acc, lds);
        const int tid2 = opaque_tid(), lane2 = tid2 & 63, fr = lane2 & 15, fq = lane2 >> 4;
#pragma unroll
        for (int ai = 0; ai < 2; ai++)
            epi_store_rows(lds, wid, lane2, fr, fq, wc, mt, (bf16_t*)p.Y() + nt * 256 + ai * 128 + wr * 64, DM, [&](int bj, int n, int m) -> u32x2 {
                const f32x4 v = acc[ai][bj][m][n];
                return (u32x2){pk2(v[0], v[1]), pk2(v[2], v[3])};
            });
        asm volatile("s_waitcnt vmcnt(0)" ::: "memory");
        __syncthreads();
        if (threadIdx.x == 0) {
            __builtin_amdgcn_fence(__ATOMIC_RELEASE, "agent");
            asm volatile("s_waitcnt vmcnt(0)" ::: "memory");
            xb_add(&p.BAR()[G23_PC2(mt)], 1u);
        }
    }
}

__global__ void __launch_bounds__(512, 2) fwd_kernel(Params p) {
    extern __shared__ __attribute__((aligned(16))) unsigned char lds[];
    cg::grid_group grid = cg::this_grid();
    volatile LAS unsigned* bst = (volatile LAS unsigned*)((LAS unsigned char*)lds + LDS_BYTES);
    if (threadIdx.x == 0) { bst[0] = 0u; bst[1] = 0u; }
    __syncthreads();
    (void)xcd_barrier_post(p.BAR(), bst);
    phase_pro_a(p, lds);
    grid.sync();
    phase_pro_b(p);
    xcd_barrier(p.BAR(), bst);
    for (int chunk = 0; chunk < NB / CB; chunk++) {
        phase_norm(p, chunk, -1);
        xcd_barrier(p.BAR(), bst);
        for (int layer = 0; layer < NLAY; layer++) {
            phase_gemm1(p, layer, (LAS unsigned char*)lds);
            xcd_barrier(p.BAR(), bst);
            phase_attn(p, layer, lds);
            xcd_barrier(p.BAR(), bst);
            phase_gemm2(p, layer, (LAS unsigned char*)lds);
            phase_gemm3(p, layer, chunk * NLAY + layer, (LAS unsigned char*)lds, bst);
            phase_norm_ticketed(p, chunk, layer, chunk * NLAY + layer, bst);
            xcd_barrier(p.BAR(), bst);
        }
    }
}

extern "C" void kernel_launch(void* const* d_in, const int* in_sizes, int n_in, void* d_out, int out_size, void* d_ws, size_t ws_size, hipStream_t stream) {
    static int grid_blocks = 0;
    if (!grid_blocks) {
        int dev = 0, cus = 0, per_cu = 0;
        hipGetDevice(&dev);
        hipDeviceGetAttribute(&cus, hipDeviceAttributeMultiprocessorCount, dev);
        hipFuncSetAttribute((const void*)fwd_kernel, hipFuncAttributeMaxDynamicSharedMemorySize, LDS_BYTES + 16);
        hipOccupancyMaxActiveBlocksPerMultiprocessor(&per_cu, (const void*)fwd_kernel, NTHR, LDS_BYTES + 16);
        if (per_cu < 1) per_cu = 1;
        if (per_cu > 1) per_cu = 1;
        grid_blocks = cus * per_cu;
    }
    Params p{};
    const float* const* in = (const float* const*)d_in;
    p.x = in[0]; p.c = in[1]; p.ctx = in[2]; p.c_ctx = in[3]; p.w_ada = in[4]; p.b_ada = in[5]; p.g_pre = in[6]; p.g_post = in[7];
    p.w_in = in[8]; p.q_norm = in[9]; p.k_norm = in[10]; p.lam_q1 = in[11]; p.lam_k1 = in[12]; p.lam_q2 = in[13]; p.lam_k2 = in[14];
    p.subln = in[15]; p.sink = in[16]; p.w_br_a = in[17]; p.w_br_b = in[18]; p.w_br_c = in[19]; p.w_mg = in[20]; p.b_mg = in[21]; p.w_out = in[22];
    p.out = (float*)d_out;
    p.ws = (unsigned char*)d_ws;
    if (WS_END > ws_size) { fprintf(stderr, "kernel_launch: workspace too small: need %zu, have %zu\n", (size_t)WS_END, ws_size); return; }
    hipMemsetAsync((unsigned char*)d_ws + OFF_BAR, 0, ALL_BAR_WORDS * 4, stream);
    void* args[] = {&p};
    hipError_t e = hipLaunchCooperativeKernel((void*)fwd_kernel, dim3(grid_blocks), dim3(NTHR), args, LDS_BYTES + 16, stream);
    if (e != hipSuccess) fprintf(stderr, "cooperative launch failed: %s (grid %d)\n", hipGetErrorString(e), grid_blocks);
}
```

```cpp
#include <hip/hip_runtime.h>
#include <hip/hip_cooperative_groups.h>
#include <cstdio>
#include <cstdint>
namespace cg = cooperative_groups;

typedef unsigned short bf16_t;
typedef short bf16x8 __attribute__((ext_vector_type(8)));
typedef float f32x16 __attribute__((ext_vector_type(16)));
typedef unsigned u32x4 __attribute__((ext_vector_type(4)));
typedef float f32x4 __attribute__((ext_vector_type(4)));
typedef unsigned u32x2 __attribute__((ext_vector_type(2)));

constexpr int NB = 16, SEQ = 2048, CTXL = 256, TT = 2304, DM = 1024, NLAY = 4, INW = 4608, N1 = 7680;
constexpr int CB = 8, NTC = CB * TT;
constexpr int LDS_BYTES = 147456;
constexpr int NTHR = 512;
constexpr int LROW = 144;
constexpr float LOG2E = 1.4426950408889634f;

#define MFMA(a, b, c) __builtin_amdgcn_mfma_f32_32x32x16_bf16((a), (b), (c), 0, 0, 0)

constexpr size_t al256(size_t x) { return (x + 255) & ~(size_t)255; }
constexpr size_t OFF_W1T = 0;
constexpr size_t OFF_WBRT = OFF_W1T + al256((size_t)NLAY * N1 * DM * 2);
constexpr size_t OFF_WOUTT = OFF_WBRT + al256((size_t)NLAY * 3 * DM * 512 * 2);
constexpr size_t OFF_MODP = OFF_WOUTT + al256((size_t)NLAY * DM * DM * 2);
constexpr size_t OFF_MOD = OFF_MODP + al256((size_t)8 * NLAY * 17 * 3072 * 4);
constexpr size_t OFF_ROPE = OFF_MOD + al256((size_t)NLAY * 17 * 3072 * 4);
constexpr size_t OFF_LAM = OFF_ROPE + al256(64 * 16 * 2 * 4);
constexpr size_t OFF_BAR = OFF_LAM + 256;
constexpr size_t OFF_CX = OFF_BAR + al256((size_t)16384 * 4);
constexpr size_t OFF_H = OFF_CX + al256((size_t)NB * CTXL * DM * 4);
constexpr size_t OFF_U = OFF_H + al256((size_t)NTC * DM * 2);
constexpr size_t OFF_PROJ = OFF_U + al256((size_t)NTC * 1536 * 2);
constexpr size_t OFF_VTA = OFF_PROJ + al256((size_t)NTC * INW * 2);
constexpr size_t OFF_VTB = OFF_VTA + al256((size_t)CB * 2 * 64 * TT * 2);
constexpr size_t OFF_VTC = OFF_VTB + al256((size_t)CB * 4 * 128 * TT * 2);
constexpr size_t OFF_G = OFF_VTC + al256((size_t)CB * 2 * 64 * TT * 2);
constexpr size_t WS_END = OFF_G + al256((size_t)NTC * 3072 * 2);
constexpr size_t OFF_MB = OFF_PROJ;
constexpr size_t OFF_Y = OFF_PROJ + (size_t)NTC * DM * 2;

struct Params {
    const float *x, *c, *ctx, *c_ctx, *w_ada, *b_ada, *g_pre, *g_post, *w_in, *q_norm, *k_norm;
    const float *lam_q1, *lam_k1, *lam_q2, *lam_k2, *subln, *sink, *w_br_a, *w_br_b, *w_br_c, *w_mg, *b_mg, *w_out;
    float* out;
    unsigned char* ws;
    __device__ __forceinline__ bf16_t* W1t() const { return (bf16_t*)(ws + OFF_W1T); }
    __device__ __forceinline__ bf16_t* Wbrt() const { return (bf16_t*)(ws + OFF_WBRT); }
    __device__ __forceinline__ bf16_t* Woutt() const { return (bf16_t*)(ws + OFF_WOUTT); }
    __device__ __forceinline__ float* MODP() const { return (float*)(ws + OFF_MODP); }
    __device__ __forceinline__ float* MOD() const { return (float*)(ws + OFF_MOD); }
    __device__ __forceinline__ float* ROPE() const { return (float*)(ws + OFF_ROPE); }
    __device__ __forceinline__ float* LAM() const { return (float*)(ws + OFF_LAM); }
    __device__ __forceinline__ unsigned* BAR() const { return (unsigned*)(ws + OFF_BAR); }
    __device__ __forceinline__ float* CX() const { return (float*)(ws + OFF_CX); }
    __device__ __forceinline__ bf16_t* H() const { return (bf16_t*)(ws + OFF_H); }
    __device__ __forceinline__ bf16_t* U() const { return (bf16_t*)(ws + OFF_U); }
    __device__ __forceinline__ bf16_t* PROJ() const { return (bf16_t*)(ws + OFF_PROJ); }
    __device__ __forceinline__ bf16_t* VtA() const { return (bf16_t*)(ws + OFF_VTA); }
    __device__ __forceinline__ bf16_t* VtB() const { return (bf16_t*)(ws + OFF_VTB); }
    __device__ __forceinline__ bf16_t* VtC() const { return (bf16_t*)(ws + OFF_VTC); }
    __device__ __forceinline__ bf16_t* G() const { return (bf16_t*)(ws + OFF_G); }
    __device__ __forceinline__ bf16_t* Mb() const { return (bf16_t*)(ws + OFF_MB); }
    __device__ __forceinline__ float* Y() const { return (float*)(ws + OFF_Y); }
};

typedef __bf16 bf16x2_t __attribute__((ext_vector_type(2)));
typedef float f32x2_t __attribute__((ext_vector_type(2)));
__device__ __forceinline__ unsigned pk2(float lo, float hi) { const f32x2_t f = {lo, hi}; const bf16x2_t b = __builtin_convertvector(f, bf16x2_t); return __builtin_bit_cast(unsigned, b); }
__device__ __forceinline__ float bflo(unsigned w) { return __uint_as_float(w << 16); }
__device__ __forceinline__ float bfhi(unsigned w) { return __uint_as_float(w & 0xffff0000u); }
__device__ __forceinline__ float sigmoid_f(float v) { return __builtin_amdgcn_rcpf(1.f + __builtin_amdgcn_exp2f(-LOG2E * v)); }
__device__ __forceinline__ float silu_f(float v) { return v * sigmoid_f(v); }
__device__ __forceinline__ float wave_sum(float v) {
    v += __shfl_xor(v, 32); v += __shfl_xor(v, 16); v += __shfl_xor(v, 8); v += __shfl_xor(v, 4); v += __shfl_xor(v, 2); v += __shfl_xor(v, 1); return v;
}
__device__ __forceinline__ int opaque_tid() { int t = threadIdx.x; asm volatile("" : "+v"(t)); return t; }
__device__ __forceinline__ float lam_init_of(int l) { return 0.8f - 0.6f * expf(-0.3f * (float)l); }


#define XB_TMO      128
#define XB_XCNT(j)  (256  + 64 * (j))
#define XB_XSUB(j)  (1280 + 64 * (j))
#define XB_XGEN(j)  (2304 + 64 * (j))
#define XB_TOP      3328
#define XB_TOPGEN   3392
#define XCD_BAR_WORDS 3456
#define G23_PC(mt)   (XCD_BAR_WORDS + 64 * (mt))
#define G23_TK       (XCD_BAR_WORDS + 64 * 72)
#define G23_PC2(mt)  (XCD_BAR_WORDS + 64 * 73 + 64 * (mt))
#define G23_TK2      (XCD_BAR_WORDS + 64 * 145)
#define ALL_BAR_WORDS (XCD_BAR_WORDS + 64 * 146)
#define XB_SPIN_CAP (1u << 18)
#define LAS __attribute__((address_space(3)))
__device__ __forceinline__ unsigned xb_ld(unsigned* p)              { return __hip_atomic_load(p, __ATOMIC_RELAXED, __HIP_MEMORY_SCOPE_AGENT); }
__device__ __forceinline__ unsigned xb_add(unsigned* p, unsigned v) { return __hip_atomic_fetch_add(p, v, __ATOMIC_RELAXED, __HIP_MEMORY_SCOPE_AGENT); }
__device__ __forceinline__ unsigned xb_xcc_id() { return (unsigned)__builtin_amdgcn_s_getreg((3 << 11) | 20) & 0xFu; }
#define XB_SPIN(cond, bar) do { unsigned _sp = 0; while (cond) { __builtin_amdgcn_s_sleep(1); \
    if ((++_sp & 255u) == 0u) { if (xb_ld(&(bar)[XB_TMO])) break; if (_sp > XB_SPIN_CAP) { atomicAdd(&(bar)[XB_TMO], 1u); break; } } } } while (0)
#define XB_SPIN_SLOW(cond, bar) do { unsigned _sp = 0; while (cond) { __builtin_amdgcn_s_sleep(32); \
    if ((++_sp & 63u) == 0u) { if (xb_ld(&(bar)[XB_TMO])) break; if (_sp > (1u << 17)) { atomicAdd(&(bar)[XB_TMO], 1u); break; } } } } while (0)
struct XcdBarrier { unsigned* bar; unsigned x; volatile LAS unsigned* st; };
__device__ __forceinline__ XcdBarrier xcd_barrier_post(unsigned* bar, volatile LAS unsigned* st) {
    XcdBarrier b; b.bar = bar; b.x = xb_xcc_id(); b.st = st;
    if (threadIdx.x == 0) (void)xb_add(&bar[XB_XCNT(b.x)], 1u);
    return b;
}
__device__ __forceinline__ void xcd_barrier_complete(unsigned* bar, unsigned x, unsigned& nloc, unsigned& nx) {
    const unsigned G = gridDim.x * gridDim.y * gridDim.z;
    unsigned sum, cnt, mine, sp = 0u;
    for (;;) {
        sum = 0u; cnt = 0u; mine = 0u;
#pragma unroll
        for (unsigned j = 0; j < 16; ++j) { const unsigned c = xb_ld(&bar[XB_XCNT(j)]); sum += c; cnt += (c > 0u) ? 1u : 0u; mine = (j == x) ? c : mine; }
        if (sum == G) break;
        __builtin_amdgcn_s_sleep(1);
        if ((++sp & 255u) == 0u) { if (xb_ld(&bar[XB_TMO])) break; if (sp > XB_SPIN_CAP) { atomicAdd(&bar[XB_TMO], 1u); break; } }
    }
    nloc = mine > 0u ? mine : 1u; nx = cnt > 0u ? cnt : 1u;
}
__device__ __forceinline__ void xcd_barrier(unsigned* bar_, volatile LAS unsigned* st_) {
    XcdBarrier b; b.bar = bar_; b.x = xb_xcc_id(); b.st = st_;
    asm volatile("s_waitcnt vmcnt(0)" ::: "memory");
    __syncthreads();
    if (threadIdx.x == 0) {
        unsigned* bar = b.bar;
        __builtin_amdgcn_s_waitcnt(0);
        unsigned nloc = b.st[0], nx = b.st[1];
        if (nloc == 0u) { xcd_barrier_complete(bar, b.x, nloc, nx); b.st[0] = nloc; b.st[1] = nx; }
        const unsigned old = xb_add(&bar[XB_XSUB(b.x)], 1u);
        const unsigned gen = old / nloc;
        if (old + 1u == (gen + 1u) * nloc) {
            __builtin_amdgcn_fence(__ATOMIC_RELEASE, "agent");
            asm volatile("s_waitcnt vmcnt(0)" ::: "memory");
            const unsigned og = xb_add(&bar[XB_TOP], 1u);
            const unsigned tg = og / nx;
            if (og + 1u == (tg + 1u) * nx) xb_add(&bar[XB_TOPGEN], 1u);
            else XB_SPIN(xb_ld(&bar[XB_TOPGEN]) == tg, bar);
            __builtin_amdgcn_fence(__ATOMIC_ACQUIRE, "agent");
            xb_add(&bar[XB_XGEN(b.x)], 1u);
            asm volatile("s_waitcnt vmcnt(0)" ::: "memory");
        } else {
            XB_SPIN(xb_ld(&bar[XB_XGEN(b.x)]) == gen, bar);
            __builtin_amdgcn_fence(__ATOMIC_ACQUIRE, "agent");
            asm volatile("s_waitcnt vmcnt(0)" ::: "memory");
        }
    }
    __syncthreads();
}

template <int NY>
__device__ __forceinline__ void gemm_tile(const bf16_t* __restrict__ X, int ldx, const bf16_t* __restrict__ Y, int ldy, int K,
                                          f32x16 (&acc)[2][NY], unsigned char* lds, int tid) {
    const int lane = tid & 63, wave = tid >> 6, wm = wave >> 1, wn = wave & 1, l31 = lane & 31, hh = lane >> 5;
    const int lrow = tid >> 3, lc = tid & 7;
    const bf16_t* gx = X + (size_t)lrow * ldx + lc * 8;
    const bf16_t* gy = Y + (size_t)lrow * ldy + lc * 8;
    u32x4 rx[4], ry[2 * NY];
#pragma unroll
    for (int i = 0; i < 4; i++) rx[i] = *(const u32x4*)(gx + (size_t)(32 * i) * ldx);
#pragma unroll
    for (int i = 0; i < 2 * NY; i++) ry[i] = *(const u32x4*)(gy + (size_t)(32 * i) * ldy);
    __syncthreads();
    unsigned char* wx = lds + lrow * LROW + lc * 16;
#pragma unroll
    for (int i = 0; i < 4; i++) *(u32x4*)(wx + i * 32 * LROW) = rx[i];
#pragma unroll
    for (int i = 0; i < 2 * NY; i++) *(u32x4*)(wx + 18432 + i * 32 * LROW) = ry[i];
    __syncthreads();
    const int nk = K >> 6;
    const unsigned char* rxb = lds + (wm * 64 + l31) * LROW + hh * 16;
    const unsigned char* ryb = lds + 18432 + (wn * 32 * NY + l31) * LROW + hh * 16;
    for (int kt = 0; kt < nk; kt++) {
        const int cur = (kt & 1) * 36864;
        const bool more = (kt + 1 < nk);
        if (more) {
            const int ko = (kt + 1) * 64;
#pragma unroll
            for (int i = 0; i < 4; i++) rx[i] = *(const u32x4*)(gx + (size_t)(32 * i) * ldx + ko);
#pragma unroll
            for (int i = 0; i < 2 * NY; i++) ry[i] = *(const u32x4*)(gy + (size_t)(32 * i) * ldy + ko);
        }
#pragma unroll
        for (int kk = 0; kk < 4; kk++) {
            bf16x8 xf[2], yf[NY];
            xf[0] = *(const bf16x8*)(rxb + cur + kk * 32);
            xf[1] = *(const bf16x8*)(rxb + cur + 32 * LROW + kk * 32);
#pragma unroll
            for (int yi = 0; yi < NY; yi++) yf[yi] = *(const bf16x8*)(ryb + cur + yi * 32 * LROW + kk * 32);
#pragma unroll
            for (int xi = 0; xi < 2; xi++)
#pragma unroll
                for (int yi = 0; yi < NY; yi++) acc[xi][yi] = MFMA(xf[xi], yf[yi], acc[xi][yi]);
        }
        if (more) {
            unsigned char* w2 = wx + (36864 - cur);
#pragma unroll
            for (int i = 0; i < 4; i++) *(u32x4*)(w2 + i * 32 * LROW) = rx[i];
#pragma unroll
            for (int i = 0; i < 2 * NY; i++) *(u32x4*)(w2 + 18432 + i * 32 * LROW) = ry[i];
        }
        __syncthreads();
    }
}

template <int NY>
__device__ __forceinline__ void zero_acc(f32x16 (&acc)[2][NY]) {
#pragma unroll
    for (int a = 0; a < 2; a++)
#pragma unroll
        for (int b = 0; b < NY; b++)
#pragma unroll
            for (int r = 0; r < 16; r++) acc[a][b][r] = 0.f;
}

template <bool PERM = false>
__device__ __forceinline__ void transpose_tile(const float* __restrict__ src, int ldsrc, bf16_t* __restrict__ dst, int lddst, int k0, int n0, float* tile) {
    const int tid = opaque_tid();
    __syncthreads();
#pragma unroll
    for (int i = 0; i < 2; i++) {
        const int id = tid + i * 512, r = id >> 4, c4 = id & 15;
        const float4 v = *(const float4*)(src + (size_t)(k0 + r) * ldsrc + n0 + c4 * 4);
        float* tp = tile + r * 65 + c4 * 4;
        tp[0] = v.x; tp[1] = v.y; tp[2] = v.z; tp[3] = v.w;
    }
    __syncthreads();
    const int n = tid >> 3, kq = tid & 7;
    u32x4 w;
#pragma unroll
    for (int j = 0; j < 4; j++) w[j] = pk2(tile[(kq * 8 + 2 * j) * 65 + n], tile[(kq * 8 + 2 * j + 1) * 65 + n]);
    const int nrow = PERM ? (((n >> 2) & 3) * 16 + ((n >> 4) & 3) * 4 + (n & 3)) : n;
    *(u32x4*)(dst + (size_t)(n0 + nrow) * lddst + k0 + kq * 8) = w;
}

__device__ __forceinline__ int nb2ob(int nb) {
    if (nb < 4) return nb;
    if (nb == 4) return 4;
    if (nb == 5) return 30;
    if (nb == 6) return 5;
    if (nb == 7) return 31;
    if (nb < 32) return nb - 2;
    return nb;
}

__device__ __forceinline__ void phase_pro_a(const Params& p, unsigned char* lds) {
    const int tid = opaque_tid();
    float* tile = (float*)lds;
    const int NCONV = 2560 * NLAY;
    for (int j = blockIdx.x; j < NCONV + 192; j += gridDim.x) {
        if (j < NCONV) {
            const int l = j / 2560; int r = j - l * 2560;
            if (r < 1920) {
                const int kt = r / 120, nt = r - kt * 120;
                const int ob = nb2ob(nt >> 1), oc = ob * 128 + (nt & 1) * 64;
                bf16_t* dstw = p.W1t() + ((size_t)l * N1 + nt * 64) * DM;
                if (oc < INW) transpose_tile(p.w_in + (size_t)l * DM * INW + oc, INW, dstw, DM, kt * 64, 0, tile);
                else transpose_tile(p.w_mg + (size_t)l * DM * 3072 + (oc - INW), 3072, dstw, DM, kt * 64, 0, tile);
            }
            else if (r < 2304) { r -= 1920; const int which = r >> 7; r &= 127; const int kt = r >> 4, nt = r & 15;
                bf16_t* dstw = p.Wbrt() + (size_t)(l * 3 + which) * DM * 512;
                if (which == 0) transpose_tile<true>(p.w_br_a + (size_t)l * 512 * DM, DM, dstw, 512, kt * 64, nt * 64, tile);
                else if (which == 1) transpose_tile<true>(p.w_br_b + (size_t)l * 512 * DM, DM, dstw, 512, kt * 64, nt * 64, tile);
                else transpose_tile<true>(p.w_br_c + (size_t)l * 512 * DM, DM, dstw, 512, kt * 64, nt * 64, tile); }
            else { r -= 2304; const int kt = r >> 4, nt = r & 15;
                transpose_tile(p.w_out + (size_t)l * DM * DM, DM, p.Woutt() + (size_t)l * DM * DM, DM, kt * 64, nt * 64, tile); }
        } else {
            const int jj = j - NCONV; const int l = jj / 48; const int rr = jj - l * 48; const int kc = rr / 6, jb = rr - kc * 6;
            float* sc = (float*)lds;
            __syncthreads();
            for (int idx = tid; idx < 17 * 128; idx += NTHR) {
                const int r = idx >> 7, k = idx & 127;
                const float v = (r < 16) ? p.c[r * DM + kc * 128 + k] : p.c_ctx[kc * 128 + k];
                sc[idx] = v / (1.f + expf(-v));
            }
            __syncthreads();
            float a[17];
#pragma unroll
            for (int r = 0; r < 17; r++) a[r] = 0.f;
            const float* w = p.w_ada + ((size_t)l * DM + kc * 128) * 3072 + jb * NTHR + tid;
            for (int k = 0; k < 128; k++) {
                const float wv = w[(size_t)k * 3072];
#pragma unroll
                for (int r = 0; r < 17; r++) a[r] += sc[r * 128 + k] * wv;
            }
#pragma unroll
            for (int r = 0; r < 17; r++) p.MODP()[((size_t)(kc * 4 + l) * 17 + r) * 3072 + jb * NTHR + tid] = a[r];
        }
    }
}

__device__ const double ROPE_FREQ[16] = {1.0, 0.5623413251903491, 0.31622776601683794, 0.1778279410038923, 0.1, 0.05623413251903491,
    0.031622776601683794, 0.01778279410038923, 0.01, 0.005623413251903491, 0.0031622776601683794, 0.001778279410038923,
    0.001, 0.0005623413251903491, 0.00031622776601683794, 0.0001778279410038923};

__device__ __forceinline__ void sincos_d(double a, double& s, double& c) {
    const double n = rint(a * 0.6366197723675814);
    double r = fma(-n, 1.5707963267948966, a); r = fma(-n, 6.123233995736766e-17, r);
    const double r2 = r * r;
    const double sp = r * (1.0 + r2 * (-1.0 / 6.0 + r2 * (1.0 / 120.0 + r2 * (-1.0 / 5040.0 + r2 * (1.0 / 362880.0 + r2 * (-1.0 / 39916800.0 + r2 * (1.0 / 6227020800.0 + r2 * (-1.0 / 1307674368000.0))))))));
    const double cp = 1.0 + r2 * (-0.5 + r2 * (1.0 / 24.0 + r2 * (-1.0 / 720.0 + r2 * (1.0 / 40320.0 + r2 * (-1.0 / 3628800.0 + r2 * (1.0 / 479001600.0 + r2 * (-1.0 / 87178291200.0 + r2 * (1.0 / 20922789888000.0))))))));
    const int q = ((int)n) & 3;
    if (q == 0) { s = sp; c = cp; } else if (q == 1) { s = cp; c = -sp; } else if (q == 2) { s = -sp; c = -cp; } else { s = -cp; c = sp; }
}

__device__ __forceinline__ void phase_pro_b(const Params& p) {
    const int tid = opaque_tid(), lane = tid & 63, wave = tid >> 6;
    const int gsz = gridDim.x * NTHR;
    for (int idx = blockIdx.x * NTHR + tid; idx < NLAY * 17 * 3072; idx += gsz) {
        const int l = idx / (17 * 3072), j = idx % 3072;
        float s = p.b_ada[l * 3072 + j];
#pragma unroll
        for (int kc = 0; kc < 8; kc++) s += p.MODP()[(size_t)kc * (NLAY * 17 * 3072) + idx];
        p.MOD()[idx] = s;
    }
    if (blockIdx.x == 0 && wave < NLAY) {
        const int l = wave;
        float a = p.lam_q1[l * 64 + lane] * p.lam_k1[l * 64 + lane];
        float b = p.lam_q2[l * 64 + lane] * p.lam_k2[l * 64 + lane];
        a = wave_sum(a); b = wave_sum(b);
        if (lane == 0) p.LAM()[l] = expf(a) - expf(b) + lam_init_of(l);
    }
    if (blockIdx.x == (gridDim.x > 1 ? 1 : 0)) {
        for (int idx = tid; idx < 1024; idx += NTHR) {
            const int pp = idx >> 4, i = idx & 15;
            double s, c; sincos_d((double)pp * ROPE_FREQ[i], s, c);
            p.ROPE()[idx * 2] = (float)c; p.ROPE()[idx * 2 + 1] = (float)s;
        }
    }
}

__device__ __forceinline__ int panel_of(int pi) { return pi < 64 ? (pi >> 3) * 9 + 1 + (pi & 7) : (pi - 64) * 9; }
__device__ __forceinline__ unsigned panel_want(int mt, int inst) { return 4u * (unsigned)(inst + 1) - ((inst > 3 && (mt % 9) == 0) ? 4u : 0u); }
template <bool HOIST>
__device__ __forceinline__ void norm_rows(const Params& p, int chunk, int layer, int row_begin, int row_end, int row_step) {
    const int tid = opaque_tid(), lane = tid & 63, wave = tid >> 6;
    float4 gq[4], ga[4], sh[4];
    auto load_vecs = [&](int mr) {
        if (layer >= 0) {
            const float* gate = p.MOD() + ((size_t)layer * 17 + mr) * 3072 + 2048;
            const float* gp = p.g_post + layer * DM;
#pragma unroll
            for (int i = 0; i < 4; i++) { const int e = i * 256 + lane * 4; const float4 g = *(const float4*)(gate + e), q = *(const float4*)(gp + e);
                gq[i] = make_float4(g.x * q.x, g.y * q.y, g.z * q.z, g.w * q.w); }
        }
        if (layer < NLAY - 1) {
            const int nl = layer + 1;
            const float* md = p.MOD() + ((size_t)nl * 17 + mr) * 3072;
            const float* gpre = p.g_pre + nl * DM;
#pragma unroll
            for (int i = 0; i < 4; i++) { const int e = i * 256 + lane * 4; const float4 s4 = *(const float4*)(md + e), scl = *(const float4*)(md + 1024 + e), g = *(const float4*)(gpre + e);
                ga[i] = make_float4(g.x * (1.f + scl.x), g.y * (1.f + scl.y), g.z * (1.f + scl.z), g.w * (1.f + scl.w)); sh[i] = s4; }
        }
    };
    if (HOIST) { const int bl0 = row_begin / TT, t0 = row_begin - bl0 * TT; load_vecs(t0 < CTXL ? 16 : chunk * CB + bl0); }
    for (int row = row_begin + wave; row < row_end; row += row_step) {
        const int bl = row / TT, t = row - bl * TT, b = chunk * CB + bl;
        const bool isctx = t < CTXL;
        if (layer == NLAY - 1 && isctx) continue;
        const float* xin; float* xst; int mr;
        if (isctx) { const size_t o = ((size_t)b * CTXL + t) * DM; xin = (layer <= 0 ? p.ctx : (const float*)p.CX()) + o; xst = p.CX() + o; mr = 16; }
        else { const size_t o = ((size_t)b * SEQ + (t - CTXL)) * DM; xin = (layer <= 0 ? p.x : (const float*)p.out) + o; xst = p.out + o; mr = b; }
        if (!HOIST) load_vecs(mr);
        float4 xv[4];
#pragma unroll
        for (int i = 0; i < 4; i++) { const f32x4 t4 = __builtin_nontemporal_load((const f32x4*)(xin + i * 256 + lane * 4)); xv[i] = make_float4(t4[0], t4[1], t4[2], t4[3]); }
        if (layer >= 0) {
            const bf16_t* yr = (const bf16_t*)p.Y() + (size_t)row * DM;
            float4 yv[4]; float ss = 0.f;
#pragma unroll
            for (int i = 0; i < 4; i++) { const u32x2 w = __builtin_nontemporal_load((const u32x2*)(yr + i * 256 + lane * 4)); yv[i] = make_float4(bflo(w[0]), bfhi(w[0]), bflo(w[1]), bfhi(w[1]));
                ss += yv[i].x * yv[i].x + yv[i].y * yv[i].y + yv[i].z * yv[i].z + yv[i].w * yv[i].w; }
            ss = wave_sum(ss);
            const float rstd = rsqrtf(ss * (1.f / DM) + 1e-6f);
#pragma unroll
            for (int i = 0; i < 4; i++) {
                const int e = i * 256 + lane * 4;
                xv[i].x += gq[i].x * (yv[i].x * rstd); xv[i].y += gq[i].y * (yv[i].y * rstd);
                xv[i].z += gq[i].z * (yv[i].z * rstd); xv[i].w += gq[i].w * (yv[i].w * rstd);
                __builtin_nontemporal_store((f32x4){xv[i].x, xv[i].y, xv[i].z, xv[i].w}, (f32x4*)(xst + e));
            }
        }
        if (layer < NLAY - 1) {
            float ss = 0.f;
#pragma unroll
            for (int i = 0; i < 4; i++) ss += xv[i].x * xv[i].x + xv[i].y * xv[i].y + xv[i].z * xv[i].z + xv[i].w * xv[i].w;
            ss = wave_sum(ss);
            const float rstd = rsqrtf(ss * (1.f / DM) + 1e-6f);
#pragma unroll
            for (int i = 0; i < 4; i++) {
                const int e = i * 256 + lane * 4;
                const float h0 = xv[i].x * rstd * ga[i].x + sh[i].x, h1 = xv[i].y * rstd * ga[i].y + sh[i].y;
                const float h2 = xv[i].z * rstd * ga[i].z + sh[i].z, h3 = xv[i].w * rstd * ga[i].w + sh[i].w;
                *(uint2*)(p.H() + (size_t)row * DM + e) = make_uint2(pk2(h0, h1), pk2(h2, h3));
            }
        }
    }
}
__device__ __forceinline__ void phase_norm(const Params& p, int chunk, int layer) {
    norm_rows<false>(p, chunk, layer, blockIdx.x * 8, NTC, gridDim.x * 8);
}
__device__ __forceinline__ void phase_norm_ticketed(const Params& p, int chunk, int layer, int inst, volatile LAS unsigned* bst) {
    for (;;) {
        __syncthreads();
        if (threadIdx.x == 0) {
            const unsigned tk = xb_add(&p.BAR()[G23_TK2], 1u) - 544u * (unsigned)inst;
            if (tk < 288u && !(layer == NLAY - 1 && ((int)(tk >> 2) % 9) == 0)) {
                unsigned* pc = &p.BAR()[G23_PC2(tk >> 2)];
                const unsigned want = panel_want((int)(tk >> 2), inst);
                XB_SPIN_SLOW(xb_ld(pc) < want, p.BAR());
                __builtin_amdgcn_fence(__ATOMIC_ACQUIRE, "agent");
                asm volatile("s_waitcnt vmcnt(0)" ::: "memory");
            }
            bst[2] = tk;
        }
        __syncthreads();
        const unsigned it = (unsigned)__builtin_amdgcn_readfirstlane((int)bst[2]);
        if (it >= 288u) break;
        norm_rows<true>(p, chunk, layer, (int)it * 64, (int)it * 64 + 64, 8);
    }
}

__device__ __forceinline__ int lds_byte(int r, int c) {
    const int st = (r >> 4) * 2 + (c >> 5), rr = r & 15, cc = c & 31, ob = rr * 64 + cc * 2;
    return st * 1024 + (ob ^ (((ob >> 9) & 1) << 5));
}
__device__ __forceinline__ void stage_rc(int b, int& R, int& C) {
    const int st = b / 1024, sb = b % 1024, swz = sb ^ (((sb >> 9) & 1) << 5);
    R = (st >> 1) * 16 + swz / 64; C = (st & 1) * 32 + (swz % 64) / 2;
}
struct NoHook { __device__ __forceinline__ void operator()(int, f32x4 (&)[2][2][4][2]) const {} };
template <int LDA, int LDB, int KSEG = 0, class Hook = NoHook>
__device__ __forceinline__ void gemm256(const bf16_t* __restrict__ A, const bf16_t* __restrict__ Bt, const int K, const int brow, const int bcol,
                                        f32x4 (&acc)[2][2][4][2], LAS unsigned char* lds, const size_t segA = 0, const size_t segB = 0, const Hook hook = Hook()) {
    constexpr int BK = 64, HALF = 128, HTB = HALF * BK * 2;
    const int tid = opaque_tid(), wid = __builtin_amdgcn_readfirstlane(tid >> 6), lane = tid & 63, wr = wid >> 2, wc = wid & 3, fr = lane & 15, fq = lane >> 4;
    unsigned voffA[2], voffB[2];
#pragma unroll
    for (int i = 0; i < 2; ++i) { int R, C; stage_rc(tid * 16 + i * 8192, R, C); voffA[i] = (unsigned)(R * LDA + C) * 2u; voffB[i] = (unsigned)(R * LDB + C) * 2u; }
    const size_t kstep = (size_t)(BK * 2);
    const size_t hstepA = (size_t)HALF * LDA * 2, hstepB = (size_t)HALF * LDB * 2;
    const unsigned ldsw = (unsigned)wid * 1024u;
    const int aoff = lds_byte(wr * 64 + fr, fq * 8), boff = lds_byte(wc * 32 + fr, fq * 8);
    const char* cA = (const char*)(A + (size_t)brow * LDA);
    const char* cB = (const char*)(Bt + (size_t)bcol * LDB);
    auto pA = [&](int T) -> const char* { return KSEG ? cA + (size_t)(T / (KSEG ? KSEG : 1)) * segA + (size_t)(T % (KSEG ? KSEG : 1)) * kstep : cA + (size_t)T * kstep; };
    auto pB = [&](int T) -> const char* { return KSEG ? cB + (size_t)(T / (KSEG ? KSEG : 1)) * segB + (size_t)(T % (KSEG ? KSEG : 1)) * kstep : cB + (size_t)T * kstep; };
#define SA(b, h) (((b) * 2 + (h)) * HTB)
#define SB(b, h) ((4 + (b) * 2 + (h)) * HTB)
#define STAGE(bufoff, gbase, voff) do { _Pragma("unroll") for (int _i = 0; _i < 2; ++_i) \
        __builtin_amdgcn_global_load_lds((const unsigned*)((const char*)(gbase) + voff[_i]), (LAS unsigned*)(lds + (bufoff) + ldsw + _i * 8192), 16, 0, 0); } while (0)
#define LDA(dst, b, h) do { _Pragma("unroll") for (int m = 0; m < 4; ++m) _Pragma("unroll") for (int k = 0; k < 2; ++k) dst[m][k] = *(const LAS bf16x8*)(lds + SA(b, h) + aoff + m * 2048 + k * 1024); } while (0)
#define LDB(dst, b, h) do { _Pragma("unroll") for (int n = 0; n < 2; ++n) _Pragma("unroll") for (int k = 0; k < 2; ++k) dst[n][k] = *(const LAS bf16x8*)(lds + SB(b, h) + boff + n * 2048 + k * 1024); } while (0)
#define MMA(ai, bj, At, Bx) do { __builtin_amdgcn_s_setprio(1); _Pragma("unroll") for (int m = 0; m < 4; ++m) _Pragma("unroll") for (int n = 0; n < 2; ++n) _Pragma("unroll") for (int k = 0; k < 2; ++k) \
      acc[ai][bj][m][n] = __builtin_amdgcn_mfma_f32_16x16x32_bf16(At[m][k], Bx[n][k], acc[ai][bj][m][n], 0, 0, 0); \
    __builtin_amdgcn_s_setprio(0); } while (0)
#define WAIT_V(n) asm volatile("s_waitcnt vmcnt(" #n ")" ::: "memory")
#define WAIT_L(n) asm volatile("s_waitcnt lgkmcnt(" #n ")" ::: "memory")
#define BAR __builtin_amdgcn_s_barrier()
#define SCHED __builtin_amdgcn_sched_barrier(0)
#pragma unroll
    for (int a = 0; a < 2; a++)
#pragma unroll
        for (int b = 0; b < 2; b++)
#pragma unroll
            for (int m = 0; m < 4; m++)
#pragma unroll
                for (int n = 0; n < 2; n++) acc[a][b][m][n] = (f32x4){0.f, 0.f, 0.f, 0.f};
    bf16x8 At[4][2], B0[2][2], B1[2][2];
    const int nt = K / BK;
    WAIT_V(0); WAIT_L(0);
    __syncthreads();
    STAGE(SB(0, 0), cB, voffB); STAGE(SA(0, 0), cA, voffA); STAGE(SB(0, 1), cB + hstepB, voffB); STAGE(SA(0, 1), cA + hstepA, voffA);
    if (wr == 1) BAR;
    WAIT_V(4); BAR;
    STAGE(SB(1, 0), pB(1), voffB); STAGE(SA(1, 0), pA(1), voffA); STAGE(SB(1, 1), pB(1) + hstepB, voffB);
    WAIT_V(6); BAR;
    for (int t = 0; t < nt - 2; t += 2) {
        if (KSEG && t > 0 && (t % (KSEG ? KSEG : 1)) == 0) hook(t / (KSEG ? KSEG : 1), acc);
        const char* a1 = pA(t + 1); const char* a2 = pA(t + 2); const char* a3 = pA(t + 3);
        const char* b2 = pB(t + 2); const char* b3 = pB(t + 3);
        LDB(B0, 0, 0); SCHED; LDA(At, 0, 0); STAGE(SA(1, 1), a1 + hstepA, voffA);
        WAIT_L(8); BAR; WAIT_L(0); MMA(0, 0, At, B0); BAR; SCHED;
        LDB(B1, 0, 1); STAGE(SB(0, 0), b2, voffB);
        BAR; WAIT_L(0); MMA(0, 1, At, B1); BAR;
        LDA(At, 0, 1); STAGE(SA(0, 0), a2, voffA);
        BAR; WAIT_L(0); MMA(1, 0, At, B0); BAR; SCHED;
        STAGE(SB(0, 1), b2 + hstepB, voffB);
        WAIT_V(6); BAR; MMA(1, 1, At, B1); BAR;
        LDB(B0, 1, 0); SCHED; LDA(At, 1, 0); STAGE(SA(0, 1), a2 + hstepA, voffA);
        WAIT_L(8); BAR; WAIT_L(0); MMA(0, 0, At, B0); BAR; SCHED;
        LDB(B1, 1, 1); STAGE(SB(1, 0), b3, voffB);
        BAR; WAIT_L(0); MMA(0, 1, At, B1); BAR;
        LDA(At, 1, 1); STAGE(SA(1, 0), a3, voffA);
        BAR; WAIT_L(0); MMA(1, 0, At, B0); BAR; SCHED;
        STAGE(SB(1, 1), b3 + hstepB, voffB);
        WAIT_V(6); BAR; MMA(1, 1, At, B1); BAR;
    }
    { LDB(B0, 0, 0); LDA(At, 0, 0); STAGE(SA(1, 1), pA(nt - 1) + hstepA, voffA);
      BAR; WAIT_L(0); MMA(0, 0, At, B0); BAR;
      LDB(B1, 0, 1); BAR; WAIT_L(0); MMA(0, 1, At, B1); BAR;
      LDA(At, 0, 1); WAIT_V(4); BAR; WAIT_L(0); MMA(1, 0, At, B0); MMA(1, 1, At, B1); BAR; }
    { LDB(B0, 1, 0); LDA(At, 1, 0); WAIT_V(2); BAR; WAIT_L(0); MMA(0, 0, At, B0); BAR;
      LDB(B1, 1, 1); WAIT_V(0); BAR; WAIT_L(0); MMA(0, 1, At, B1); BAR;
      LDA(At, 1, 1); BAR; WAIT_L(0); MMA(1, 0, At, B0); MMA(1, 1, At, B1); BAR; }
    if (wr == 0) BAR;
#undef SA
#undef SB
#undef STAGE
#undef LDA
#undef LDB
#undef MMA
#undef WAIT_V
#undef WAIT_L
#undef BAR
#undef SCHED
}

template <bool PERMF = false, class F>
__device__ __forceinline__ void epi_store_rows(LAS unsigned char* lds, int wid, int lane2, int fr, int fq, int wc, int mt, bf16_t* dbase, size_t dld, F getpk) {
    LAS unsigned char* reg = lds + wid * 9216;
#pragma unroll
    for (int bj = 0; bj < 2; bj++)
#pragma unroll
        for (int n = 0; n < 2; n++)
#pragma unroll
            for (int m = 0; m < 4; m++) *(LAS u32x2*)(reg + ((bj * 2 + n) * 16 + fr) * LROW + (PERMF ? fq * 32 + m * 8 : fq * 8 + m * 32)) = getpk(bj, n, m);
#pragma unroll
    for (int i = 0; i < 8; i++) {
        const int c = lane2 + 64 * i, row = c >> 3, ch = c & 7;
        const u32x4 w = *(const LAS u32x4*)(reg + row * LROW + ch * 16);
        const int tk2 = mt * 256 + (row >> 5) * 128 + wc * 32 + (row & 31);
        *(u32x4*)(dbase + (size_t)tk2 * dld + ch * 8) = w;
    }
}

__device__ __forceinline__ void phase_gemm1(const Params& p, int layer, LAS unsigned char* lds) {
    const int tid = opaque_tid(), wid = __builtin_amdgcn_readfirstlane(tid >> 6), wr = wid >> 2, wc = wid & 3;
    const bf16_t* Wt = p.W1t() + (size_t)layer * N1 * DM;
    const bool lastl = (layer == NLAY - 1);
    const int nslots = lastl ? (1920 + 48) : 6 * 48 * 8;
    for (int L = blockIdx.x; L < nslots; L += gridDim.x) {
        int mt, nt;
        if (lastl && L >= 1920) {
            const int c = L - 1920, cp = c / 6, k = c - cp * 6;
            mt = cp * 9; nt = (k < 2) ? 2 + k : 6 + k;
        } else {
            const int xc = L & 7, q = L >> 3, pidx = q / 48, w = q - pidx * 48, gp = pidx * 8 + xc;
            if (gp >= 45) continue;
            const int pmp = gp / 5, pnp = gp - pmp * 5;
            const int pr = pmp * 8 + (w & 7);
            mt = lastl ? (pr >> 3) * 9 + 1 + (pr & 7) : pr;
            nt = pnp * 6 + (w >> 3);
        }
        const bool isV = (nt == 3) || (nt == 10) || (nt == 11);
        f32x4 acc[2][2][4][2];
        if (isV) {
            gemm256<DM, DM>(p.H(), Wt, DM, mt * 256, nt * 256, acc, lds);
            const int tid2 = opaque_tid(), lane2 = tid2 & 63, fr = lane2 & 15, fq = lane2 >> 4;
            const int tok0 = mt * 256; const int bl = tok0 / TT, t0 = tok0 - bl * TT;
            const int ppos = 8 * (fq & 1) + 4 * (fq >> 1);
            LAS unsigned char* vreg = lds + wid * 2304;
#pragma unroll
            for (int bj = 0; bj < 2; bj++)
#pragma unroll
                for (int n = 0; n < 2; n++)
#pragma unroll
                    for (int ai = 0; ai < 2; ai++) {
#pragma unroll
                        for (int m = 0; m < 4; m++) {
                            const f32x4 v = acc[ai][bj][m][n];
                            *(LAS u32x2*)(vreg + fr * LROW + m * 32 + ppos * 2) = (u32x2){pk2(v[0], v[1]), pk2(v[2], v[3])};
                        }
#pragma unroll
                        for (int i = 0; i < 2; i++) {
                            const int c = lane2 + 64 * i, r = c >> 3, ch = c & 7;
                            const int vcr = wc * 32 + n * 16 + r;
                            bf16_t* dr;
                            if (nt == 3) dr = (bj == 0 ? p.VtA() : p.VtC()) + ((size_t)(bl * 2 + (vcr >> 6)) * 64 + (vcr & 63)) * TT;
                            else { const int vc = (nt - 10) * 256 + bj * 128 + vcr; dr = p.VtB() + ((size_t)(bl * 4 + (vc >> 7)) * 128 + (vc & 127)) * TT; }
                            *(u32x4*)(dr + t0 + ai * 128 + wr * 64 + ch * 8) = *(const LAS u32x4*)(vreg + r * LROW + ch * 16);
                        }
                    }
        } else {
            gemm256<DM, DM>(Wt, p.H(), DM, nt * 256, mt * 256, acc, lds);
            const int tid2 = opaque_tid(), lane2 = tid2 & 63, fr = lane2 & 15, fq = lane2 >> 4;
#pragma unroll
            for (int ai = 0; ai < 2; ai++) {
                const int col0 = nb2ob(nt * 2 + ai) * 128 + wr * 64;
                int type;
                if (col0 < 512) type = 0; else if (col0 < 640) type = 1; else if (col0 < 1280) type = 3; else if (col0 < 2304) type = 2;
                else if (col0 < 3328) type = 3; else if (col0 < 3968) type = 2; else if (col0 < 4608) type = 3; else type = 4;
#pragma unroll
                for (int bj = 0; bj < 2; bj++)
#pragma unroll
                    for (int n = 0; n < 2; n++) {
                        const int tk = mt * 256 + bj * 128 + wc * 32 + n * 16 + fr;
                        const int bl = tk / TT, t = tk - bl * TT;
                        float v[4][4];
#pragma unroll
                        for (int m = 0; m < 4; m++)
#pragma unroll
                            for (int j = 0; j < 4; j++) v[m][j] = acc[ai][bj][m][n][j];
                        if (type <= 1) {
                            float ss = 0.f;
#pragma unroll
                            for (int m = 0; m < 4; m++)
#pragma unroll
                                for (int j = 0; j < 4; j++) ss += v[m][j] * v[m][j];
                            ss += __shfl_xor(ss, 16); ss += __shfl_xor(ss, 32);
                            const float rstd = rsqrtf(ss * (1.f / 64.f) + 1e-6f);
                            const float* gn = (type == 0 ? p.q_norm : p.k_norm) + layer * 64;
#pragma unroll
                            for (int m = 0; m < 4; m++) {
                                const float4 g4 = *(const float4*)(gn + m * 16 + fq * 4);
                                v[m][0] *= rstd * g4.x; v[m][1] *= rstd * g4.y; v[m][2] *= rstd * g4.z; v[m][3] *= rstd * g4.w;
                            }
                        }
                        if (type <= 2 && t >= CTXL) {
                            const int pos = t - CTXL;
#pragma unroll
                            for (int ax = 0; ax < 2; ax++) {
                                const int pp = (ax == 0) ? (pos >> 6) : (pos & 63);
                                const float4* rp = (const float4*)(p.ROPE() + (size_t)(pp * 16 + fq * 4) * 2);
                                const float4 c01 = rp[0], c23 = rp[1];
                                const float cs[4] = {c01.x, c01.z, c23.x, c23.z}, sn[4] = {c01.y, c01.w, c23.y, c23.w};
#pragma unroll
                                for (int j = 0; j < 4; j++) {
                                    const float x1 = v[2 * ax][j], x2 = v[2 * ax + 1][j];
                                    v[2 * ax][j] = x1 * cs[j] - x2 * sn[j];
                                    v[2 * ax + 1][j] = x2 * cs[j] + x1 * sn[j];
                                }
                            }
                        }
                        if (col0 < 512 || (col0 >= 3328 && col0 < 3840)) {
#pragma unroll
                            for (int m = 0; m < 4; m++)
#pragma unroll
                                for (int j = 0; j < 4; j++) v[m][j] *= 0.125f * LOG2E;
                        }
                        if (type == 3) {
#pragma unroll
                            for (int m = 0; m < 4; m++)
#pragma unroll
                                for (int j = 0; j < 4; j++) v[m][j] = silu_f(v[m][j]);
                        }
                        if (type == 4) {
                            const float* bm = p.b_mg + layer * 3072 + (col0 - INW);
#pragma unroll
                            for (int m = 0; m < 4; m++) {
                                const float4 b4 = *(const float4*)(bm + m * 16 + fq * 4);
                                v[m][0] = fmaxf(sigmoid_f(v[m][0] + b4.x), 5.96e-8f); v[m][1] = fmaxf(sigmoid_f(v[m][1] + b4.y), 5.96e-8f);
                                v[m][2] = fmaxf(sigmoid_f(v[m][2] + b4.z), 5.96e-8f); v[m][3] = fmaxf(sigmoid_f(v[m][3] + b4.w), 5.96e-8f);
                            }
                        }
                        if (type == 4) {
                            LAS unsigned char* srow = lds + wid * 9216 + ((bj * 2 + n) * 16 + fr) * 80 + fq * 4;
#pragma unroll
                            for (int m = 0; m < 4; m++) {
                                const unsigned q0 = (unsigned)fmaxf(__builtin_rintf(v[m][0] * 255.f), 1.f), q1 = (unsigned)fmaxf(__builtin_rintf(v[m][1] * 255.f), 1.f);
                                const unsigned q2 = (unsigned)fmaxf(__builtin_rintf(v[m][2] * 255.f), 1.f), q3 = (unsigned)fmaxf(__builtin_rintf(v[m][3] * 255.f), 1.f);
                                *(LAS unsigned*)(srow + m * 16) = q0 | (q1 << 8) | (q2 << 16) | (q3 << 24);
                            }
                        } else {
                        LAS unsigned char* srow = lds + wid * 9216 + ((bj * 2 + n) * 16 + fr) * LROW + fq * 8;
#pragma unroll
                        for (int m = 0; m < 4; m++)
                            *(LAS u32x2*)(srow + m * 32) = (u32x2){pk2(v[m][0], v[m][1]), pk2(v[m][2], v[m][3])};
                        }
                    }
                if (type == 4) {
                    unsigned char* dbase = (unsigned char*)p.G() + (col0 - INW);
#pragma unroll
                    for (int i = 0; i < 4; i++) {
                        const int c = lane2 + 64 * i, row = c >> 2, ch = c & 3;
                        const u32x4 w = *(const LAS u32x4*)(lds + wid * 9216 + row * 80 + ch * 16);
                        const int tk2 = mt * 256 + (row >> 5) * 128 + wc * 32 + (row & 31);
                        *(u32x4*)(dbase + (size_t)tk2 * 3072 + ch * 16) = w;
                    }
                } else {
                    bf16_t* dbase = p.PROJ() + col0;
                    const size_t dld = INW;
#pragma unroll
                    for (int i = 0; i < 8; i++) {
                        const int c = lane2 + 64 * i, row = c >> 3, ch = c & 7;
                        const u32x4 w = *(const LAS u32x4*)(lds + wid * 9216 + row * LROW + ch * 16);
                        const int tk2 = mt * 256 + (row >> 5) * 128 + wc * 32 + (row & 31);
                        *(u32x4*)(dbase + (size_t)tk2 * dld + ch * 8) = w;
                    }
                }
            }
        }
    }
}

template <int DV>
__device__ __forceinline__ void attn_tile(const unsigned char* Kl, const unsigned char* Vl, const bf16x8 (&qf)[4], f32x16 (&O)[DV / 32], float& m, float& l,
                                          int l31, int hh, bool domask, int qpos, int kpos0) {
    const float SL2 = 0.125f * LOG2E;
    const float THR = 8.f;
    f32x16 S[2];
#pragma unroll
    for (int sub = 0; sub < 2; sub++)
#pragma unroll
        for (int r = 0; r < 16; r++) S[sub][r] = 0.f;
#pragma unroll
    for (int kk = 0; kk < 4; kk++)
#pragma unroll
        for (int sub = 0; sub < 2; sub++) {
            const bf16x8 kf = *(const bf16x8*)(Kl + (sub * 32 + l31) * LROW + kk * 32 + hh * 16);
            S[sub] = MFMA(kf, qf[kk], S[sub]);
        }
    if (domask) {
#pragma unroll
        for (int sub = 0; sub < 2; sub++)
#pragma unroll
            for (int r = 0; r < 16; r++) {
                const int d = qpos - (kpos0 + sub * 32 + (r & 3) + 8 * (r >> 2) + 4 * hh);
                S[sub][r] = (d <= 128 && d >= -128) ? S[sub][r] : -1e30f;
            }
    }
    float mx = S[0][0];
#pragma unroll
    for (int sub = 0; sub < 2; sub++)
#pragma unroll
        for (int r = 0; r < 16; r++) mx = fmaxf(mx, S[sub][r]);
    mx = fmaxf(mx, __shfl_xor(mx, 32));
    const float mxs = mx * SL2;
    if (__any(mxs > m + THR)) {
        const float mnew = fmaxf(m, mxs);
        const float alpha = __builtin_amdgcn_exp2f(m - mnew);
        m = mnew; l *= alpha;
#pragma unroll
        for (int dt = 0; dt < DV / 32; dt++)
#pragma unroll
            for (int r = 0; r < 16; r++) O[dt][r] *= alpha;
    }
    float ps = 0.f;
#pragma unroll
    for (int sub = 0; sub < 2; sub++)
#pragma unroll
        for (int r = 0; r < 16; r++) { S[sub][r] = __builtin_amdgcn_exp2f(__builtin_fmaf(S[sub][r], SL2, -m)); ps += S[sub][r]; }
    l += ps;
    bf16x8 pb[2][2];
#pragma unroll
    for (int sub = 0; sub < 2; sub++)
#pragma unroll
        for (int s = 0; s < 2; s++) {
            u32x4 cv;
            cv[0] = pk2(S[sub][8 * s + 0], S[sub][8 * s + 1]); cv[1] = pk2(S[sub][8 * s + 2], S[sub][8 * s + 3]);
            cv[2] = pk2(S[sub][8 * s + 4], S[sub][8 * s + 5]); cv[3] = pk2(S[sub][8 * s + 6], S[sub][8 * s + 7]);
            pb[sub][s] = __builtin_bit_cast(bf16x8, cv);
        }
#pragma unroll
    for (int sub = 0; sub < 2; sub++)
#pragma unroll
        for (int s = 0; s < 2; s++)
#pragma unroll
            for (int dt = 0; dt < DV / 32; dt++) {
                const bf16x8 vf = *(const bf16x8*)(Vl + (dt * 32 + l31) * LROW + (sub * 4 + s * 2 + hh) * 16);
                O[dt] = MFMA(vf, pb[sub][s], O[dt]);
            }
}

template <int DV>
__device__ __forceinline__ void attn_tile_rel(const unsigned char* Kl, const unsigned char* Vl, const bf16x8 (&qf)[4], f32x16 (&O)[DV / 32], float& m, float& l, f32x16& NEGM,
                                              bool first, int l31, int hh, bool domask, int qpos, int kpos0) {
    const float THR = 8.f;
    f32x16 S[2];
#pragma unroll
    for (int sub = 0; sub < 2; sub++) {
        const bf16x8 kf = *(const bf16x8*)(Kl + (sub * 32 + l31) * LROW + hh * 16);
        S[sub] = MFMA(kf, qf[0], NEGM);
    }
#pragma unroll
    for (int kk = 1; kk < 4; kk++)
#pragma unroll
        for (int sub = 0; sub < 2; sub++) {
            const bf16x8 kf = *(const bf16x8*)(Kl + (sub * 32 + l31) * LROW + kk * 32 + hh * 16);
            S[sub] = MFMA(kf, qf[kk], S[sub]);
        }
    if (domask) {
#pragma unroll
        for (int sub = 0; sub < 2; sub++)
#pragma unroll
            for (int r = 0; r < 16; r++) {
                const int d = qpos - (kpos0 + sub * 32 + (r & 3) + 8 * (r >> 2) + 4 * hh);
                S[sub][r] = (d <= 128 && d >= -128) ? S[sub][r] : -1e30f;
            }
    }
    float mx = S[0][0];
#pragma unroll
    for (int sub = 0; sub < 2; sub++)
#pragma unroll
        for (int r = 0; r < 16; r++) mx = fmaxf(mx, S[sub][r]);
    mx = fmaxf(mx, __shfl_xor(mx, 32));
    if (first || __any(mx > THR)) {
        const float d = first ? mx : fmaxf(mx, 0.f);
        const float alpha = __builtin_amdgcn_exp2f(-d);
        m += d; l *= alpha;
#pragma unroll
        for (int dt = 0; dt < DV / 32; dt++)
#pragma unroll
            for (int r = 0; r < 16; r++) O[dt][r] *= alpha;
#pragma unroll
        for (int r = 0; r < 16; r++) NEGM[r] -= d;
#pragma unroll
        for (int sub = 0; sub < 2; sub++)
#pragma unroll
            for (int r = 0; r < 16; r++) S[sub][r] -= d;
    }
    float ps = 0.f;
#pragma unroll
    for (int sub = 0; sub < 2; sub++)
#pragma unroll
        for (int r = 0; r < 16; r++) { S[sub][r] = __builtin_amdgcn_exp2f(S[sub][r]); ps += S[sub][r]; }
    l += ps;
#pragma unroll
    for (int sub = 0; sub < 2; sub++)
#pragma unroll
        for (int s = 0; s < 2; s++) {
            u32x4 cv;
            cv[0] = pk2(S[sub][8 * s + 0], S[sub][8 * s + 1]); cv[1] = pk2(S[sub][8 * s + 2], S[sub][8 * s + 3]);
            cv[2] = pk2(S[sub][8 * s + 4], S[sub][8 * s + 5]); cv[3] = pk2(S[sub][8 * s + 6], S[sub][8 * s + 7]);
            const bf16x8 pb = __builtin_bit_cast(bf16x8, cv);
#pragma unroll
            for (int dt = 0; dt < DV / 32; dt++) {
                const bf16x8 vf = *(const bf16x8*)(Vl + (dt * 32 + l31) * LROW + (sub * 4 + s * 2 + hh) * 16);
                O[dt] = MFMA(vf, pb, O[dt]);
            }
        }
}

template <bool DIFF>
__device__ __forceinline__ void attn_unit(const Params& p, int layer, int mode, int bl, int hidx, int qblk, bool isctx, unsigned char* lds) {
    constexpr int DV = DIFF ? 128 : 64;
    constexpr int NKM = DIFF ? 2 : 1;
    constexpr int KBYTES = NKM * 9216, VBYTES = DV * LROW, BUFB = KBYTES + VBYTES;
    const int tid = opaque_tid(), lane = tid & 63, wave = __builtin_amdgcn_readfirstlane(tid >> 6), l31 = lane & 31, hh = lane >> 5;
    int qcol, kcol, gcol, ucol, tq, head = 0, cm = 0, qs = 0;
    const bf16_t* vt;
    int qpos;
    if (DIFF) {
        cm = wave & 1; qs = wave >> 1;
        qcol = 1280 + hidx * 128 + cm * 64; kcol = 1792 + hidx * 128; gcol = 2816 + hidx * 128; ucol = NTC * 512 + hidx * 128;
        vt = p.VtB() + (size_t)(bl * 4 + hidx) * 128 * TT;
        qpos = qblk * 128 + qs * 32 + l31;
        tq = bl * TT + (isctx ? 0 : CTXL) + qpos;
    } else {
        head = hidx * 4 + (wave & 3);
        qpos = qblk * 64 + (wave >> 2) * 32 + l31;
        if (mode == 0) { qcol = head * 64; kcol = 512 + hidx * 64; gcol = 768 + head * 64; ucol = head * 64; vt = p.VtA() + (size_t)(bl * 2 + hidx) * 64 * TT; }
        else { qcol = 3328 + head * 64; kcol = 3840 + hidx * 64; gcol = 4096 + head * 64; ucol = 2 * NTC * 512 + head * 64; vt = p.VtC() + (size_t)(bl * 2 + hidx) * 64 * TT; }
        tq = bl * TT + (isctx ? 0 : CTXL) + qpos;
    }
    const bool win = (!DIFF) && (mode == 2) && !isctx;
    int n2, start2;
    if (isctx) { n2 = 0; start2 = 0; }
    else if (win) { const int q0 = qblk * 64; int lo = q0 - 128; if (lo < 0) lo = 0; int hi = q0 + 192; if (hi > SEQ) hi = SEQ; n2 = (hi - lo) >> 6; start2 = CTXL + lo; }
    else { n2 = 32; start2 = CTXL; }
    const int ntile = 4 + n2;

    const bf16_t* kp = p.PROJ() + (size_t)(bl * TT) * INW + kcol;
    const int lr = tid >> 3, lc = tid & 7;
    u32x4 kr[NKM], vr[DV / 64];
    bf16x8 qf[4];
    {
        unsigned char* qreg = lds + 73728 + wave * 4608;
        const int tqb = tq - l31;
#pragma unroll
        for (int i = 0; i < 4; i++) {
            const int c = lane + 64 * i, row = c >> 3, ch = c & 7;
            *(u32x4*)(qreg + row * LROW + ch * 16) = *(const u32x4*)(p.PROJ() + (size_t)(tqb + row) * INW + qcol + ch * 8);
        }
#pragma unroll
        for (int kk = 0; kk < 4; kk++) qf[kk] = *(const bf16x8*)(qreg + l31 * LROW + kk * 32 + hh * 16);
    }
    f32x16 O[DV / 32];
#pragma unroll
    for (int dt = 0; dt < DV / 32; dt++)
#pragma unroll
        for (int r = 0; r < 16; r++) O[dt][r] = 0.f;
    float m = DIFF ? -1e30f : 0.f, l = 0.f;
    f32x16 NEGM;
#pragma unroll
    for (int r = 0; r < 16; r++) NEGM[r] = 0.f;

    {
        const int t0 = 0;
#pragma unroll
        for (int i = 0; i < NKM; i++) kr[i] = *(const u32x4*)(kp + (size_t)(t0 + lr) * INW + i * 64 + lc * 8);
#pragma unroll
        for (int i = 0; i < DV / 64; i++) vr[i] = *(const u32x4*)(vt + (size_t)(lr + i * 64) * TT + t0 + lc * 8);
    }
    __syncthreads();
    {
        unsigned char* wb = lds + lr * LROW + lc * 16;
#pragma unroll
        for (int i = 0; i < NKM; i++) *(u32x4*)(wb + i * 9216) = kr[i];
#pragma unroll
        for (int i = 0; i < DV / 64; i++) *(u32x4*)(wb + KBYTES + i * 64 * LROW) = vr[i];
    }
    __syncthreads();
    for (int it = 0; it < ntile; it++) {
        const unsigned char* cur = lds + (it & 1) * BUFB;
        const bool more = (it + 1 < ntile);
        if (more) {
            const int t0 = (it + 1 < 4) ? (it + 1) * 64 : start2 + (it + 1 - 4) * 64;
#pragma unroll
            for (int i = 0; i < NKM; i++) kr[i] = *(const u32x4*)(kp + (size_t)(t0 + lr) * INW + i * 64 + lc * 8);
#pragma unroll
            for (int i = 0; i < DV / 64; i++) vr[i] = *(const u32x4*)(vt + (size_t)(lr + i * 64) * TT + t0 + lc * 8);
        }
        const int tcur = (it < 4) ? it * 64 : start2 + (it - 4) * 64;
        const int rel = (tcur - CTXL) - (DIFF ? 0 : (qblk * 64 + (wave >> 2) * 32));
        if (DIFF) attn_tile<DV>(cur + cm * 9216, cur + KBYTES, qf, O, m, l, l31, hh, false, qpos, tcur - CTXL);
        else attn_tile_rel<DV>(cur, cur + KBYTES, qf, O, m, l, NEGM, it == 0, l31, hh, win && (it >= 4) && (rel < -97 || rel > 65), qpos, tcur - CTXL);
        if (more) {
            unsigned char* wb = lds + ((it + 1) & 1) * BUFB + lr * LROW + lc * 16;
#pragma unroll
            for (int i = 0; i < NKM; i++) *(u32x4*)(wb + i * 9216) = kr[i];
#pragma unroll
            for (int i = 0; i < DV / 64; i++) *(u32x4*)(wb + KBYTES + i * 64 * LROW) = vr[i];
        }
        __syncthreads();
    }
    float lt = l + __shfl_xor(l, 32);
    if (DIFF) {
        const float inv = 1.f / lt;
        float* xb = (float*)lds + qs * 128 * 32;
        if (cm == 1) {
#pragma unroll
            for (int dt = 0; dt < DV / 32; dt++)
#pragma unroll
                for (int r = 0; r < 16; r++) xb[(dt * 32 + (r & 3) + 8 * (r >> 2) + 4 * hh) * 32 + l31] = O[dt][r] * inv;
        }
        __syncthreads();
        if (cm == 0) {
            const float lam = p.LAM()[layer];
            const float om = 1.f - lam_init_of(layer);
            float ss = 0.f;
#pragma unroll
            for (int dt = 0; dt < DV / 32; dt++)
#pragma unroll
                for (int r = 0; r < 16; r++) {
                    const float o = O[dt][r] * inv - lam * xb[(dt * 32 + (r & 3) + 8 * (r >> 2) + 4 * hh) * 32 + l31];
                    O[dt][r] = o; ss += o * o;
                }
            ss += __shfl_xor(ss, 32);
            const float rstd = rsqrtf(ss * (1.f / 128.f) + 1e-5f) * om;
            unsigned char* sreg = lds + 65536 + wave * 9216;
            constexpr int RS = DV * 2 + 16, CPR = DV / 8;
            const int lane_e = opaque_tid() & 63;
            const int tqb = tq - l31;
#pragma unroll
            for (int i = 0; i < DV / 16; i++) {
                const int c = lane_e + 64 * i, row = c / CPR, ch = c % CPR;
                *(u32x4*)(sreg + row * RS + ch * 16) = __builtin_nontemporal_load((const u32x4*)(p.PROJ() + (size_t)(tqb + row) * INW + gcol + ch * 8));
                if ((i & 1) == 1) asm volatile("" ::: "memory");
            }
#pragma unroll
            for (int dt = 0; dt < DV / 32; dt++)
#pragma unroll
                for (int rg = 0; rg < 4; rg++) {
                    const int d0 = dt * 32 + rg * 8 + hh * 4;
                    const float4 sg = *(const float4*)(p.subln + layer * 128 + d0);
                    u32x2* sp = (u32x2*)(sreg + l31 * RS + d0 * 2);
                    const u32x2 gw = *sp;
                    const float o0 = O[dt][rg * 4 + 0] * rstd * sg.x * bflo(gw[0]), o1 = O[dt][rg * 4 + 1] * rstd * sg.y * bfhi(gw[0]);
                    const float o2 = O[dt][rg * 4 + 2] * rstd * sg.z * bflo(gw[1]), o3 = O[dt][rg * 4 + 3] * rstd * sg.w * bfhi(gw[1]);
                    *sp = (u32x2){pk2(o0, o1), pk2(o2, o3)};
                }
#pragma unroll
            for (int i = 0; i < DV / 16; i++) {
                const int c = lane_e + 64 * i, row = c / CPR, ch = c % CPR;
                *(u32x4*)(p.U() + (size_t)(tqb + row) * 512 + ucol + ch * 8) = *(const u32x4*)(sreg + row * RS + ch * 16);
                if ((i & 1) == 1) asm volatile("" ::: "memory");
            }
        }
    } else {
        float a = 1.f;
        if (mode == 2) {
            const float s2 = p.sink[layer * 8 + head] * LOG2E;
            const float mf = fmaxf(m, s2);
            a = __builtin_amdgcn_exp2f(m - mf);
            lt = lt * a + __builtin_amdgcn_exp2f(s2 - mf);
        }
        const float inv = a / lt;
        unsigned char* sreg = lds + 65536 + wave * 9216;
        constexpr int RS = DV * 2 + 16, CPR = DV / 8;
        const int lane_e = opaque_tid() & 63;
        const int tqb = tq - l31;
#pragma unroll
        for (int i = 0; i < DV / 16; i++) {
            const int c = lane_e + 64 * i, row = c / CPR, ch = c % CPR;
            *(u32x4*)(sreg + row * RS + ch * 16) = __builtin_nontemporal_load((const u32x4*)(p.PROJ() + (size_t)(tqb + row) * INW + gcol + ch * 8));
        }
#pragma unroll
        for (int dt = 0; dt < DV / 32; dt++)
#pragma unroll
            for (int rg = 0; rg < 4; rg++) {
                const int d0 = dt * 32 + rg * 8 + hh * 4;
                u32x2* sp = (u32x2*)(sreg + l31 * RS + d0 * 2);
                const u32x2 gw = *sp;
                const float o0 = O[dt][rg * 4 + 0] * inv * bflo(gw[0]), o1 = O[dt][rg * 4 + 1] * inv * bfhi(gw[0]);
                const float o2 = O[dt][rg * 4 + 2] * inv * bflo(gw[1]), o3 = O[dt][rg * 4 + 3] * inv * bfhi(gw[1]);
                *sp = (u32x2){pk2(o0, o1), pk2(o2, o3)};
            }
#pragma unroll
        for (int i = 0; i < DV / 16; i++) {
            const int c = lane_e + 64 * i, row = c / CPR, ch = c % CPR;
            *(u32x4*)(p.U() + (size_t)(tqb + row) * 512 + ucol + ch * 8) = *(const u32x4*)(sreg + row * RS + ch * 16);
        }
    }
}

__device__ __forceinline__ void phase_attn(const Params& p, int layer, unsigned char* lds) {
    const int nunits = 1536 + ((layer < NLAY - 1) ? 192 : 0);
    for (int u = blockIdx.x; u < nunits; u += gridDim.x) {
        int mode, bl, hidx, qb; bool isctx;
        if (u < 512) { const int x = u & 7, rest = u >> 3; qb = rest & 15; const int combo = (rest >> 4) * 8 + x; mode = 1; bl = combo >> 2; hidx = combo & 3; isctx = false; }
        else if (u < 1536) { const int u2 = (u - 512) & 511; const int x = u2 & 7, rest = u2 >> 3; qb = rest & 31; const int combo = (rest >> 5) * 8 + x;
            mode = (u < 1024) ? 0 : 2; bl = combo >> 1; hidx = combo & 1; isctx = false; }
        else if (u < 1600) { const int u2 = u - 1536; qb = u2 & 1; const int combo = u2 >> 1; mode = 1; bl = combo >> 2; hidx = combo & 3; isctx = true; }
        else { const int u2 = (u - 1600) & 63; qb = u2 & 3; const int combo = u2 >> 2; mode = (u < 1664) ? 0 : 2; bl = combo >> 1; hidx = combo & 1; isctx = true; }
        __syncthreads();
        if (mode == 1) attn_unit<true>(p, layer, mode, bl, hidx, qb, isctx, lds);
        else attn_unit<false>(p, layer, mode, bl, hidx, qb, isctx, lds);
    }
}

__device__ __forceinline__ float ub(unsigned w, int j) { return (float)((w >> (8 * j)) & 0xffu); }
struct GateHook {
    const unsigned char* G; int tok0, feat0;
    __device__ __forceinline__ void operator()(int seg, f32x4 (&acc)[2][2][4][2]) const {
        const int tid2 = opaque_tid(), lane2 = tid2 & 63, wid2 = __builtin_amdgcn_readfirstlane(tid2 >> 6), wr = wid2 >> 2, wc = wid2 & 3, fr = lane2 & 15, fq = lane2 >> 4;
#pragma unroll
        for (int bj = 0; bj < 2; bj++)
#pragma unroll
            for (int n = 0; n < 2; n++) {
                const int tk = tok0 + bj * 128 + wc * 32 + n * 16 + fr;
                const unsigned char* gprev = G + (size_t)tk * 3072 + (seg - 1) * 1024 + feat0 + wr * 64 + fq * 16;
#pragma unroll
                for (int ai = 0; ai < 2; ai++) {
                    const u32x4 gp = *(const u32x4*)(gprev + ai * 128), gn = *(const u32x4*)(gprev + 1024 + ai * 128);
#pragma unroll
                    for (int m = 0; m < 4; m++) {
                        f32x4& v = acc[ai][bj][m][n];
                        v[0] *= ub(gp[m], 0) * __builtin_amdgcn_rcpf(ub(gn[m], 0)); v[1] *= ub(gp[m], 1) * __builtin_amdgcn_rcpf(ub(gn[m], 1));
                        v[2] *= ub(gp[m], 2) * __builtin_amdgcn_rcpf(ub(gn[m], 2)); v[3] *= ub(gp[m], 3) * __builtin_amdgcn_rcpf(ub(gn[m], 3));
                    }
                }
            }
    }
};

__device__ __forceinline__ void phase_gemm2(const Params& p, int layer, LAS unsigned char* lds) {
    const int tid = opaque_tid(), wid = __builtin_amdgcn_readfirstlane(tid >> 6), wr = wid >> 2, wc = wid & 3;
    const int ntiles = (layer == NLAY - 1) ? 256 : 288;
    for (int L = blockIdx.x; L < ntiles; L += gridDim.x) {
        const int mt = panel_of(L >> 2), nt = L & 3;
        f32x4 acc[2][2][4][2];
        GateHook hk; hk.G = (const unsigned char*)p.G(); hk.tok0 = mt * 256; hk.feat0 = nt * 256;
        gemm256<512, 512, 8, GateHook>(p.Wbrt() + (size_t)(layer * 3) * DM * 512, p.U(), 1536, nt * 256, mt * 256, acc, lds,
                                       (size_t)DM * 512 * 2, (size_t)NTC * 512 * 2, hk);
        const int tid2 = opaque_tid(), lane2 = tid2 & 63, fr = lane2 & 15, fq = lane2 >> 4;
#pragma unroll
        for (int ai = 0; ai < 2; ai++) {
            const int f0 = nt * 256 + ai * 128 + wr * 64;
            epi_store_rows<true>(lds, wid, lane2, fr, fq, wc, mt, p.Mb() + f0, DM, [&](int bj, int n, int m) -> u32x2 {
                const int tk = mt * 256 + bj * 128 + wc * 32 + n * 16 + fr;
                const unsigned gw = *(const unsigned*)((const unsigned char*)p.G() + (size_t)tk * 3072 + 2048 + f0 + fq * 16 + m * 4);
                const f32x4 v = acc[ai][bj][m][n] * (1.f / 255.f);
                return (u32x2){pk2(v[0] * ub(gw, 0), v[1] * ub(gw, 1)), pk2(v[2] * ub(gw, 2), v[3] * ub(gw, 3))};
            });
        }
        asm volatile("s_waitcnt vmcnt(0)" ::: "memory");
        __syncthreads();
        if (threadIdx.x == 0) {
            __builtin_amdgcn_fence(__ATOMIC_RELEASE, "agent");
            asm volatile("s_waitcnt vmcnt(0)" ::: "memory");
            xb_add(&p.BAR()[G23_PC(mt)], 1u);
        }
    }
}

__device__ __forceinline__ void phase_gemm3(const Params& p, int layer, int inst, LAS unsigned char* lds, volatile LAS unsigned* bst) {
    const int tid = opaque_tid(), wid = __builtin_amdgcn_readfirstlane(tid >> 6), wr = wid >> 2, wc = wid & 3;
    const unsigned nvalid = (layer == NLAY - 1) ? 256u : 288u;
    for (;;) {
        __syncthreads();
        if (threadIdx.x == 0) {
            const unsigned tk = xb_add(&p.BAR()[G23_TK], 1u) - (544u * (unsigned)inst - (inst > 3 ? 32u : 0u));
            if (tk < nvalid) {
                const int pmt = panel_of((int)(tk >> 2));
                unsigned* pc = &p.BAR()[G23_PC(pmt)];
                const unsigned want = panel_want(pmt, inst);
                XB_SPIN_SLOW(xb_ld(pc) < want, p.BAR());
                __builtin_amdgcn_fence(__ATOMIC_ACQUIRE, "agent");
                asm volatile("s_waitcnt vmcnt(0)" ::: "memory");
            }
            bst[2] = tk;
        }
        __syncthreads();
        const unsigned L = (unsigned)__builtin_amdgcn_readfirstlane((int)bst[2]);
        if (L >= nvalid) break;
        const int mt = panel_of((int)(L >> 2)), nt = (int)(L & 3u);
        f32x4 acc[2][2][4][2];
        gemm256<DM, DM>(p.Woutt() + (size_t)layer * DM * DM, p.Mb(), DM, nt * 256, mt * 256, acc, lds);
        const int tid2 = opaque_tid(), lane2 = tid2 & 63, fr = lane2 & 15, fq = lane2 >> 4;
#pragma unroll
        for (int ai = 0; ai < 2; ai++)
            epi_store_rows(lds, wid, lane2, fr, fq, wc, mt, (bf16_t*)p.Y() + nt * 256 + ai * 128 + wr * 64, DM, [&](int bj, int n, int m) -> u32x2 {
                const f32x4 v = acc[ai][bj][m][n];
                return (u32x2){pk2(v[0], v[1]), pk2(v[2], v[3])};
            });
        asm volatile("s_waitcnt vmcnt(0)" ::: "memory");
        __syncthreads();
        if (threadIdx.x == 0) {
            __builtin_amdgcn_fence(__ATOMIC_RELEASE, "agent");
            asm volatile("s_waitcnt vmcnt(0)" ::: "memory");
            xb_add(&p.BAR()[G23_PC2(mt)], 1u);
        }
    }
}

__global__ void __launch_bounds__(512, 2) fwd_kernel(Params p) {
    extern __shared__ __attribute__((aligned(16))) unsigned char lds[];
    cg::grid_group grid = cg::this_grid();
    volatile LAS unsigned* bst = (volatile LAS unsigned*)((LAS unsigned char*)lds + LDS_BYTES);
    if (threadIdx.x == 0) { bst[0] = 0u; bst[1] = 0u; }
    __syncthreads();
    (void)xcd_barrier_post(p.BAR(), bst);
    phase_pro_a(p, lds);
    grid.sync();
    phase_pro_b(p);
    xcd_barrier(p.BAR(), bst);
    for (int chunk = 0; chunk < NB / CB; chunk++) {
        phase_norm(p, chunk, -1);
        xcd_barrier(p.BAR(), bst);
        for (int layer = 0; layer < NLAY; layer++) {
            phase_gemm1(p, layer, (LAS unsigned char*)lds);
            xcd_barrier(p.BAR(), bst);
            phase_attn(p, layer, lds);
            xcd_barrier(p.BAR(), bst);
            phase_gemm2(p, layer, (LAS unsigned char*)lds);
            phase_gemm3(p, layer, chunk * NLAY + layer, (LAS unsigned char*)lds, bst);
            phase_norm_ticketed(p, chunk, layer, chunk * NLAY + layer, bst);
            xcd_barrier(p.BAR(), bst);
        }
    }
}

extern "C" void kernel_launch(void* const* d_in, const int* in_sizes, int n_in, void* d_out, int out_size, void* d_ws, size_t ws_size, hipStream_t stream) {
    static int grid_blocks = 0;
    if (!grid_blocks) {
        int dev = 0, cus = 0, per_cu = 0;
        hipGetDevice(&dev);
        hipDeviceGetAttribute(&cus, hipDeviceAttributeMultiprocessorCount, dev);
        hipFuncSetAttribute((const void*)fwd_kernel, hipFuncAttributeMaxDynamicSharedMemorySize, LDS_BYTES + 16);
        hipOccupancyMaxActiveBlocksPerMultiprocessor(&per_cu, (const void*)fwd_kernel, NTHR, LDS_BYTES + 16);
        if (per_cu < 1) per_cu = 1;
        if (per_cu > 1) per_cu = 1;
        grid_blocks = cus * per_cu;
    }
    Params p{};
    const float* const* in = (const float* const*)d_in;
    p.x = in[0]; p.c = in[1]; p.ctx = in[2]; p.c_ctx = in[3]; p.w_ada = in[4]; p.b_ada = in[5]; p.g_pre = in[6]; p.g_post = in[7];
    p.w_in = in[8]; p.q_norm = in[9]; p.k_norm = in[10]; p.lam_q1 = in[11]; p.lam_k1 = in[12]; p.lam_q2 = in[13]; p.lam_k2 = in[14];
    p.subln = in[15]; p.sink = in[16]; p.w_br_a = in[17]; p.w_br_b = in[18]; p.w_br_c = in[19]; p.w_mg = in[20]; p.b_mg = in[21]; p.w_out = in[22];
    p.out = (float*)d_out;
    p.ws = (unsigned char*)d_ws;
    if (WS_END > ws_size) { fprintf(stderr, "kernel_launch: workspace too small: need %zu, have %zu\n", (size_t)WS_END, ws_size); return; }
    hipMemsetAsync((unsigned char*)d_ws + OFF_BAR, 0, ALL_BAR_WORDS * 4, stream);
    void* args[] = {&p};
    hipError_t e = hipLaunchCooperativeKernel((void*)fwd_kernel, dim3(grid_blocks), dim3(NTHR), args, LDS_BYTES + 16, stream);
    if (e != hipSuccess) fprintf(stderr, "cooperative launch failed: %s (grid %d)\n", hipGetErrorString(e), grid_blocks);
}
```

```cpp
#include <hip/hip_runtime.h>
#include <hip/hip_cooperative_groups.h>
#include <cstdio>
#include <cstdint>
namespace cg = cooperative_groups;

typedef unsigned short bf16_t;
typedef short bf16x8 __attribute__((ext_vector_type(8)));
typedef float f32x16 __attribute__((ext_vector_type(16)));
typedef unsigned u32x4 __attribute__((ext_vector_type(4)));
typedef float f32x4 __attribute__((ext_vector_type(4)));
typedef unsigned u32x2 __attribute__((ext_vector_type(2)));

constexpr int NB = 16, SEQ = 2048, CTXL = 256, TT = 2304, DM = 1024, NLAY = 4, INW = 4608, N1 = 7680;
constexpr int CB = 8, NTC = CB * TT;
constexpr int LDS_BYTES = 147456;
constexpr int NTHR = 512;
constexpr int LROW = 144;
constexpr float LOG2E = 1.4426950408889634f;

#define MFMA(a, b, c) __builtin_amdgcn_mfma_f32_32x32x16_bf16((a), (b), (c), 0, 0, 0)

constexpr size_t al256(size_t x) { return (x + 255) & ~(size_t)255; }
constexpr size_t OFF_W1T = 0;
constexpr size_t OFF_WBRT = OFF_W1T + al256((size_t)NLAY * N1 * DM * 2);
constexpr size_t OFF_WOUTT = OFF_WBRT + al256((size_t)NLAY * 3 * DM * 512 * 2);
constexpr size_t OFF_MODP = OFF_WOUTT + al256((size_t)NLAY * DM * DM * 2);
constexpr size_t OFF_MOD = OFF_MODP + al256((size_t)8 * NLAY * 17 * 3072 * 4);
constexpr size_t OFF_ROPE = OFF_MOD + al256((size_t)NLAY * 17 * 3072 * 4);
constexpr size_t OFF_LAM = OFF_ROPE + al256(64 * 16 * 2 * 4);
constexpr size_t OFF_BAR = OFF_LAM + 256;
constexpr size_t OFF_CX = OFF_BAR + al256((size_t)16384 * 4);
constexpr size_t OFF_H = OFF_CX + al256((size_t)NB * CTXL * DM * 4);
constexpr size_t OFF_U = OFF_H + al256((size_t)NTC * DM * 2);
constexpr size_t OFF_PROJ = OFF_U + al256((size_t)NTC * 1536 * 2);
constexpr size_t OFF_VTA = OFF_PROJ + al256((size_t)NTC * INW * 2);
constexpr size_t OFF_VTB = OFF_VTA + al256((size_t)CB * 2 * 64 * TT * 2);
constexpr size_t OFF_VTC = OFF_VTB + al256((size_t)CB * 4 * 128 * TT * 2);
constexpr size_t OFF_G = OFF_VTC + al256((size_t)CB * 2 * 64 * TT * 2);
constexpr size_t WS_END = OFF_G + al256((size_t)NTC * 3072 * 2);
constexpr size_t OFF_MB = OFF_PROJ;
constexpr size_t OFF_Y = OFF_PROJ + (size_t)NTC * DM * 2;

struct Params {
    const float *x, *c, *ctx, *c_ctx, *w_ada, *b_ada, *g_pre, *g_post, *w_in, *q_norm, *k_norm;
    const float *lam_q1, *lam_k1, *lam_q2, *lam_k2, *subln, *sink, *w_br_a, *w_br_b, *w_br_c, *w_mg, *b_mg, *w_out;
    float* out;
    unsigned char* ws;
    __device__ __forceinline__ bf16_t* W1t() const { return (bf16_t*)(ws + OFF_W1T); }
    __device__ __forceinline__ bf16_t* Wbrt() const { return (bf16_t*)(ws + OFF_WBRT); }
    __device__ __forceinline__ bf16_t* Woutt() const { return (bf16_t*)(ws + OFF_WOUTT); }
    __device__ __forceinline__ float* MODP() const { return (float*)(ws + OFF_MODP); }
    __device__ __forceinline__ float* MOD() const { return (float*)(ws + OFF_MOD); }
    __device__ __forceinline__ float* ROPE() const { return (float*)(ws + OFF_ROPE); }
    __device__ __forceinline__ float* LAM() const { return (float*)(ws + OFF_LAM); }
    __device__ __forceinline__ unsigned* BAR() const { return (unsigned*)(ws + OFF_BAR); }
    __device__ __forceinline__ float* CX() const { return (float*)(ws + OFF_CX); }
    __device__ __forceinline__ bf16_t* H() const { return (bf16_t*)(ws + OFF_H); }
    __device__ __forceinline__ bf16_t* U() const { return (bf16_t*)(ws + OFF_U); }
    __device__ __forceinline__ bf16_t* PROJ() const { return (bf16_t*)(ws + OFF_PROJ); }
    __device__ __forceinline__ bf16_t* VtA() const { return (bf16_t*)(ws + OFF_VTA); }
    __device__ __forceinline__ bf16_t* VtB() const { return (bf16_t*)(ws + OFF_VTB); }
    __device__ __forceinline__ bf16_t* VtC() const { return (bf16_t*)(ws + OFF_VTC); }
    __device__ __forceinline__ bf16_t* G() const { return (bf16_t*)(ws + OFF_G); }
    __device__ __forceinline__ bf16_t* Mb() const { return (bf16_t*)(ws + OFF_MB); }
    __device__ __forceinline__ float* Y() const { return (float*)(ws + OFF_Y); }
};

typedef __bf16 bf16x2_t __attribute__((ext_vector_type(2)));
typedef float f32x2_t __attribute__((ext_vector_type(2)));
__device__ __forceinline__ unsigned pk2(float lo, float hi) { const f32x2_t f = {lo, hi}; const bf16x2_t b = __builtin_convertvector(f, bf16x2_t); return __builtin_bit_cast(unsigned, b); }
__device__ __forceinline__ float bflo(unsigned w) { return __uint_as_float(w << 16); }
__device__ __forceinline__ float bfhi(unsigned w) { return __uint_as_float(w & 0xffff0000u); }
__device__ __forceinline__ float sigmoid_f(float v) { return __builtin_amdgcn_rcpf(1.f + __builtin_amdgcn_exp2f(-LOG2E * v)); }
__device__ __forceinline__ float silu_f(float v) { return v * sigmoid_f(v); }
__device__ __forceinline__ float wave_sum(float v) {
    v += __shfl_xor(v, 32); v += __shfl_xor(v, 16); v += __shfl_xor(v, 8); v += __shfl_xor(v, 4); v += __shfl_xor(v, 2); v += __shfl_xor(v, 1); return v;
}
__device__ __forceinline__ int opaque_tid() { int t = threadIdx.x; asm volatile("" : "+v"(t)); return t; }
__device__ __forceinline__ float lam_init_of(int l) { return 0.8f - 0.6f * expf(-0.3f * (float)l); }


#define XB_TMO      128
#define XB_XCNT(j)  (256  + 64 * (j))
#define XB_XSUB(j)  (1280 + 64 * (j))
#define XB_XGEN(j)  (2304 + 64 * (j))
#define XB_TOP      3328
#define XB_TOPGEN   3392
#define XCD_BAR_WORDS 3456
#define G23_PC(mt)   (XCD_BAR_WORDS + 64 * (mt))
#define G23_TK       (XCD_BAR_WORDS + 64 * 72)
#define G23_PC2(mt)  (XCD_BAR_WORDS + 64 * 73 + 64 * (mt))
#define G23_TK2      (XCD_BAR_WORDS + 64 * 145)
#define ALL_BAR_WORDS (XCD_BAR_WORDS + 64 * 146)
#define XB_SPIN_CAP (1u << 18)
#define LAS __attribute__((address_space(3)))
__device__ __forceinline__ unsigned xb_ld(unsigned* p)              { return __hip_atomic_load(p, __ATOMIC_RELAXED, __HIP_MEMORY_SCOPE_AGENT); }
__device__ __forceinline__ unsigned xb_add(unsigned* p, unsigned v) { return __hip_atomic_fetch_add(p, v, __ATOMIC_RELAXED, __HIP_MEMORY_SCOPE_AGENT); }
__device__ __forceinline__ unsigned xb_xcc_id() { return (unsigned)__builtin_amdgcn_s_getreg((3 << 11) | 20) & 0xFu; }
#define XB_SPIN(cond, bar) do { unsigned _sp = 0; while (cond) { __builtin_amdgcn_s_sleep(1); \
    if ((++_sp & 255u) == 0u) { if (xb_ld(&(bar)[XB_TMO])) break; if (_sp > XB_SPIN_CAP) { atomicAdd(&(bar)[XB_TMO], 1u); break; } } } } while (0)
#define XB_SPIN_SLOW(cond, bar) do { unsigned _sp = 0; while (cond) { __builtin_amdgcn_s_sleep(32); \
    if ((++_sp & 63u) == 0u) { if (xb_ld(&(bar)[XB_TMO])) break; if (_sp > (1u << 17)) { atomicAdd(&(bar)[XB_TMO], 1u); break; } } } } while (0)
struct XcdBarrier { unsigned* bar; unsigned x; volatile LAS unsigned* st; };
__device__ __forceinline__ XcdBarrier xcd_barrier_post(unsigned* bar, volatile LAS unsigned* st) {
    XcdBarrier b; b.bar = bar; b.x = xb_xcc_id(); b.st = st;
    if (threadIdx.x == 0) (void)xb_add(&bar[XB_XCNT(b.x)], 1u);
    return b;
}
__device__ __forceinline__ void xcd_barrier_complete(unsigned* bar, unsigned x, unsigned& nloc, unsigned& nx) {
    const unsigned G = gridDim.x * gridDim.y * gridDim.z;
    unsigned sum, cnt, mine, sp = 0u;
    for (;;) {
        sum = 0u; cnt = 0u; mine = 0u;
#pragma unroll
        for (unsigned j = 0; j < 16; ++j) { const unsigned c = xb_ld(&bar[XB_XCNT(j)]); sum += c; cnt += (c > 0u) ? 1u : 0u; mine = (j == x) ? c : mine; }
        if (sum == G) break;
        __builtin_amdgcn_s_sleep(1);
        if ((++sp & 255u) == 0u) { if (xb_ld(&bar[XB_TMO])) break; if (sp > XB_SPIN_CAP) { atomicAdd(&bar[XB_TMO], 1u); break; } }
    }
    nloc = mine > 0u ? mine : 1u; nx = cnt > 0u ? cnt : 1u;
}
__device__ __forceinline__ void xcd_barrier(unsigned* bar_, volatile LAS unsigned* st_) {
    XcdBarrier b; b.bar = bar_; b.x = xb_xcc_id(); b.st = st_;
    asm volatile("s_waitcnt vmcnt(0)" ::: "memory");
    __syncthreads();
    if (threadIdx.x == 0) {
        unsigned* bar = b.bar;
        __builtin_amdgcn_s_waitcnt(0);
        unsigned nloc = b.st[0], nx = b.st[1];
        if (nloc == 0u) { xcd_barrier_complete(bar, b.x, nloc, nx); b.st[0] = nloc; b.st[1] = nx; }
        const unsigned old = xb_add(&bar[XB_XSUB(b.x)], 1u);
        const unsigned gen = old / nloc;
        if (old + 1u == (gen + 1u) * nloc) {
            __builtin_amdgcn_fence(__ATOMIC_RELEASE, "agent");
            asm volatile("s_waitcnt vmcnt(0)" ::: "memory");
            const unsigned og = xb_add(&bar[XB_TOP], 1u);
            const unsigned tg = og / nx;
            if (og + 1u == (tg + 1u) * nx) xb_add(&bar[XB_TOPGEN], 1u);
            else XB_SPIN(xb_ld(&bar[XB_TOPGEN]) == tg, bar);
            __builtin_amdgcn_fence(__ATOMIC_ACQUIRE, "agent");
            xb_add(&bar[XB_XGEN(b.x)], 1u);
            asm volatile("s_waitcnt vmcnt(0)" ::: "memory");
        } else {
            XB_SPIN(xb_ld(&bar[XB_XGEN(b.x)]) == gen, bar);
            __builtin_amdgcn_fence(__ATOMIC_ACQUIRE, "agent");
            asm volatile("s_waitcnt vmcnt(0)" ::: "memory");
        }
    }
    __syncthreads();
}

template <int NY>
__device__ __forceinline__ void gemm_tile(const bf16_t* __restrict__ X, int ldx, const bf16_t* __restrict__ Y, int ldy, int K,
                                          f32x16 (&acc)[2][NY], unsigned char* lds, int tid) {
    const int lane = tid & 63, wave = tid >> 6, wm = wave >> 1, wn = wave & 1, l31 = lane & 31, hh = lane >> 5;
    const int lrow = tid >> 3, lc = tid & 7;
    const bf16_t* gx = X + (size_t)lrow * ldx + lc * 8;
    const bf16_t* gy = Y + (size_t)lrow * ldy + lc * 8;
    u32x4 rx[4], ry[2 * NY];
#pragma unroll
    for (int i = 0; i < 4; i++) rx[i] = *(const u32x4*)(gx + (size_t)(32 * i) * ldx);
#pragma unroll
    for (int i = 0; i < 2 * NY; i++) ry[i] = *(const u32x4*)(gy + (size_t)(32 * i) * ldy);
    __syncthreads();
    unsigned char* wx = lds + lrow * LROW + lc * 16;
#pragma unroll
    for (int i = 0; i < 4; i++) *(u32x4*)(wx + i * 32 * LROW) = rx[i];
#pragma unroll
    for (int i = 0; i < 2 * NY; i++) *(u32x4*)(wx + 18432 + i * 32 * LROW) = ry[i];
    __syncthreads();
    const int nk = K >> 6;
    const unsigned char* rxb = lds + (wm * 64 + l31) * LROW + hh * 16;
    const unsigned char* ryb = lds + 18432 + (wn * 32 * NY + l31) * LROW + hh * 16;
    for (int kt = 0; kt < nk; kt++) {
        const int cur = (kt & 1) * 36864;
        const bool more = (kt + 1 < nk);
        if (more) {
            const int ko = (kt + 1) * 64;
#pragma unroll
            for (int i = 0; i < 4; i++) rx[i] = *(const u32x4*)(gx + (size_t)(32 * i) * ldx + ko);
#pragma unroll
            for (int i = 0; i < 2 * NY; i++) ry[i] = *(const u32x4*)(gy + (size_t)(32 * i) * ldy + ko);
        }
#pragma unroll
        for (int kk = 0; kk < 4; kk++) {
            bf16x8 xf[2], yf[NY];
            xf[0] = *(const bf16x8*)(rxb + cur + kk * 32);
            xf[1] = *(const bf16x8*)(rxb + cur + 32 * LROW + kk * 32);
#pragma unroll
            for (int yi = 0; yi < NY; yi++) yf[yi] = *(const bf16x8*)(ryb + cur + yi * 32 * LROW + kk * 32);
#pragma unroll
            for (int xi = 0; xi < 2; xi++)
#pragma unroll
                for (int yi = 0; yi < NY; yi++) acc[xi][yi] = MFMA(xf[xi], yf[yi], acc[xi][yi]);
        }
        if (more) {
            unsigned char* w2 = wx + (36864 - cur);
#pragma unroll
            for (int i = 0; i < 4; i++) *(u32x4*)(w2 + i * 32 * LROW) = rx[i];
#pragma unroll
            for (int i = 0; i < 2 * NY; i++) *(u32x4*)(w2 + 18432 + i * 32 * LROW) = ry[i];
        }
        __syncthreads();
    }
}

template <int NY>
__device__ __forceinline__ void zero_acc(f32x16 (&acc)[2][NY]) {
#pragma unroll
    for (int a = 0; a < 2; a++)
#pragma unroll
        for (int b = 0; b < NY; b++)
#pragma unroll
            for (int r = 0; r < 16; r++) acc[a][b][r] = 0.f;
}

template <bool PERM = false>
__device__ __forceinline__ void transpose_tile(const float* __restrict__ src, int ldsrc, bf16_t* __restrict__ dst, int lddst, int k0, int n0, float* tile) {
    const int tid = opaque_tid();
    __syncthreads();
#pragma unroll
    for (int i = 0; i < 2; i++) {
        const int id = tid + i * 512, r = id >> 4, c4 = id & 15;
        const float4 v = *(const float4*)(src + (size_t)(k0 + r) * ldsrc + n0 + c4 * 4);
        float* tp = tile + r * 65 + c4 * 4;
        tp[0] = v.x; tp[1] = v.y; tp[2] = v.z; tp[3] = v.w;
    }
    __syncthreads();
    const int n = tid >> 3, kq = tid & 7;
    u32x4 w;
#pragma unroll
    for (int j = 0; j < 4; j++) w[j] = pk2(tile[(kq * 8 + 2 * j) * 65 + n], tile[(kq * 8 + 2 * j + 1) * 65 + n]);
    const int nrow = PERM ? (((n >> 2) & 3) * 16 + ((n >> 4) & 3) * 4 + (n & 3)) : n;
    *(u32x4*)(dst + (size_t)(n0 + nrow) * lddst + k0 + kq * 8) = w;
}

__device__ __forceinline__ int nb2ob(int nb) {
    if (nb < 4) return nb;
    if (nb == 4) return 4;
    if (nb == 5) return 30;
    if (nb == 6) return 5;
    if (nb == 7) return 31;
    if (nb < 32) return nb - 2;
    return nb;
}

__device__ __forceinline__ void phase_pro_a(const Params& p, unsigned char* lds) {
    const int tid = opaque_tid();
    float* tile = (float*)lds;
    const int NCONV = 2560 * NLAY;
    for (int j = blockIdx.x; j < NCONV + 192; j += gridDim.x) {
        if (j < NCONV) {
            const int l = j / 2560; int r = j - l * 2560;
            if (r < 1920) {
                const int kt = r / 120, nt = r - kt * 120;
                const int ob = nb2ob(nt >> 1), oc = ob * 128 + (nt & 1) * 64;
                bf16_t* dstw = p.W1t() + ((size_t)l * N1 + nt * 64) * DM;
                if (oc < INW) transpose_tile(p.w_in + (size_t)l * DM * INW + oc, INW, dstw, DM, kt * 64, 0, tile);
                else transpose_tile(p.w_mg + (size_t)l * DM * 3072 + (oc - INW), 3072, dstw, DM, kt * 64, 0, tile);
            }
            else if (r < 2304) { r -= 1920; const int which = r >> 7; r &= 127; const int kt = r >> 4, nt = r & 15;
                bf16_t* dstw = p.Wbrt() + (size_t)(l * 3 + which) * DM * 512;
                if (which == 0) transpose_tile<true>(p.w_br_a + (size_t)l * 512 * DM, DM, dstw, 512, kt * 64, nt * 64, tile);
                else if (which == 1) transpose_tile<true>(p.w_br_b + (size_t)l * 512 * DM, DM, dstw, 512, kt * 64, nt * 64, tile);
                else transpose_tile<true>(p.w_br_c + (size_t)l * 512 * DM, DM, dstw, 512, kt * 64, nt * 64, tile); }
            else { r -= 2304; const int kt = r >> 4, nt = r & 15;
                transpose_tile(p.w_out + (size_t)l * DM * DM, DM, p.Woutt() + (size_t)l * DM * DM, DM, kt * 64, nt * 64, tile); }
        } else {
            const int jj = j - NCONV; const int l = jj / 48; const int rr = jj - l * 48; const int kc = rr / 6, jb = rr - kc * 6;
            float* sc = (float*)lds;
            __syncthreads();
            for (int idx = tid; idx < 17 * 128; idx += NTHR) {
                const int r = idx >> 7, k = idx & 127;
                const float v = (r < 16) ? p.c[r * DM + kc * 128 + k] : p.c_ctx[kc * 128 + k];
                sc[idx] = v / (1.f + expf(-v));
            }
            __syncthreads();
            float a[17];
#pragma unroll
            for (int r = 0; r < 17; r++) a[r] = 0.f;
            const float* w = p.w_ada + ((size_t)l * DM + kc * 128) * 3072 + jb * NTHR + tid;
            for (int k = 0; k < 128; k++) {
                const float wv = w[(size_t)k * 3072];
#pragma unroll
                for (int r = 0; r < 17; r++) a[r] += sc[r * 128 + k] * wv;
            }
#pragma unroll
            for (int r = 0; r < 17; r++) p.MODP()[((size_t)(kc * 4 + l) * 17 + r) * 3072 + jb * NTHR + tid] = a[r];
        }
    }
}

__device__ const double ROPE_FREQ[16] = {1.0, 0.5623413251903491, 0.31622776601683794, 0.1778279410038923, 0.1, 0.05623413251903491,
    0.031622776601683794, 0.01778279410038923, 0.01, 0.005623413251903491, 0.0031622776601683794, 0.001778279410038923,
    0.001, 0.0005623413251903491, 0.00031622776601683794, 0.0001778279410038923};

__device__ __forceinline__ void sincos_d(double a, double& s, double& c) {
    const double n = rint(a * 0.6366197723675814);
    double r = fma(-n, 1.5707963267948966, a); r = fma(-n, 6.123233995736766e-17, r);
    const double r2 = r * r;
    const double sp = r * (1.0 + r2 * (-1.0 / 6.0 + r2 * (1.0 / 120.0 + r2 * (-1.0 / 5040.0 + r2 * (1.0 / 362880.0 + r2 * (-1.0 / 39916800.0 + r2 * (1.0 / 6227020800.0 + r2 * (-1.0 / 1307674368000.0))))))));
    const double cp = 1.0 + r2 * (-0.5 + r2 * (1.0 / 24.0 + r2 * (-1.0 / 720.0 + r2 * (1.0 / 40320.0 + r2 * (-1.0 / 3628800.0 + r2 * (1.0 / 479001600.0 + r2 * (-1.0 / 87178291200.0 + r2 * (1.0 / 20922789888000.0))))))));
    const int q = ((int)n) & 3;
    if (q == 0) { s = sp; c = cp; } else if (q == 1) { s = cp; c = -sp; } else if (q == 2) { s = -sp; c = -cp; } else { s = -cp; c = sp; }
}

__device__ __forceinline__ void phase_pro_b(const Params& p) {
    const int tid = opaque_tid(), lane = tid & 63, wave = tid >> 6;
    const int gsz = gridDim.x * NTHR;
    for (int idx = blockIdx.x * NTHR + tid; idx < NLAY * 17 * 3072; idx += gsz) {
        const int l = idx / (17 * 3072), j = idx % 3072;
        float s = p.b_ada[l * 3072 + j];
#pragma unroll
        for (int kc = 0; kc < 8; kc++) s += p.MODP()[(size_t)kc * (NLAY * 17 * 3072) + idx];
        p.MOD()[idx] = s;
    }
    if (blockIdx.x == 0 && wave < NLAY) {
        const int l = wave;
        float a = p.lam_q1[l * 64 + lane] * p.lam_k1[l * 64 + lane];
        float b = p.lam_q2[l * 64 + lane] * p.lam_k2[l * 64 + lane];
        a = wave_sum(a); b = wave_sum(b);
        if (lane == 0) p.LAM()[l] = expf(a) - expf(b) + lam_init_of(l);
    }
    if (blockIdx.x == (gridDim.x > 1 ? 1 : 0)) {
        for (int idx = tid; idx < 1024; idx += NTHR) {
            const int pp = idx >> 4, i = idx & 15;
            double s, c; sincos_d((double)pp * ROPE_FREQ[i], s, c);
            p.ROPE()[idx * 2] = (float)c; p.ROPE()[idx * 2 + 1] = (float)s;
        }
    }
}

__device__ __forceinline__ int panel_of(int pi) { return pi < 64 ? (pi >> 3) * 9 + 1 + (pi & 7) : (pi - 64) * 9; }
__device__ __forceinline__ unsigned panel_want(int mt, int inst) { return 4u * (unsigned)(inst + 1) - ((inst > 3 && (mt % 9) == 0) ? 4u : 0u); }
template <bool HOIST>
__device__ __forceinline__ void norm_rows(const Params& p, int chunk, int layer, int row_begin, int row_end, int row_step) {
    const int tid = opaque_tid(), lane = tid & 63, wave = tid >> 6;
    float4 gq[4], ga[4], sh[4];
    auto load_vecs = [&](int mr) {
        if (layer >= 0) {
            const float* gate = p.MOD() + ((size_t)layer * 17 + mr) * 3072 + 2048;
            const float* gp = p.g_post + layer * DM;
#pragma unroll
            for (int i = 0; i < 4; i++) { const int e = i * 256 + lane * 4; const float4 g = *(const float4*)(gate + e), q = *(const float4*)(gp + e);
                gq[i] = make_float4(g.x * q.x, g.y * q.y, g.z * q.z, g.w * q.w); }
        }
        if (layer < NLAY - 1) {
            const int nl = layer + 1;
            const float* md = p.MOD() + ((size_t)nl * 17 + mr) * 3072;
            const float* gpre = p.g_pre + nl * DM;
#pragma unroll
            for (int i = 0; i < 4; i++) { const int e = i * 256 + lane * 4; const float4 s4 = *(const float4*)(md + e), scl = *(const float4*)(md + 1024 + e), g = *(const float4*)(gpre + e);
                ga[i] = make_float4(g.x * (1.f + scl.x), g.y * (1.f + scl.y), g.z * (1.f + scl.z), g.w * (1.f + scl.w)); sh[i] = s4; }
        }
    };
    if (HOIST) { const int bl0 = row_begin / TT, t0 = row_begin - bl0 * TT; load_vecs(t0 < CTXL ? 16 : chunk * CB + bl0); }
    for (int row = row_begin + wave; row < row_end; row += row_step) {
        const int bl = row / TT, t = row - bl * TT, b = chunk * CB + bl;
        const bool isctx = t < CTXL;
        if (layer == NLAY - 1 && isctx) continue;
        const float* xin; float* xst; int mr;
        if (isctx) { const size_t o = ((size_t)b * CTXL + t) * DM; xin = (layer <= 0 ? p.ctx : (const float*)p.CX()) + o; xst = p.CX() + o; mr = 16; }
        else { const size_t o = ((size_t)b * SEQ + (t - CTXL)) * DM; xin = (layer <= 0 ? p.x : (const float*)p.out) + o; xst = p.out + o; mr = b; }
        if (!HOIST) load_vecs(mr);
        float4 xv[4];
#pragma unroll
        for (int i = 0; i < 4; i++) { const f32x4 t4 = __builtin_nontemporal_load((const f32x4*)(xin + i * 256 + lane * 4)); xv[i] = make_float4(t4[0], t4[1], t4[2], t4[3]); }
        if (layer >= 0) {
            const bf16_t* yr = (const bf16_t*)p.Y() + (size_t)row * DM;
            float4 yv[4]; float ss = 0.f;
#pragma unroll
            for (int i = 0; i < 4; i++) { const u32x2 w = __builtin_nontemporal_load((const u32x2*)(yr + i * 256 + lane * 4)); yv[i] = make_float4(bflo(w[0]), bfhi(w[0]), bflo(w[1]), bfhi(w[1]));
                ss += yv[i].x * yv[i].x + yv[i].y * yv[i].y + yv[i].z * yv[i].z + yv[i].w * yv[i].w; }
            ss = wave_sum(ss);
            const float rstd = rsqrtf(ss * (1.f / DM) + 1e-6f);
#pragma unroll
            for (int i = 0; i < 4; i++) {
                const int e = i * 256 + lane * 4;
                xv[i].x += gq[i].x * (yv[i].x * rstd); xv[i].y += gq[i].y * (yv[i].y * rstd);
                xv[i].z += gq[i].z * (yv[i].z * rstd); xv[i].w += gq[i].w * (yv[i].w * rstd);
                __builtin_nontemporal_store((f32x4){xv[i].x, xv[i].y, xv[i].z, xv[i].w}, (f32x4*)(xst + e));
            }
        }
        if (layer < NLAY - 1) {
            float ss = 0.f;
#pragma unroll
            for (int i = 0; i < 4; i++) ss += xv[i].x * xv[i].x + xv[i].y * xv[i].y + xv[i].z * xv[i].z + xv[i].w * xv[i].w;
            ss = wave_sum(ss);
            const float rstd = rsqrtf(ss * (1.f / DM) + 1e-6f);
#pragma unroll
            for (int i = 0; i < 4; i++) {
                const int e = i * 256 + lane * 4;
                const float h0 = xv[i].x * rstd * ga[i].x + sh[i].x, h1 = xv[i].y * rstd * ga[i].y + sh[i].y;
                const float h2 = xv[i].z * rstd * ga[i].z + sh[i].z, h3 = xv[i].w * rstd * ga[i].w + sh[i].w;
                *(uint2*)(p.H() + (size_t)row * DM + e) = make_uint2(pk2(h0, h1), pk2(h2, h3));
            }
        }
    }
}
__device__ __forceinline__ void phase_norm(const Params& p, int chunk, int layer) {
    norm_rows<false>(p, chunk, layer, blockIdx.x * 8, NTC, gridDim.x * 8);
}
__device__ __forceinline__ void phase_norm_ticketed(const Params& p, int chunk, int layer, int inst, volatile LAS unsigned* bst) {
    for (;;) {
        __syncthreads();
        if (threadIdx.x == 0) {
            const unsigned tk = xb_add(&p.BAR()[G23_TK2], 1u) - 544u * (unsigned)inst;
            if (tk < 288u && !(layer == NLAY - 1 && ((int)(tk >> 2) % 9) == 0)) {
                unsigned* pc = &p.BAR()[G23_PC2(tk >> 2)];
                const unsigned want = panel_want((int)(tk >> 2), inst);
                XB_SPIN_SLOW(xb_ld(pc) < want, p.BAR());
                __builtin_amdgcn_fence(__ATOMIC_ACQUIRE, "agent");
                asm volatile("s_waitcnt vmcnt(0)" ::: "memory");
            }
            bst[2] = tk;
        }
        __syncthreads();
        const unsigned it = (unsigned)__builtin_amdgcn_readfirstlane((int)bst[2]);
        if (it >= 288u) break;
        norm_rows<true>(p, chunk, layer, (int)it * 64, (int)it * 64 + 64, 8);
    }
}

__device__ __forceinline__ int lds_byte(int r, int c) {
    const int st = (r >> 4) * 2 + (c >> 5), rr = r & 15, cc = c & 31, ob = rr * 64 + cc * 2;
    return st * 1024 + (ob ^ (((ob >> 9) & 1) << 5));
}
__device__ __forceinline__ void stage_rc(int b, int& R, int& C) {
    const int st = b / 1024, sb = b % 1024, swz = sb ^ (((sb >> 9) & 1) << 5);
    R = (st >> 1) * 16 + swz / 64; C = (st & 1) * 32 + (swz % 64) / 2;
}
struct NoHook { __device__ __forceinline__ void operator()(int, f32x4 (&)[2][2][4][2]) const {} };
template <int LDA, int LDB, int KSEG = 0, class Hook = NoHook>
__device__ __forceinline__ void gemm256(const bf16_t* __restrict__ A, const bf16_t* __restrict__ Bt, const int K, const int brow, const int bcol,
                                        f32x4 (&acc)[2][2][4][2], LAS unsigned char* lds, const size_t segA = 0, const size_t segB = 0, const Hook hook = Hook()) {
    constexpr int BK = 64, HALF = 128, HTB = HALF * BK * 2;
    const int tid = opaque_tid(), wid = __builtin_amdgcn_readfirstlane(tid >> 6), lane = tid & 63, wr = wid >> 2, wc = wid & 3, fr = lane & 15, fq = lane >> 4;
    unsigned voffA[2], voffB[2];
#pragma unroll
    for (int i = 0; i < 2; ++i) { int R, C; stage_rc(tid * 16 + i * 8192, R, C); voffA[i] = (unsigned)(R * LDA + C) * 2u; voffB[i] = (unsigned)(R * LDB + C) * 2u; }
    const size_t kstep = (size_t)(BK * 2);
    const size_t hstepA = (size_t)HALF * LDA * 2, hstepB = (size_t)HALF * LDB * 2;
    const unsigned ldsw = (unsigned)wid * 1024u;
    const int aoff = lds_byte(wr * 64 + fr, fq * 8), boff = lds_byte(wc * 32 + fr, fq * 8);
    const char* cA = (const char*)(A + (size_t)brow * LDA);
    const char* cB = (const char*)(Bt + (size_t)bcol * LDB);
    auto pA = [&](int T) -> const char* { return KSEG ? cA + (size_t)(T / (KSEG ? KSEG : 1)) * segA + (size_t)(T % (KSEG ? KSEG : 1)) * kstep : cA + (size_t)T * kstep; };
    auto pB = [&](int T) -> const char* { return KSEG ? cB + (size_t)(T / (KSEG ? KSEG : 1)) * segB + (size_t)(T % (KSEG ? KSEG : 1)) * kstep : cB + (size_t)T * kstep; };
#define SA(b, h) (((b) * 2 + (h)) * HTB)
#define SB(b, h) ((4 + (b) * 2 + (h)) * HTB)
#define STAGE(bufoff, gbase, voff) do { _Pragma("unroll") for (int _i = 0; _i < 2; ++_i) \
        __builtin_amdgcn_global_load_lds((const unsigned*)((const char*)(gbase) + voff[_i]), (LAS unsigned*)(lds + (bufoff) + ldsw + _i * 8192), 16, 0, 0); } while (0)
#define LDA(dst, b, h) do { _Pragma("unroll") for (int m = 0; m < 4; ++m) _Pragma("unroll") for (int k = 0; k < 2; ++k) dst[m][k] = *(const LAS bf16x8*)(lds + SA(b, h) + aoff + m * 2048 + k * 1024); } while (0)
#define LDB(dst, b, h) do { _Pragma("unroll") for (int n = 0; n < 2; ++n) _Pragma("unroll") for (int k = 0; k < 2; ++k) dst[n][k] = *(const LAS bf16x8*)(lds + SB(b, h) + boff + n * 2048 + k * 1024); } while (0)
#define MMA(ai, bj, At, Bx) do { __builtin_amdgcn_s_setprio(1); _Pragma("unroll") for (int m = 0; m < 4; ++m) _Pragma("unroll") for (int n = 0; n < 2; ++n) _Pragma("unroll") for (int k = 0; k < 2; ++k) \
      acc[ai][bj][m][n] = __builtin_amdgcn_mfma_f32_16x16x32_bf16(At[m][k], Bx[n][k], acc[ai][bj][m][n], 0, 0, 0); \
    __builtin_amdgcn_s_setprio(0); } while (0)
#define WAIT_V(n) asm volatile("s_waitcnt vmcnt(" #n ")" ::: "memory")
#define WAIT_L(n) asm volatile("s_waitcnt lgkmcnt(" #n ")" ::: "memory")
#define BAR __builtin_amdgcn_s_barrier()
#define SCHED __builtin_amdgcn_sched_barrier(0)
#pragma unroll
    for (int a = 0; a < 2; a++)
#pragma unroll
        for (int b = 0; b < 2; b++)
#pragma unroll
            for (int m = 0; m < 4; m++)
#pragma unroll
                for (int n = 0; n < 2; n++) acc[a][b][m][n] = (f32x4){0.f, 0.f, 0.f, 0.f};
    bf16x8 At[4][2], B0[2][2], B1[2][2];
    const int nt = K / BK;
    WAIT_V(0); WAIT_L(0);
    __syncthreads();
    STAGE(SB(0, 0), cB, voffB); STAGE(SA(0, 0), cA, voffA); STAGE(SB(0, 1), cB + hstepB, voffB); STAGE(SA(0, 1), cA + hstepA, voffA);
    if (wr == 1) BAR;
    WAIT_V(4); BAR;
    STAGE(SB(1, 0), pB(1), voffB); STAGE(SA(1, 0), pA(1), voffA); STAGE(SB(1, 1), pB(1) + hstepB, voffB);
    WAIT_V(6); BAR;
    for (int t = 0; t < nt - 2; t += 2) {
        if (KSEG && t > 0 && (t % (KSEG ? KSEG : 1)) == 0) hook(t / (KSEG ? KSEG : 1), acc);
        const char* a1 = pA(t + 1); const char* a2 = pA(t + 2); const char* a3 = pA(t + 3);
        const char* b2 = pB(t + 2); const char* b3 = pB(t + 3);
        LDB(B0, 0, 0); SCHED; LDA(At, 0, 0); STAGE(SA(1, 1), a1 + hstepA, voffA);
        WAIT_L(8); BAR; WAIT_L(0); MMA(0, 0, At, B0); BAR; SCHED;
        LDB(B1, 0, 1); STAGE(SB(0, 0), b2, voffB);
        BAR; WAIT_L(0); MMA(0, 1, At, B1); BAR;
        LDA(At, 0, 1); STAGE(SA(0, 0), a2, voffA);
        BAR; WAIT_L(0); MMA(1, 0, At, B0); BAR; SCHED;
        STAGE(SB(0, 1), b2 + hstepB, voffB);
        WAIT_V(6); BAR; MMA(1, 1, At, B1); BAR;
        LDB(B0, 1, 0); SCHED; LDA(At, 1, 0); STAGE(SA(0, 1), a2 + hstepA, voffA);
        WAIT_L(8); BAR; WAIT_L(0); MMA(0, 0, At, B0); BAR; SCHED;
        LDB(B1, 1, 1); STAGE(SB(1, 0), b3, voffB);
        BAR; WAIT_L(0); MMA(0, 1, At, B1); BAR;
        LDA(At, 1, 1); STAGE(SA(1, 0), a3, voffA);
        BAR; WAIT_L(0); MMA(1, 0, At, B0); BAR; SCHED;
        STAGE(SB(1, 1), b3 + hstepB, voffB);
        WAIT_V(6); BAR; MMA(1, 1, At, B1); BAR;
    }
    { LDB(B0, 0, 0); LDA(At, 0, 0); STAGE(SA(1, 1), pA(nt - 1) + hstepA, voffA);
      BAR; WAIT_L(0); MMA(0, 0, At, B0); BAR;
      LDB(B1, 0, 1); BAR; WAIT_L(0); MMA(0, 1, At, B1); BAR;
      LDA(At, 0, 1); WAIT_V(4); BAR; WAIT_L(0); MMA(1, 0, At, B0); MMA(1, 1, At, B1); BAR; }
    { LDB(B0, 1, 0); LDA(At, 1, 0); WAIT_V(2); BAR; WAIT_L(0); MMA(0, 0, At, B0); BAR;
      LDB(B1, 1, 1); WAIT_V(0); BAR; WAIT_L(0); MMA(0, 1, At, B1); BAR;
      LDA(At, 1, 1); BAR; WAIT_L(0); MMA(1, 0, At, B0); MMA(1, 1, At, B1); BAR; }
    if (wr == 0) BAR;
#undef SA
#undef SB
#undef STAGE
#undef LDA
#undef LDB
#undef MMA
#undef WAIT_V
#undef WAIT_L
#undef BAR
#undef SCHED
}

template <bool PERMF = false, class F>
__device__ __forceinline__ void epi_store_rows(LAS unsigned char* lds, int wid, int lane2, int fr, int fq, int wc, int mt, bf16_t* dbase, size_t dld, F getpk) {
    LAS unsigned char* reg = lds + wid * 9216;
#pragma unroll
    for (int bj = 0; bj < 2; bj++)
#pragma unroll
        for (int n = 0; n < 2; n++)
#pragma unroll
            for (int m = 0; m < 4; m++) *(LAS u32x2*)(reg + ((bj * 2 + n) * 16 + fr) * LROW + (PERMF ? fq * 32 + m * 8 : fq * 8 + m * 32)) = getpk(bj, n, m);
#pragma unroll
    for (int i = 0; i < 8; i++) {
        const int c = lane2 + 64 * i, row = c >> 3, ch = c & 7;
        const u32x4 w = *(const LAS u32x4*)(reg + row * LROW + ch * 16);
        const int tk2 = mt * 256 + (row >> 5) * 128 + wc * 32 + (row & 31);
        if (PERMF) *(u32x4*)(dbase + (size_t)tk2 * dld + ch * 8) = w;
        else __builtin_nontemporal_store(w, (u32x4*)(dbase + (size_t)tk2 * dld + ch * 8));
    }
}

__device__ __forceinline__ void phase_gemm1(const Params& p, int layer, LAS unsigned char* lds) {
    const int tid = opaque_tid(), wid = __builtin_amdgcn_readfirstlane(tid >> 6), wr = wid >> 2, wc = wid & 3;
    const bf16_t* Wt = p.W1t() + (size_t)layer * N1 * DM;
    const bool lastl = (layer == NLAY - 1);
    const int nslots = lastl ? (1920 + 48) : 6 * 48 * 8;
    for (int L = blockIdx.x; L < nslots; L += gridDim.x) {
        int mt, nt;
        if (lastl && L >= 1920) {
            const int c = L - 1920, cp = c / 6, k = c - cp * 6;
            mt = cp * 9; nt = (k < 2) ? 2 + k : 6 + k;
        } else {
            const int xc = L & 7, q = L >> 3, pidx = q / 48, w = q - pidx * 48, gp = pidx * 8 + xc;
            if (gp >= 45) continue;
            const int pmp = gp / 5, pnp = gp - pmp * 5;
            const int pr = pmp * 8 + (w & 7);
            mt = lastl ? (pr >> 3) * 9 + 1 + (pr & 7) : pr;
            nt = pnp * 6 + (w >> 3);
        }
        const bool isV = (nt == 3) || (nt == 10) || (nt == 11);
        f32x4 acc[2][2][4][2];
        if (isV) {
            gemm256<DM, DM>(p.H(), Wt, DM, mt * 256, nt * 256, acc, lds);
            const int tid2 = opaque_tid(), lane2 = tid2 & 63, fr = lane2 & 15, fq = lane2 >> 4;
            const int tok0 = mt * 256; const int bl = tok0 / TT, t0 = tok0 - bl * TT;
            const int ppos = 8 * (fq & 1) + 4 * (fq >> 1);
            LAS unsigned char* vreg = lds + wid * 2304;
#pragma unroll
            for (int bj = 0; bj < 2; bj++)
#pragma unroll
                for (int n = 0; n < 2; n++)
#pragma unroll
                    for (int ai = 0; ai < 2; ai++) {
#pragma unroll
                        for (int m = 0; m < 4; m++) {
                            const f32x4 v = acc[ai][bj][m][n];
                            *(LAS u32x2*)(vreg + fr * LROW + m * 32 + ppos * 2) = (u32x2){pk2(v[0], v[1]), pk2(v[2], v[3])};
                        }
#pragma unroll
                        for (int i = 0; i < 2; i++) {
                            const int c = lane2 + 64 * i, r = c >> 3, ch = c & 7;
                            const int vcr = wc * 32 + n * 16 + r;
                            bf16_t* dr;
                            if (nt == 3) dr = (bj == 0 ? p.VtA() : p.VtC()) + ((size_t)(bl * 2 + (vcr >> 6)) * 64 + (vcr & 63)) * TT;
                            else { const int vc = (nt - 10) * 256 + bj * 128 + vcr; dr = p.VtB() + ((size_t)(bl * 4 + (vc >> 7)) * 128 + (vc & 127)) * TT; }
                            *(u32x4*)(dr + t0 + ai * 128 + wr * 64 + ch * 8) = *(const LAS u32x4*)(vreg + r * LROW + ch * 16);
                        }
                    }
        } else {
            gemm256<DM, DM>(Wt, p.H(), DM, nt * 256, mt * 256, acc, lds);
            const int tid2 = opaque_tid(), lane2 = tid2 & 63, fr = lane2 & 15, fq = lane2 >> 4;
#pragma unroll
            for (int ai = 0; ai < 2; ai++) {
                const int col0 = nb2ob(nt * 2 + ai) * 128 + wr * 64;
                int type;
                if (col0 < 512) type = 0; else if (col0 < 640) type = 1; else if (col0 < 1280) type = 3; else if (col0 < 2304) type = 2;
                else if (col0 < 3328) type = 3; else if (col0 < 3968) type = 2; else if (col0 < 4608) type = 3; else type = 4;
#pragma unroll
                for (int bj = 0; bj < 2; bj++)
#pragma unroll
                    for (int n = 0; n < 2; n++) {
                        const int tk = mt * 256 + bj * 128 + wc * 32 + n * 16 + fr;
                        const int bl = tk / TT, t = tk - bl * TT;
                        float v[4][4];
#pragma unroll
                        for (int m = 0; m < 4; m++)
#pragma unroll
                            for (int j = 0; j < 4; j++) v[m][j] = acc[ai][bj][m][n][j];
                        if (type <= 1) {
                            float ss = 0.f;
#pragma unroll
                            for (int m = 0; m < 4; m++)
#pragma unroll
                                for (int j = 0; j < 4; j++) ss += v[m][j] * v[m][j];
                            ss += __shfl_xor(ss, 16); ss += __shfl_xor(ss, 32);
                            const float rstd = rsqrtf(ss * (1.f / 64.f) + 1e-6f);
                            const float* gn = (type == 0 ? p.q_norm : p.k_norm) + layer * 64;
#pragma unroll
                            for (int m = 0; m < 4; m++) {
                                const float4 g4 = *(const float4*)(gn + m * 16 + fq * 4);
                                v[m][0] *= rstd * g4.x; v[m][1] *= rstd * g4.y; v[m][2] *= rstd * g4.z; v[m][3] *= rstd * g4.w;
                            }
                        }
                        if (type <= 2 && t >= CTXL) {
                            const int pos = t - CTXL;
#pragma unroll
                            for (int ax = 0; ax < 2; ax++) {
                                const int pp = (ax == 0) ? (pos >> 6) : (pos & 63);
                                const float4* rp = (const float4*)(p.ROPE() + (size_t)(pp * 16 + fq * 4) * 2);
                                const float4 c01 = rp[0], c23 = rp[1];
                                const float cs[4] = {c01.x, c01.z, c23.x, c23.z}, sn[4] = {c01.y, c01.w, c23.y, c23.w};
#pragma unroll
                                for (int j = 0; j < 4; j++) {
                                    const float x1 = v[2 * ax][j], x2 = v[2 * ax + 1][j];
                                    v[2 * ax][j] = x1 * cs[j] - x2 * sn[j];
                                    v[2 * ax + 1][j] = x2 * cs[j] + x1 * sn[j];
                                }
                            }
                        }
                        if (col0 < 512 || (col0 >= 3328 && col0 < 3840)) {
#pragma unroll
                            for (int m = 0; m < 4; m++)
#pragma unroll
                                for (int j = 0; j < 4; j++) v[m][j] *= 0.125f * LOG2E;
                        }
                        if (type == 3) {
#pragma unroll
                            for (int m = 0; m < 4; m++)
#pragma unroll
                                for (int j = 0; j < 4; j++) v[m][j] = silu_f(v[m][j]);
                        }
                        if (type == 4) {
                            const float* bm = p.b_mg + layer * 3072 + (col0 - INW);
#pragma unroll
                            for (int m = 0; m < 4; m++) {
                                const float4 b4 = *(const float4*)(bm + m * 16 + fq * 4);
                                v[m][0] = fmaxf(sigmoid_f(v[m][0] + b4.x), 5.96e-8f); v[m][1] = fmaxf(sigmoid_f(v[m][1] + b4.y), 5.96e-8f);
                                v[m][2] = fmaxf(sigmoid_f(v[m][2] + b4.z), 5.96e-8f); v[m][3] = fmaxf(sigmoid_f(v[m][3] + b4.w), 5.96e-8f);
                            }
                        }
                        if (type == 4) {
                            LAS unsigned char* srow = lds + wid * 9216 + ((bj * 2 + n) * 16 + fr) * 80 + fq * 4;
#pragma unroll
                            for (int m = 0; m < 4; m++) {
                                const unsigned q0 = (unsigned)fmaxf(__builtin_rintf(v[m][0] * 255.f), 1.f), q1 = (unsigned)fmaxf(__builtin_rintf(v[m][1] * 255.f), 1.f);
                                const unsigned q2 = (unsigned)fmaxf(__builtin_rintf(v[m][2] * 255.f), 1.f), q3 = (unsigned)fmaxf(__builtin_rintf(v[m][3] * 255.f), 1.f);
                                *(LAS unsigned*)(srow + m * 16) = q0 | (q1 << 8) | (q2 << 16) | (q3 << 24);
                            }
                        } else {
                        LAS unsigned char* srow = lds + wid * 9216 + ((bj * 2 + n) * 16 + fr) * LROW + fq * 8;
#pragma unroll
                        for (int m = 0; m < 4; m++)
                            *(LAS u32x2*)(srow + m * 32) = (u32x2){pk2(v[m][0], v[m][1]), pk2(v[m][2], v[m][3])};
                        }
                    }
                if (type == 4) {
                    unsigned char* dbase = (unsigned char*)p.G() + (col0 - INW);
#pragma unroll
                    for (int i = 0; i < 4; i++) {
                        const int c = lane2 + 64 * i, row = c >> 2, ch = c & 3;
                        const u32x4 w = *(const LAS u32x4*)(lds + wid * 9216 + row * 80 + ch * 16);
                        const int tk2 = mt * 256 + (row >> 5) * 128 + wc * 32 + (row & 31);
                        *(u32x4*)(dbase + (size_t)tk2 * 3072 + ch * 16) = w;
                    }
                } else {
                    bf16_t* dbase = p.PROJ() + col0;
                    const size_t dld = INW;
#pragma unroll
                    for (int i = 0; i < 8; i++) {
                        const int c = lane2 + 64 * i, row = c >> 3, ch = c & 7;
                        const u32x4 w = *(const LAS u32x4*)(lds + wid * 9216 + row * LROW + ch * 16);
                        const int tk2 = mt * 256 + (row >> 5) * 128 + wc * 32 + (row & 31);
                        *(u32x4*)(dbase + (size_t)tk2 * dld + ch * 8) = w;
                    }
                }
            }
        }
    }
}

template <int DV>
__device__ __forceinline__ void attn_tile(const unsigned char* Kl, const unsigned char* Vl, const bf16x8 (&qf)[4], f32x16 (&O)[DV / 32], float& m, float& l,
                                          int l31, int hh, bool domask, int qpos, int kpos0) {
    const float SL2 = 0.125f * LOG2E;
    const float THR = 8.f;
    f32x16 S[2];
#pragma unroll
    for (int sub = 0; sub < 2; sub++)
#pragma unroll
        for (int r = 0; r < 16; r++) S[sub][r] = 0.f;
#pragma unroll
    for (int kk = 0; kk < 4; kk++)
#pragma unroll
        for (int sub = 0; sub < 2; sub++) {
            const bf16x8 kf = *(const bf16x8*)(Kl + (sub * 32 + l31) * LROW + kk * 32 + hh * 16);
            S[sub] = MFMA(kf, qf[kk], S[sub]);
        }
    if (domask) {
#pragma unroll
        for (int sub = 0; sub < 2; sub++)
#pragma unroll
            for (int r = 0; r < 16; r++) {
                const int d = qpos - (kpos0 + sub * 32 + (r & 3) + 8 * (r >> 2) + 4 * hh);
                S[sub][r] = (d <= 128 && d >= -128) ? S[sub][r] : -1e30f;
            }
    }
    float mx = S[0][0];
#pragma unroll
    for (int sub = 0; sub < 2; sub++)
#pragma unroll
        for (int r = 0; r < 16; r++) mx = fmaxf(mx, S[sub][r]);
    mx = fmaxf(mx, __shfl_xor(mx, 32));
    const float mxs = mx * SL2;
    if (__any(mxs > m + THR)) {
        const float mnew = fmaxf(m, mxs);
        const float alpha = __builtin_amdgcn_exp2f(m - mnew);
        m = mnew; l *= alpha;
#pragma unroll
        for (int dt = 0; dt < DV / 32; dt++)
#pragma unroll
            for (int r = 0; r < 16; r++) O[dt][r] *= alpha;
    }
    float ps = 0.f;
#pragma unroll
    for (int sub = 0; sub < 2; sub++)
#pragma unroll
        for (int r = 0; r < 16; r++) { S[sub][r] = __builtin_amdgcn_exp2f(__builtin_fmaf(S[sub][r], SL2, -m)); ps += S[sub][r]; }
    l += ps;
    bf16x8 pb[2][2];
#pragma unroll
    for (int sub = 0; sub < 2; sub++)
#pragma unroll
        for (int s = 0; s < 2; s++) {
            u32x4 cv;
            cv[0] = pk2(S[sub][8 * s + 0], S[sub][8 * s + 1]); cv[1] = pk2(S[sub][8 * s + 2], S[sub][8 * s + 3]);
            cv[2] = pk2(S[sub][8 * s + 4], S[sub][8 * s + 5]); cv[3] = pk2(S[sub][8 * s + 6], S[sub][8 * s + 7]);
            pb[sub][s] = __builtin_bit_cast(bf16x8, cv);
        }
#pragma unroll
    for (int sub = 0; sub < 2; sub++)
#pragma unroll
        for (int s = 0; s < 2; s++)
#pragma unroll
            for (int dt = 0; dt < DV / 32; dt++) {
                const bf16x8 vf = *(const bf16x8*)(Vl + (dt * 32 + l31) * LROW + (sub * 4 + s * 2 + hh) * 16);
                O[dt] = MFMA(vf, pb[sub][s], O[dt]);
            }
}

template <int DV>
__device__ __forceinline__ void attn_tile_rel(const unsigned char* Kl, const unsigned char* Vl, const bf16x8 (&qf)[4], f32x16 (&O)[DV / 32], float& m, float& l, f32x16& NEGM,
                                              bool first, int l31, int hh, bool domask, int qpos, int kpos0) {
    const float THR = 8.f;
    f32x16 S[2];
#pragma unroll
    for (int sub = 0; sub < 2; sub++) {
        const bf16x8 kf = *(const bf16x8*)(Kl + (sub * 32 + l31) * LROW + hh * 16);
        S[sub] = MFMA(kf, qf[0], NEGM);
    }
#pragma unroll
    for (int kk = 1; kk < 4; kk++)
#pragma unroll
        for (int sub = 0; sub < 2; sub++) {
            const bf16x8 kf = *(const bf16x8*)(Kl + (sub * 32 + l31) * LROW + kk * 32 + hh * 16);
            S[sub] = MFMA(kf, qf[kk], S[sub]);
        }
    if (domask) {
#pragma unroll
        for (int sub = 0; sub < 2; sub++)
#pragma unroll
            for (int r = 0; r < 16; r++) {
                const int d = qpos - (kpos0 + sub * 32 + (r & 3) + 8 * (r >> 2) + 4 * hh);
                S[sub][r] = (d <= 128 && d >= -128) ? S[sub][r] : -1e30f;
            }
    }
    float mx = S[0][0];
#pragma unroll
    for (int sub = 0; sub < 2; sub++)
#pragma unroll
        for (int r = 0; r < 16; r++) mx = fmaxf(mx, S[sub][r]);
    mx = fmaxf(mx, __shfl_xor(mx, 32));
    if (first || __any(mx > THR)) {
        const float d = first ? mx : fmaxf(mx, 0.f);
        const float alpha = __builtin_amdgcn_exp2f(-d);
        m += d; l *= alpha;
#pragma unroll
        for (int dt = 0; dt < DV / 32; dt++)
#pragma unroll
            for (int r = 0; r < 16; r++) O[dt][r] *= alpha;
#pragma unroll
        for (int r = 0; r < 16; r++) NEGM[r] -= d;
#pragma unroll
        for (int sub = 0; sub < 2; sub++)
#pragma unroll
            for (int r = 0; r < 16; r++) S[sub][r] -= d;
    }
    float ps = 0.f;
#pragma unroll
    for (int sub = 0; sub < 2; sub++)
#pragma unroll
        for (int r = 0; r < 16; r++) { S[sub][r] = __builtin_amdgcn_exp2f(S[sub][r]); ps += S[sub][r]; }
    l += ps;
#pragma unroll
    for (int sub = 0; sub < 2; sub++)
#pragma unroll
        for (int s = 0; s < 2; s++) {
            u32x4 cv;
            cv[0] = pk2(S[sub][8 * s + 0], S[sub][8 * s + 1]); cv[1] = pk2(S[sub][8 * s + 2], S[sub][8 * s + 3]);
            cv[2] = pk2(S[sub][8 * s + 4], S[sub][8 * s + 5]); cv[3] = pk2(S[sub][8 * s + 6], S[sub][8 * s + 7]);
            const bf16x8 pb = __builtin_bit_cast(bf16x8, cv);
#pragma unroll
            for (int dt = 0; dt < DV / 32; dt++) {
                const bf16x8 vf = *(const bf16x8*)(Vl + (dt * 32 + l31) * LROW + (sub * 4 + s * 2 + hh) * 16);
                O[dt] = MFMA(vf, pb, O[dt]);
            }
        }
}

template <bool DIFF>
__device__ __forceinline__ void attn_unit(const Params& p, int layer, int mode, int bl, int hidx, int qblk, bool isctx, unsigned char* lds) {
    constexpr int DV = DIFF ? 128 : 64;
    constexpr int NKM = DIFF ? 2 : 1;
    constexpr int KBYTES = NKM * 9216, VBYTES = DV * LROW, BUFB = KBYTES + VBYTES;
    const int tid = opaque_tid(), lane = tid & 63, wave = __builtin_amdgcn_readfirstlane(tid >> 6), l31 = lane & 31, hh = lane >> 5;
    int qcol, kcol, gcol, ucol, tq, head = 0, cm = 0, qs = 0;
    const bf16_t* vt;
    int qpos;
    if (DIFF) {
        cm = wave & 1; qs = wave >> 1;
        qcol = 1280 + hidx * 128 + cm * 64; kcol = 1792 + hidx * 128; gcol = 2816 + hidx * 128; ucol = NTC * 512 + hidx * 128;
        vt = p.VtB() + (size_t)(bl * 4 + hidx) * 128 * TT;
        qpos = qblk * 128 + qs * 32 + l31;
        tq = bl * TT + (isctx ? 0 : CTXL) + qpos;
    } else {
        head = hidx * 4 + (wave & 3);
        qpos = qblk * 64 + (wave >> 2) * 32 + l31;
        if (mode == 0) { qcol = head * 64; kcol = 512 + hidx * 64; gcol = 768 + head * 64; ucol = head * 64; vt = p.VtA() + (size_t)(bl * 2 + hidx) * 64 * TT; }
        else { qcol = 3328 + head * 64; kcol = 3840 + hidx * 64; gcol = 4096 + head * 64; ucol = 2 * NTC * 512 + head * 64; vt = p.VtC() + (size_t)(bl * 2 + hidx) * 64 * TT; }
        tq = bl * TT + (isctx ? 0 : CTXL) + qpos;
    }
    const bool win = (!DIFF) && (mode == 2) && !isctx;
    int n2, start2;
    if (isctx) { n2 = 0; start2 = 0; }
    else if (win) { const int q0 = qblk * 64; int lo = q0 - 128; if (lo < 0) lo = 0; int hi = q0 + 192; if (hi > SEQ) hi = SEQ; n2 = (hi - lo) >> 6; start2 = CTXL + lo; }
    else { n2 = 32; start2 = CTXL; }
    const int ntile = 4 + n2;

    const bf16_t* kp = p.PROJ() + (size_t)(bl * TT) * INW + kcol;
    const int lr = tid >> 3, lc = tid & 7;
    u32x4 kr[NKM], vr[DV / 64];
    bf16x8 qf[4];
    {
        unsigned char* qreg = lds + 73728 + wave * 4608;
        const int tqb = tq - l31;
#pragma unroll
        for (int i = 0; i < 4; i++) {
            const int c = lane + 64 * i, row = c >> 3, ch = c & 7;
            *(u32x4*)(qreg + row * LROW + ch * 16) = *(const u32x4*)(p.PROJ() + (size_t)(tqb + row) * INW + qcol + ch * 8);
        }
#pragma unroll
        for (int kk = 0; kk < 4; kk++) qf[kk] = *(const bf16x8*)(qreg + l31 * LROW + kk * 32 + hh * 16);
    }
    f32x16 O[DV / 32];
#pragma unroll
    for (int dt = 0; dt < DV / 32; dt++)
#pragma unroll
        for (int r = 0; r < 16; r++) O[dt][r] = 0.f;
    float m = DIFF ? -1e30f : 0.f, l = 0.f;
    f32x16 NEGM;
#pragma unroll
    for (int r = 0; r < 16; r++) NEGM[r] = 0.f;

    {
        const int t0 = 0;
#pragma unroll
        for (int i = 0; i < NKM; i++) kr[i] = *(const u32x4*)(kp + (size_t)(t0 + lr) * INW + i * 64 + lc * 8);
#pragma unroll
        for (int i = 0; i < DV / 64; i++) vr[i] = *(const u32x4*)(vt + (size_t)(lr + i * 64) * TT + t0 + lc * 8);
    }
    __syncthreads();
    {
        unsigned char* wb = lds + lr * LROW + lc * 16;
#pragma unroll
        for (int i = 0; i < NKM; i++) *(u32x4*)(wb + i * 9216) = kr[i];
#pragma unroll
        for (int i = 0; i < DV / 64; i++) *(u32x4*)(wb + KBYTES + i * 64 * LROW) = vr[i];
    }
    __syncthreads();
    for (int it = 0; it < ntile; it++) {
        const unsigned char* cur = lds + (it & 1) * BUFB;
        const bool more = (it + 1 < ntile);
        if (more) {
            const int t0 = (it + 1 < 4) ? (it + 1) * 64 : start2 + (it + 1 - 4) * 64;
#pragma unroll
            for (int i = 0; i < NKM; i++) kr[i] = *(const u32x4*)(kp + (size_t)(t0 + lr) * INW + i * 64 + lc * 8);
#pragma unroll
            for (int i = 0; i < DV / 64; i++) vr[i] = *(const u32x4*)(vt + (size_t)(lr + i * 64) * TT + t0 + lc * 8);
        }
        const int tcur = (it < 4) ? it * 64 : start2 + (it - 4) * 64;
        const int rel = (tcur - CTXL) - (DIFF ? 0 : (qblk * 64 + (wave >> 2) * 32));
        if (DIFF) attn_tile<DV>(cur + cm * 9216, cur + KBYTES, qf, O, m, l, l31, hh, false, qpos, tcur - CTXL);
        else attn_tile_rel<DV>(cur, cur + KBYTES, qf, O, m, l, NEGM, it == 0, l31, hh, win && (it >= 4) && (rel < -97 || rel > 65), qpos, tcur - CTXL);
        if (more) {
            unsigned char* wb = lds + ((it + 1) & 1) * BUFB + lr * LROW + lc * 16;
#pragma unroll
            for (int i = 0; i < NKM; i++) *(u32x4*)(wb + i * 9216) = kr[i];
#pragma unroll
            for (int i = 0; i < DV / 64; i++) *(u32x4*)(wb + KBYTES + i * 64 * LROW) = vr[i];
        }
        __syncthreads();
    }
    float lt = l + __shfl_xor(l, 32);
    if (DIFF) {
        const float inv = 1.f / lt;
        float* xb = (float*)lds + qs * 128 * 32;
        if (cm == 1) {
#pragma unroll
            for (int dt = 0; dt < DV / 32; dt++)
#pragma unroll
                for (int r = 0; r < 16; r++) xb[(dt * 32 + (r & 3) + 8 * (r >> 2) + 4 * hh) * 32 + l31] = O[dt][r] * inv;
        }
        __syncthreads();
        if (cm == 0) {
            const float lam = p.LAM()[layer];
            const float om = 1.f - lam_init_of(layer);
            float ss = 0.f;
#pragma unroll
            for (int dt = 0; dt < DV / 32; dt++)
#pragma unroll
                for (int r = 0; r < 16; r++) {
                    const float o = O[dt][r] * inv - lam * xb[(dt * 32 + (r & 3) + 8 * (r >> 2) + 4 * hh) * 32 + l31];
                    O[dt][r] = o; ss += o * o;
                }
            ss += __shfl_xor(ss, 32);
            const float rstd = rsqrtf(ss * (1.f / 128.f) + 1e-5f) * om;
            unsigned char* sreg = lds + 65536 + wave * 9216;
            constexpr int RS = DV * 2 + 16, CPR = DV / 8;
            const int lane_e = opaque_tid() & 63;
            const int tqb = tq - l31;
#pragma unroll
            for (int i = 0; i < DV / 16; i++) {
                const int c = lane_e + 64 * i, row = c / CPR, ch = c % CPR;
                *(u32x4*)(sreg + row * RS + ch * 16) = __builtin_nontemporal_load((const u32x4*)(p.PROJ() + (size_t)(tqb + row) * INW + gcol + ch * 8));
                if ((i & 1) == 1) asm volatile("" ::: "memory");
            }
#pragma unroll
            for (int dt = 0; dt < DV / 32; dt++)
#pragma unroll
                for (int rg = 0; rg < 4; rg++) {
                    const int d0 = dt * 32 + rg * 8 + hh * 4;
                    const float4 sg = *(const float4*)(p.subln + layer * 128 + d0);
                    u32x2* sp = (u32x2*)(sreg + l31 * RS + d0 * 2);
                    const u32x2 gw = *sp;
                    const float o0 = O[dt][rg * 4 + 0] * rstd * sg.x * bflo(gw[0]), o1 = O[dt][rg * 4 + 1] * rstd * sg.y * bfhi(gw[0]);
                    const float o2 = O[dt][rg * 4 + 2] * rstd * sg.z * bflo(gw[1]), o3 = O[dt][rg * 4 + 3] * rstd * sg.w * bfhi(gw[1]);
                    *sp = (u32x2){pk2(o0, o1), pk2(o2, o3)};
                }
#pragma unroll
            for (int i = 0; i < DV / 16; i++) {
                const int c = lane_e + 64 * i, row = c / CPR, ch = c % CPR;
                *(u32x4*)(p.U() + (size_t)(tqb + row) * 512 + ucol + ch * 8) = *(const u32x4*)(sreg + row * RS + ch * 16);
                if ((i & 1) == 1) asm volatile("" ::: "memory");
            }
        }
    } else {
        float a = 1.f;
        if (mode == 2) {
            const float s2 = p.sink[layer * 8 + head] * LOG2E;
            const float mf = fmaxf(m, s2);
            a = __builtin_amdgcn_exp2f(m - mf);
            lt = lt * a + __builtin_amdgcn_exp2f(s2 - mf);
        }
        const float inv = a / lt;
        unsigned char* sreg = lds + 65536 + wave * 9216;
        constexpr int RS = DV * 2 + 16, CPR = DV / 8;
        const int lane_e = opaque_tid() & 63;
        const int tqb = tq - l31;
#pragma unroll
        for (int i = 0; i < DV / 16; i++) {
            const int c = lane_e + 64 * i, row = c / CPR, ch = c % CPR;
            *(u32x4*)(sreg + row * RS + ch * 16) = __builtin_nontemporal_load((const u32x4*)(p.PROJ() + (size_t)(tqb + row) * INW + gcol + ch * 8));
        }
#pragma unroll
        for (int dt = 0; dt < DV / 32; dt++)
#pragma unroll
            for (int rg = 0; rg < 4; rg++) {
                const int d0 = dt * 32 + rg * 8 + hh * 4;
                u32x2* sp = (u32x2*)(sreg + l31 * RS + d0 * 2);
                const u32x2 gw = *sp;
                const float o0 = O[dt][rg * 4 + 0] * inv * bflo(gw[0]), o1 = O[dt][rg * 4 + 1] * inv * bfhi(gw[0]);
                const float o2 = O[dt][rg * 4 + 2] * inv * bflo(gw[1]), o3 = O[dt][rg * 4 + 3] * inv * bfhi(gw[1]);
                *sp = (u32x2){pk2(o0, o1), pk2(o2, o3)};
            }
#pragma unroll
        for (int i = 0; i < DV / 16; i++) {
            const int c = lane_e + 64 * i, row = c / CPR, ch = c % CPR;
            *(u32x4*)(p.U() + (size_t)(tqb + row) * 512 + ucol + ch * 8) = *(const u32x4*)(sreg + row * RS + ch * 16);
        }
    }
}

__device__ __forceinline__ void phase_attn(const Params& p, int layer, unsigned char* lds) {
    const int nunits = 1536 + ((layer < NLAY - 1) ? 192 : 0);
    for (int u = blockIdx.x; u < nunits; u += gridDim.x) {
        int mode, bl, hidx, qb; bool isctx;
        if (u < 512) { const int x = u & 7, rest = u >> 3; qb = rest & 15; const int combo = (rest >> 4) * 8 + x; mode = 1; bl = combo >> 2; hidx = combo & 3; isctx = false; }
        else if (u < 1536) { const int u2 = (u - 512) & 511; const int x = u2 & 7, rest = u2 >> 3; qb = rest & 31; const int combo = (rest >> 5) * 8 + x;
            mode = (u < 1024) ? 0 : 2; bl = combo >> 1; hidx = combo & 1; isctx = false; }
        else if (u < 1600) { const int u2 = u - 1536; qb = u2 & 1; const int combo = u2 >> 1; mode = 1; bl = combo >> 2; hidx = combo & 3; isctx = true; }
        else { const int u2 = (u - 1600) & 63; qb = u2 & 3; const int combo = u2 >> 2; mode = (u < 1664) ? 0 : 2; bl = combo >> 1; hidx = combo & 1; isctx = true; }
        __syncthreads();
        if (mode == 1) attn_unit<true>(p, layer, mode, bl, hidx, qb, isctx, lds);
        else attn_unit<false>(p, layer, mode, bl, hidx, qb, isctx, lds);
    }
}

__device__ __forceinline__ float ub(unsigned w, int j) { return (float)((w >> (8 * j)) & 0xffu); }
struct GateHook {
    const unsigned char* G; int tok0, feat0;
    __device__ __forceinline__ void operator()(int seg, f32x4 (&acc)[2][2][4][2]) const {
        const int tid2 = opaque_tid(), lane2 = tid2 & 63, wid2 = __builtin_amdgcn_readfirstlane(tid2 >> 6), wr = wid2 >> 2, wc = wid2 & 3, fr = lane2 & 15, fq = lane2 >> 4;
#pragma unroll
        for (int bj = 0; bj < 2; bj++)
#pragma unroll
            for (int n = 0; n < 2; n++) {
                const int tk = tok0 + bj * 128 + wc * 32 + n * 16 + fr;
                const unsigned char* gprev = G + (size_t)tk * 3072 + (seg - 1) * 1024 + feat0 + wr * 64 + fq * 16;
#pragma unroll
                for (int ai = 0; ai < 2; ai++) {
                    const u32x4 gp = *(const u32x4*)(gprev + ai * 128), gn = *(const u32x4*)(gprev + 1024 + ai * 128);
#pragma unroll
                    for (int m = 0; m < 4; m++) {
                        f32x4& v = acc[ai][bj][m][n];
                        v[0] *= ub(gp[m], 0) * __builtin_amdgcn_rcpf(ub(gn[m], 0)); v[1] *= ub(gp[m], 1) * __builtin_amdgcn_rcpf(ub(gn[m], 1));
                        v[2] *= ub(gp[m], 2) * __builtin_amdgcn_rcpf(ub(gn[m], 2)); v[3] *= ub(gp[m], 3) * __builtin_amdgcn_rcpf(ub(gn[m], 3));
                    }
                }
            }
    }
};

__device__ __forceinline__ void phase_gemm2(const Params& p, int layer, LAS unsigned char* lds) {
    const int tid = opaque_tid(), wid = __builtin_amdgcn_readfirstlane(tid >> 6), wr = wid >> 2, wc = wid & 3;
    const int ntiles = (layer == NLAY - 1) ? 256 : 288;
    for (int L = blockIdx.x; L < ntiles; L += gridDim.x) {
        const int mt = panel_of(L >> 2), nt = L & 3;
        f32x4 acc[2][2][4][2];
        GateHook hk; hk.G = (const unsigned char*)p.G(); hk.tok0 = mt * 256; hk.feat0 = nt * 256;
        gemm256<512, 512, 8, GateHook>(p.Wbrt() + (size_t)(layer * 3) * DM * 512, p.U(), 1536, nt * 256, mt * 256, acc, lds,
                                       (size_t)DM * 512 * 2, (size_t)NTC * 512 * 2, hk);
        const int tid2 = opaque_tid(), lane2 = tid2 & 63, fr = lane2 & 15, fq = lane2 >> 4;
#pragma unroll
        for (int ai = 0; ai < 2; ai++) {
            const int f0 = nt * 256 + ai * 128 + wr * 64;
            epi_store_rows<true>(lds, wid, lane2, fr, fq, wc, mt, p.Mb() + f0, DM, [&](int bj, int n, int m) -> u32x2 {
                const int tk = mt * 256 + bj * 128 + wc * 32 + n * 16 + fr;
                const unsigned gw = *(const unsigned*)((const unsigned char*)p.G() + (size_t)tk * 3072 + 2048 + f0 + fq * 16 + m * 4);
                const f32x4 v = acc[ai][bj][m][n] * (1.f / 255.f);
                return (u32x2){pk2(v[0] * ub(gw, 0), v[1] * ub(gw, 1)), pk2(v[2] * ub(gw, 2), v[3] * ub(gw, 3))};
            });
        }
        asm volatile("s_waitcnt vmcnt(0)" ::: "memory");
        __syncthreads();
        if (threadIdx.x == 0) {
            __builtin_amdgcn_fence(__ATOMIC_RELEASE, "agent");
            asm volatile("s_waitcnt vmcnt(0)" ::: "memory");
            xb_add(&p.BAR()[G23_PC(mt)], 1u);
        }
    }
}

__device__ __forceinline__ void phase_gemm3(const Params& p, int layer, int inst, LAS unsigned char* lds, volatile LAS unsigned* bst) {
    const int tid = opaque_tid(), wid = __builtin_amdgcn_readfirstlane(tid >> 6), wr = wid >> 2, wc = wid & 3;
    const unsigned nvalid = (layer == NLAY - 1) ? 256u : 288u;
    for (;;) {
        __syncthreads();
        if (threadIdx.x == 0) {
            const unsigned tk = xb_add(&p.BAR()[G23_TK], 1u) - (544u * (unsigned)inst - (inst > 3 ? 32u : 0u));
            if (tk < nvalid) {
                const int pmt = panel_of((int)(tk >> 2));
                unsigned* pc = &p.BAR()[G23_PC(pmt)];
                const unsigned want = panel_want(pmt, inst);
                XB_SPIN_SLOW(xb_ld(pc) < want, p.BAR());
                __builtin_amdgcn_fence(__ATOMIC_ACQUIRE, "agent");
                asm volatile("s_waitcnt vmcnt(0)" ::: "memory");
            }
            bst[2] = tk;
        }
        __syncthreads();
        const unsigned L = (unsigned)__builtin_amdgcn_readfirstlane((int)bst[2]);
        if (L >= nvalid) break;
        const int mt = panel_of((int)(L >> 2)), nt = (int)(L & 3u);
        f32x4 acc[2][2][4][2];
        gemm256<DM, DM>(p.Woutt() + (size_t)layer * DM * DM, p.Mb(), DM, nt * 256, mt * 256, acc, lds);
        const int tid2 = opaque_tid(), lane2 = tid2 & 63, fr = lane2 & 15, fq = lane2 >> 4;
#pragma unroll
        for (int ai = 0; ai < 2; ai++)
            epi_store_rows(lds, wid, lane2, fr, fq, wc, mt, (bf16_t*)p.Y() + nt * 256 + ai * 128 + wr * 64, DM, [&](int bj, int n, int m) -> u32x2 {
                const f32x4 v = acc[ai][bj][m][n];
                return (u32x2){pk2(v[0], v[1]), pk2(v[2], v[3])};
            });
        asm volatile("s_waitcnt vmcnt(0)" ::: "memory");
        __syncthreads();
        if (threadIdx.x == 0) {
            __builtin_amdgcn_fence(__ATOMIC_RELEASE, "agent");
            asm volatile("s_waitcnt vmcnt(0)" ::: "memory");
            xb_add(&p.BAR()[G23_PC2(mt)], 1u);
        }
    }
}

__global__ void __launch_bounds__(512, 2) fwd_kernel(Params p) {
    extern __shared__ __attribute__((aligned(16))) unsigned char lds[];
    cg::grid_group grid = cg::this_grid();
    volatile LAS unsigned* bst = (volatile LAS unsigned*)((LAS unsigned char*)lds + LDS_BYTES);
    if (threadIdx.x == 0) { bst[0] = 0u; bst[1] = 0u; }
    __syncthreads();
    (void)xcd_barrier_post(p.BAR(), bst);
    phase_pro_a(p, lds);
    grid.sync();
    phase_pro_b(p);
    xcd_barrier(p.BAR(), bst);
    for (int chunk = 0; chunk < NB / CB; chunk++) {
        phase_norm(p, chunk, -1);
        xcd_barrier(p.BAR(), bst);
        for (int layer = 0; layer < NLAY; layer++) {
            phase_gemm1(p, layer, (LAS unsigned char*)lds);
            xcd_barrier(p.BAR(), bst);
            phase_attn(p, layer, lds);
            xcd_barrier(p.BAR(), bst);
            phase_gemm2(p, layer, (LAS unsigned char*)lds);
            phase_gemm3(p, layer, chunk * NLAY + layer, (LAS unsigned char*)lds, bst);
            phase_norm_ticketed(p, chunk, layer, chunk * NLAY + layer, bst);
            xcd_barrier(p.BAR(), bst);
        }
    }
}

extern "C" void kernel_launch(void* const* d_in, const int* in_sizes, int n_in, void* d_out, int out_size, void* d_ws, size_t ws_size, hipStream_t stream) {
    static int grid_blocks = 0;
    if (!grid_blocks) {
        int dev = 0, cus = 0, per_cu = 0;
        hipGetDevice(&dev);
        hipDeviceGetAttribute(&cus, hipDeviceAttributeMultiprocessorCount, dev);
        hipFuncSetAttribute((const void*)fwd_kernel, hipFuncAttributeMaxDynamicSharedMemorySize, LDS_BYTES + 16);
        hipOccupancyMaxActiveBlocksPerMultiprocessor(&per_cu, (const void*)fwd_kernel, NTHR, LDS_BYTES + 16);
        if (per_cu < 1) per_cu = 1;
        if (per_cu > 1) per_cu = 1;
        grid_blocks = cus * per_cu;
    }
    Params p{};
    const float* const* in = (const float* const*)d_in;
    p.x = in[0]; p.c = in[1]; p.ctx = in[2]; p.c_ctx = in[3]; p.w_ada = in[4]; p.b_ada = in[5]; p.g_pre = in[6]; p.g_post = in[7];
    p.w_in = in[8]; p.q_norm = in[9]; p.k_norm = in[10]; p.lam_q1 = in[11]; p.lam_k1 = in[12]; p.lam_q2 = in[13]; p.lam_k2 = in[14];
    p.subln = in[15]; p.sink = in[16]; p.w_br_a = in[17]; p.w_br_b = in[18]; p.w_br_c = in[19]; p.w_mg = in[20]; p.b_mg = in[21]; p.w_out = in[22];
    p.out = (float*)d_out;
    p.ws = (unsigned char*)d_ws;
    if (WS_END > ws_size) { fprintf(stderr, "kernel_launch: workspace too small: need %zu, have %zu\n", (size_t)WS_END, ws_size); return; }
    hipMemsetAsync((unsigned char*)d_ws + OFF_BAR, 0, ALL_BAR_WORDS * 4, stream);
    void* args[] = {&p};
    hipError_t e = hipLaunchCooperativeKernel((void*)fwd_kernel, dim3(grid_blocks), dim3(NTHR), args, LDS_BYTES + 16, stream);
    if (e != hipSuccess) fprintf(stderr, "cooperative launch failed: %s (grid %d)\n", hipGetErrorString(e), grid_blocks);
}
```
